# Optimizing an MI355X kernel written in HIP

```python
import math
import jax
import jax.numpy as jnp
from jax import lax
import numpy as np

D_MODEL = 1024
BATCH = 2
SEQ = 8192
DEPTH = 1

N_HEADS = 4
HEAD_DIM = 64
V_DIM = 2 * HEAD_DIM
ATTN_WIDTH = N_HEADS * V_DIM
Q_BLOCK = 128
LAMBDA_STD = 0.1
ALIBI_SLOPES = tuple(2.0 ** (-8.0 * (h + 1) / N_HEADS) for h in range(N_HEADS))

LRU_WIDTH = D_MODEL // 2
LRU_BLOCKS = 8
LRU_BLOCK_W = LRU_WIDTH // LRU_BLOCKS
CONV_W = 4
LRU_C = 8.0
A_MIN = 0.9
A_MAX = 0.999

N_GROUPS = 4
EXPERTS_PER_GROUP = 8
N_EXPERTS = N_GROUPS * EXPERTS_PER_GROUP
TOP_K = 2
D_EXPERT = D_MODEL // 2
MOE_BLOCK = 128

NORM_EPS = 1e-6

QK_COLS = N_HEADS * 2 * HEAD_DIM
SPLITS = (QK_COLS, 2 * QK_COLS, 2 * QK_COLS + ATTN_WIDTH,
          2 * QK_COLS + ATTN_WIDTH + LRU_WIDTH, 2 * QK_COLS + ATTN_WIDTH + 2 * LRU_WIDTH)
IN_COLS = SPLITS[-1] + 2 * D_MODEL

kernel_name = 'hybrid_diffattn_rglru_hmoe'


def rms_norm(x, g):
    xf = x.astype(jnp.float32)
    y = xf * lax.rsqrt(jnp.mean(xf * xf, axis=-1, keepdims=True) + NORM_EPS)
    return (y * g.astype(jnp.float32)).astype(x.dtype)


def diff_attention(q, k, v, lam, subln_g, lam_init):
    B, S = q.shape[0], q.shape[1]
    n_blocks = S // Q_BLOCK
    slopes = jnp.asarray(ALIBI_SLOPES, dtype=jnp.float32)
    scale = HEAD_DIM ** -0.5
    k_pos = jnp.arange(S)

    def one_block(i):
        start = i * Q_BLOCK
        qb = lax.dynamic_slice_in_dim(q, start, Q_BLOCK, axis=1)
        s = jnp.einsum('bqhmd,bkhmd->bhmqk', qb, k).astype(jnp.float32) * scale
        dist = (start + jnp.arange(Q_BLOCK))[:, None] - k_pos[None, :]
        alibi = -slopes[:, None, None] * dist.astype(jnp.float32)[None]
        s = jnp.where((dist >= 0)[None, None, None], s + alibi[None, :, None], -jnp.inf)
        p = jax.nn.softmax(s, axis=-1)
        w = p[:, :, 0] - lam * p[:, :, 1]
        return jnp.einsum('bhqk,bkhv->bqhv', w.astype(v.dtype), v)

    o = lax.map(one_block, jnp.arange(n_blocks))
    o = jnp.moveaxis(o, 0, 1).reshape(B, S, N_HEADS, V_DIM)
    o = rms_norm(o, subln_g) * (1.0 - lam_init)
    return o.reshape(B, S, ATTN_WIDTH)


def causal_conv(x, w, b):
    C = x.shape[-1]
    y = lax.conv_general_dilated(x, w[:, None, :].astype(x.dtype), window_strides=(1,),
                                 padding=[(CONV_W - 1, 0)],
                                 dimension_numbers=('NWC', 'WIO', 'NWC'),
                                 feature_group_count=C)
    return y + b.astype(x.dtype)


def rg_lru(x, w_r, b_r, w_i, b_i, lru_lambda):
    B, S, C = x.shape
    xb = x.reshape(B, S, LRU_BLOCKS, LRU_BLOCK_W)
    r = jax.nn.sigmoid(jnp.einsum('bsnc,ncd->bsnd', xb, w_r).reshape(B, S, C) + b_r)
    i = jax.nn.sigmoid(jnp.einsum('bsnc,ncd->bsnd', xb, w_i).reshape(B, S, C) + b_i)
    log_a = -LRU_C * r.astype(jnp.float32) * jax.nn.softplus(-lru_lambda.astype(jnp.float32))
    a = jnp.exp(log_a)
    mult = jnp.sqrt(-jnp.expm1(2.0 * log_a))
    mult = jnp.where(jnp.arange(S)[None, :, None] == 0, 1.0, mult)
    u = (x * i).astype(jnp.float32) * mult

    def combine(c1, c2):
        a1, b1 = c1
        a2, b2 = c2
        return a1 * a2, a2 * b1 + b2

    _, h = lax.associative_scan(combine, (a, u), axis=1)
    return h.astype(x.dtype)


def hier_moe(h, w_group, w_expert_router, w_gate, w_up, w_down):
    B, S, D = h.shape
    N = B * S
    t = h.reshape(N, D)
    g_logits = (t @ w_group).astype(jnp.float32)
    g_prob = jax.nn.softmax(g_logits, axis=-1)
    g_idx = jnp.argmax(g_logits, axis=-1)
    g_w = jnp.take_along_axis(g_prob, g_idx[:, None], axis=1)[:, 0]
    e_logits_all = jnp.einsum('nd,gde->nge', t, w_expert_router)
    e_logits = jnp.take_along_axis(e_logits_all, g_idx[:, None, None], axis=1)[:, 0].astype(jnp.float32)
    e_prob = jax.nn.softmax(e_logits, axis=-1)
    top_p, top_i = lax.top_k(e_prob, TOP_K)
    top_p = top_p / jnp.sum(top_p, axis=-1, keepdims=True)
    weights = g_w[:, None] * top_p
    expert_id = g_idx[:, None] * EXPERTS_PER_GROUP + top_i

    A = N * TOP_K
    flat_e = expert_id.reshape(A).astype(jnp.int32)
    flat_tok = jnp.repeat(jnp.arange(N, dtype=jnp.int32), TOP_K)
    flat_w = weights.reshape(A)
    order = jnp.argsort(flat_e)
    sorted_e = flat_e[order]
    counts = jnp.bincount(flat_e, length=N_EXPERTS)
    starts = jnp.cumsum(counts) - counts
    padded = (counts + MOE_BLOCK - 1) // MOE_BLOCK * MOE_BLOCK
    pad_ends = jnp.cumsum(padded)
    pad_starts = pad_ends - padded
    dest = pad_starts[sorted_e] + (jnp.arange(A) - starts[sorted_e])
    n_blocks = (A + N_EXPERTS * (MOE_BLOCK - 1) + MOE_BLOCK - 1) // MOE_BLOCK
    P = n_blocks * MOE_BLOCK
    row_tok = jnp.full((P,), N, dtype=jnp.int32).at[dest].set(flat_tok[order])
    row_w = jnp.zeros((P,), jnp.float32).at[dest].set(flat_w[order])
    block_e = jnp.minimum(jnp.searchsorted(pad_ends, jnp.arange(n_blocks) * MOE_BLOCK, side='right'),
                          N_EXPERTS - 1)
    t_pad = jnp.concatenate([t, jnp.zeros((1, D), t.dtype)], axis=0)
    xs = t_pad[row_tok].reshape(n_blocks, MOE_BLOCK, D)

    def expert_block(args):
        xb, e = args
        return (jax.nn.silu(xb @ w_gate[e]) * (xb @ w_up[e])) @ w_down[e]

    ys = lax.map(expert_block, (xs, block_e)).reshape(P, D)
    out = jnp.zeros((N + 1, D), jnp.float32).at[row_tok].add(ys.astype(jnp.float32) * row_w[:, None])[:N]
    return out.reshape(B, S, D).astype(h.dtype)


def setup_inputs(seed: int = 0) -> dict:
    key = jax.random.key(seed)
    ks = jax.random.split(key, 24)
    f32 = jnp.float32
    nrm = lambda k, shape, s: jax.random.normal(k, shape, f32) * s
    a0 = jax.random.uniform(ks[11], (DEPTH, LRU_WIDTH), f32, A_MIN, A_MAX)
    sig = a0 ** (1.0 / LRU_C)
    lru_lambda = jnp.log(sig) - jnp.log1p(-sig)
    return {
        'x': jax.random.normal(ks[0], (BATCH, SEQ, D_MODEL), f32),
        'norm_mix_g': 1.0 + nrm(ks[1], (DEPTH, D_MODEL), 0.02),
        'w_in': nrm(ks[2], (DEPTH, D_MODEL, IN_COLS), D_MODEL ** -0.5),
        'lambda_qk': nrm(ks[3], (DEPTH, 2, 2, HEAD_DIM), LAMBDA_STD),
        'subln_g': 1.0 + nrm(ks[4], (DEPTH, V_DIM), 0.02),
        'conv_w': nrm(ks[5], (DEPTH, CONV_W, LRU_WIDTH), CONV_W ** -0.5),
        'conv_b': nrm(ks[6], (DEPTH, LRU_WIDTH), 0.01),
        'w_r': nrm(ks[7], (DEPTH, LRU_BLOCKS, LRU_BLOCK_W, LRU_BLOCK_W), LRU_BLOCK_W ** -0.5),
        'b_r': nrm(ks[8], (DEPTH, LRU_WIDTH), 0.01),
        'w_i': nrm(ks[9], (DEPTH, LRU_BLOCKS, LRU_BLOCK_W, LRU_BLOCK_W), LRU_BLOCK_W ** -0.5),
        'b_i': nrm(ks[10], (DEPTH, LRU_WIDTH), 0.01),
        'lru_lambda': lru_lambda,
        'w_o_attn': nrm(ks[12], (DEPTH, ATTN_WIDTH, D_MODEL), ATTN_WIDTH ** -0.5),
        'w_o_lru': nrm(ks[13], (DEPTH, LRU_WIDTH, D_MODEL), LRU_WIDTH ** -0.5),
        'w_out': nrm(ks[14], (DEPTH, D_MODEL, D_MODEL), D_MODEL ** -0.5),
        'norm_ffn_g': 1.0 + nrm(ks[15], (DEPTH, D_MODEL), 0.02),
        'w_group': nrm(ks[16], (DEPTH, D_MODEL, N_GROUPS), D_MODEL ** -0.5),
        'w_expert_router': nrm(ks[17], (DEPTH, N_GROUPS, D_MODEL, EXPERTS_PER_GROUP), D_MODEL ** -0.5),
        'w_gate': nrm(ks[18], (DEPTH, N_EXPERTS, D_MODEL, D_EXPERT), D_MODEL ** -0.5),
        'w_up': nrm(ks[19], (DEPTH, N_EXPERTS, D_MODEL, D_EXPERT), D_MODEL ** -0.5),
        'w_down': nrm(ks[20], (DEPTH, N_EXPERTS, D_EXPERT, D_MODEL), D_EXPERT ** -0.5),
        'final_norm_g': 1.0 + nrm(ks[21], (D_MODEL,), 0.02),
    }


def reference(x, norm_mix_g, w_in, lambda_qk, subln_g, conv_w, conv_b, w_r, b_r, w_i, b_i,
              lru_lambda, w_o_attn, w_o_lru, w_out, norm_ffn_g, w_group, w_expert_router,
              w_gate, w_up, w_down, final_norm_g):
    B, S, D = x.shape
    for l in range(DEPTH):
        lam_init = 0.8 - 0.6 * math.exp(-0.3 * l)
        h = rms_norm(x, norm_mix_g[l])
        proj = h @ w_in[l]
        q, k, v, xr, yr, gate_logits = jnp.split(proj, SPLITS + (IN_COLS - 2 * D_MODEL + 0,), axis=-1)[:6] if False else jnp.split(proj, SPLITS, axis=-1)
        q = q.reshape(B, S, N_HEADS, 2, HEAD_DIM)
        k = k.reshape(B, S, N_HEADS, 2, HEAD_DIM)
        v = v.reshape(B, S, N_HEADS, V_DIM)
        lp = lambda_qk[l].astype(jnp.float32)
        lam = jnp.exp(jnp.sum(lp[0, 0] * lp[0, 1])) - jnp.exp(jnp.sum(lp[1, 0] * lp[1, 1])) + lam_init
        attn = diff_attention(q, k, v, lam, subln_g[l], lam_init)
        xr = causal_conv(xr, conv_w[l], conv_b[l])
        lru = rg_lru(xr, w_r[l], b_r[l], w_i[l], b_i[l], lru_lambda[l]) * jax.nn.gelu(yr)
        gates = jax.nn.sigmoid(gate_logits)
        g_attn = gates[..., :D_MODEL]
        g_lru = gates[..., D_MODEL:]
        merged = g_attn * (attn @ w_o_attn[l]) + g_lru * (lru @ w_o_lru[l])
        x = x + merged @ w_out[l]
        x = x + hier_moe(rms_norm(x, norm_ffn_g[l]), w_group[l], w_expert_router[l],
                         w_gate[l], w_up[l], w_down[l])
    return rms_norm(x, final_norm_g)
```

```cpp
#include <hip/hip_runtime.h>
#include <cstdio>
#include <cstdint>
#include <cmath>

typedef unsigned short bf16;
constexpr int NTOK = 16384, SEQ = 8192, DM = 1024, INC = 4608;
constexpr float C2 = 0.125f * 1.4426950408889634f;
constexpr float LOG2E = 1.4426950408889634f;
constexpr float EPS = 1e-6f;

__device__ __forceinline__ unsigned f2bf(float f) { unsigned u = __builtin_bit_cast(unsigned, f); return (u + 0x7fffu + ((u >> 16) & 1u)) >> 16; }
__device__ __forceinline__ float bf2f(bf16 b) { return __builtin_bit_cast(float, (unsigned)b << 16); }
__device__ __forceinline__ float sigmoidf_(float x) { return 1.f / (1.f + __expf(-x)); }
__device__ __forceinline__ float gelu_tanh(float x) { const float z = 0.7978845608028654f * (x + 0.044715f * x * x * x); return 0.5f * x * (1.f + tanhf(z)); }

constexpr size_t MiB = 1u << 20;
constexpr size_t WS_CTL = 0;
constexpr size_t WS_XN = 110 * MiB, WS_Q = 142 * MiB, WS_K = 158 * MiB, WS_V = 174 * MiB, WS_XR = 190 * MiB, WS_GY = 206 * MiB, WS_AL = 222 * MiB;
constexpr size_t WS_MERGED = 142 * MiB;
constexpr size_t WS_END = 256 * MiB;

__global__ void n_rmsnorm(const float* __restrict__ x, const float* __restrict__ g, bf16* __restrict__ xn) {
    const int row = blockIdx.x, tid = threadIdx.x;
    const float4 v = ((const float4*)(x + (size_t)row * DM))[tid];
    float s = v.x * v.x + v.y * v.y + v.z * v.z + v.w * v.w;
    __shared__ float red[256];
    red[tid] = s; __syncthreads();
    for (int o = 128; o > 0; o >>= 1) { if (tid < o) red[tid] += red[tid + o]; __syncthreads(); }
    const float rstd = rsqrtf(red[0] / DM + EPS);
    const float4 gg = ((const float4*)g)[tid];
    bf16* o = xn + (size_t)row * DM + tid * 4;
    o[0] = f2bf(v.x * rstd * gg.x); o[1] = f2bf(v.y * rstd * gg.y); o[2] = f2bf(v.z * rstd * gg.z); o[3] = f2bf(v.w * rstd * gg.w);
}

template <class Epi>
__global__ void n_gemm(const bf16* __restrict__ A, int lda, const float* __restrict__ W, int ldw, int K, Epi epi) {
    __shared__ float As[16][65]; __shared__ float Ws[16][64];
    const int tx = threadIdx.x, ty = threadIdx.y, tid = ty * 16 + tx;
    const int row0 = blockIdx.y * 64, col0 = blockIdx.x * 64;
    float acc[4][4];
#pragma unroll
    for (int i = 0; i < 4; ++i)
#pragma unroll
        for (int j = 0; j < 4; ++j) acc[i][j] = 0.f;
    for (int k0 = 0; k0 < K; k0 += 16) {
#pragma unroll
        for (int i = 0; i < 4; ++i) { const int idx = tid + i * 256; const int r = idx >> 4, kk = idx & 15; As[kk][r] = bf2f(A[(size_t)(row0 + r) * lda + k0 + kk]); }
#pragma unroll
        for (int i = 0; i < 4; ++i) { const int idx = tid + i * 256; const int kk = idx >> 6, c = idx & 63; Ws[kk][c] = W[(size_t)(k0 + kk) * ldw + col0 + c]; }
        __syncthreads();
#pragma unroll
        for (int kk = 0; kk < 16; ++kk) {
            float a[4], b[4];
#pragma unroll
            for (int i = 0; i < 4; ++i) a[i] = As[kk][ty * 4 + i];
#pragma unroll
            for (int j = 0; j < 4; ++j) b[j] = Ws[kk][tx * 4 + j];
#pragma unroll
            for (int i = 0; i < 4; ++i)
#pragma unroll
                for (int j = 0; j < 4; ++j) acc[i][j] += a[i] * b[j];
        }
        __syncthreads();
    }
#pragma unroll
    for (int i = 0; i < 4; ++i)
#pragma unroll
        for (int j = 0; j < 4; ++j) epi(row0 + ty * 4 + i, col0 + tx * 4 + j, acc[i][j]);
}

struct EpiInProj {
    bf16 *Q, *K, *V, *XR, *GY, *GATES;
    __device__ void operator()(int r, int c, float v) const {
        if (c < 512) Q[(size_t)r * 512 + c] = f2bf(v * C2);
        else if (c < 1024) K[(size_t)r * 512 + c - 512] = f2bf(v);
        else if (c < 1536) V[(size_t)r * 512 + c - 1024] = f2bf(v);
        else if (c < 2048) XR[(size_t)r * 512 + c - 1536] = f2bf(v);
        else if (c < 2560) GY[(size_t)r * 512 + c - 2048] = f2bf(gelu_tanh(v));
        else GATES[(size_t)r * 2048 + c - 2560] = f2bf(sigmoidf_(v));
    }
};
struct EpiResid { const float* x; float* out; __device__ void operator()(int r, int c, float v) const { out[(size_t)r * DM + c] = x[(size_t)r * DM + c] + v; } };

__global__ void n_gemm_mix(const bf16* __restrict__ AL, const float* __restrict__ Woa, const float* __restrict__ Wol, const bf16* __restrict__ GATES, bf16* __restrict__ MERGED) {
    __shared__ float As[2][16][65]; __shared__ float Ws[2][16][64];
    const int tx = threadIdx.x, ty = threadIdx.y, tid = ty * 16 + tx;
    const int row0 = blockIdx.y * 64, col0 = blockIdx.x * 64;
    float acc[2][4][4];
#pragma unroll
    for (int s = 0; s < 2; ++s)
#pragma unroll
        for (int i = 0; i < 4; ++i)
#pragma unroll
            for (int j = 0; j < 4; ++j) acc[s][i][j] = 0.f;
    for (int k0 = 0; k0 < 512; k0 += 16) {
#pragma unroll
        for (int i = 0; i < 4; ++i) { const int idx = tid + i * 256; const int r = idx >> 4, kk = idx & 15;
            As[0][kk][r] = bf2f(AL[(size_t)(row0 + r) * 1024 + k0 + kk]); As[1][kk][r] = bf2f(AL[(size_t)(row0 + r) * 1024 + 512 + k0 + kk]); }
#pragma unroll
        for (int i = 0; i < 4; ++i) { const int idx = tid + i * 256; const int kk = idx >> 6, c = idx & 63;
            Ws[0][kk][c] = Woa[(size_t)(k0 + kk) * 1024 + col0 + c]; Ws[1][kk][c] = Wol[(size_t)(k0 + kk) * 1024 + col0 + c]; }
        __syncthreads();
#pragma unroll
        for (int s = 0; s < 2; ++s)
#pragma unroll
            for (int kk = 0; kk < 16; ++kk) {
                float a[4], b[4];
#pragma unroll
                for (int i = 0; i < 4; ++i) a[i] = As[s][kk][ty * 4 + i];
#pragma unroll
                for (int j = 0; j < 4; ++j) b[j] = Ws[s][kk][tx * 4 + j];
#pragma unroll
                for (int i = 0; i < 4; ++i)
#pragma unroll
                    for (int j = 0; j < 4; ++j) acc[s][i][j] += a[i] * b[j];
            }
        __syncthreads();
    }
#pragma unroll
    for (int i = 0; i < 4; ++i)
#pragma unroll
        for (int j = 0; j < 4; ++j) { const int r = row0 + ty * 4 + i, c = col0 + tx * 4 + j;
            const float ga = bf2f(GATES[(size_t)r * 2048 + c]), gl = bf2f(GATES[(size_t)r * 2048 + 1024 + c]);
            MERGED[(size_t)r * 1024 + c] = f2bf(ga * acc[0][i][j] + gl * acc[1][i][j]); }
}

__global__ void n_attn(const bf16* __restrict__ Q, const bf16* __restrict__ K, const bf16* __restrict__ V, const float* __restrict__ lambda_qk, const float* __restrict__ subln_g, bf16* __restrict__ AL) {
    const int row = blockIdx.x, h = blockIdx.y, tid = threadIdx.x;
    const int b = row / SEQ, qpos = row % SEQ;
    __shared__ float sc[SEQ]; __shared__ float qv[64]; __shared__ float red[256]; __shared__ float o0[128]; __shared__ float part[256];
    const float slope2 = exp2f(-2.f * (h + 1)) * LOG2E;
    float lam;
    { float s0 = 0.f, s1 = 0.f; for (int d = 0; d < 64; ++d) { s0 += lambda_qk[d] * lambda_qk[64 + d]; s1 += lambda_qk[128 + d] * lambda_qk[192 + d]; } lam = expf(s0) - expf(s1) + 0.2f; }
    float ofin = 0.f;
    for (int m = 0; m < 2; ++m) {
        __syncthreads();
        if (tid < 64) qv[tid] = bf2f(Q[(size_t)row * 512 + h * 128 + m * 64 + tid]);
        __syncthreads();
        float lmax = -INFINITY;
        for (int key = tid; key <= qpos; key += 256) {
            const bf16* kr = K + (size_t)(b * SEQ + key) * 512 + h * 128 + m * 64;
            float s = 0.f;
            for (int d = 0; d < 64; ++d) s += qv[d] * bf2f(kr[d]);
            s += slope2 * (float)(key - qpos);
            sc[key] = s; lmax = fmaxf(lmax, s);
        }
        red[tid] = lmax; __syncthreads();
        for (int o = 128; o > 0; o >>= 1) { if (tid < o) red[tid] = fmaxf(red[tid], red[tid + o]); __syncthreads(); }
        const float mx = red[0]; __syncthreads();
        float lsum = 0.f;
        for (int key = tid; key <= qpos; key += 256) { const float p = exp2f(sc[key] - mx); sc[key] = p; lsum += p; }
        red[tid] = lsum; __syncthreads();
        for (int o = 128; o > 0; o >>= 1) { if (tid < o) red[tid] += red[tid + o]; __syncthreads(); }
        const float inv = 1.f / red[0]; __syncthreads();
        const int vd = tid & 127, half = tid >> 7;
        float acc = 0.f;
        for (int key = half; key <= qpos; key += 2) acc += sc[key] * bf2f(V[(size_t)(b * SEQ + key) * 512 + h * 128 + vd]);
        part[tid] = acc; __syncthreads();
        if (tid < 128) { const float o = (part[tid] + part[tid + 128]) * inv; if (m == 0) ofin = o; else ofin = ofin - lam * o; }
    }
    __syncthreads();
    red[tid] = (tid < 128) ? ofin * ofin : 0.f; __syncthreads();
    for (int o = 128; o > 0; o >>= 1) { if (tid < o) red[tid] += red[tid + o]; __syncthreads(); }
    const float rstd = rsqrtf(red[0] / 128.f + EPS);
    if (tid < 128) AL[(size_t)row * 1024 + h * 128 + tid] = f2bf(ofin * rstd * subln_g[tid] * 0.8f);
}

__global__ void n_lru(const bf16* __restrict__ XR, const bf16* __restrict__ GY, const float* __restrict__ conv_w, const float* __restrict__ conv_b, const float* __restrict__ w_r, const float* __restrict__ b_r,
                      const float* __restrict__ w_i, const float* __restrict__ b_i, const float* __restrict__ lru_lambda, bf16* __restrict__ AL) {
    const int b = blockIdx.x >> 3, n = blockIdx.x & 7, d = threadIdx.x, ch = n * 64 + d;
    __shared__ float Wr[64][64]; __shared__ float Wi[64][64]; __shared__ float xs[64];
    for (int c = 0; c < 64; ++c) { Wr[c][d] = w_r[(size_t)n * 4096 + c * 64 + d]; Wi[c][d] = w_i[(size_t)n * 4096 + c * 64 + d]; }
    const float cw0 = conv_w[ch], cw1 = conv_w[512 + ch], cw2 = conv_w[1024 + ch], cw3 = conv_w[1536 + ch], cb = conv_b[ch];
    const float br = b_r[ch], bi = b_i[ch];
    const float sp = log1pf(expf(-lru_lambda[ch]));
    float xm3 = 0.f, xm2 = 0.f, xm1 = 0.f, hst = 0.f;
    __syncthreads();
    for (int t = 0; t < SEQ; ++t) {
        const size_t row = (size_t)b * SEQ + t;
        const float xt = bf2f(XR[row * 512 + ch]);
        const float xc = cw0 * xm3 + cw1 * xm2 + cw2 * xm1 + cw3 * xt + cb;
        xm3 = xm2; xm2 = xm1; xm1 = xt;
        xs[d] = xc; __syncthreads();
        float rp = br, ip = bi;
        for (int c = 0; c < 64; ++c) { const float xv = xs[c]; rp += xv * Wr[c][d]; ip += xv * Wi[c][d]; }
        __syncthreads();
        const float r = sigmoidf_(rp), ig = sigmoidf_(ip);
        const float log_a = -8.f * r * sp;
        const float a = expf(log_a);
        const float mult = (t == 0) ? 1.f : sqrtf(-expm1f(2.f * log_a));
        hst = a * hst + xc * ig * mult;
        AL[row * 1024 + 512 + ch] = f2bf(hst * bf2f(GY[row * 512 + ch]));
    }
}

__global__ void n_moe_final(float* __restrict__ xio, const float* __restrict__ g_ffn, const float* __restrict__ w_group, const float* __restrict__ w_er, const float* __restrict__ w_gate, const float* __restrict__ w_up,
                            const float* __restrict__ w_down, const float* __restrict__ g_fin) {
    const int row = blockIdx.x, tid = threadIdx.x;
    __shared__ float x1[1024]; __shared__ float hn[1024]; __shared__ float hb[512]; __shared__ float red[512]; __shared__ float lg[16]; __shared__ int sel[4]; __shared__ float selw[2];
    float* xr = xio + (size_t)row * DM;
    const float a0 = xr[tid], a1 = xr[tid + 512];
    x1[tid] = a0; x1[tid + 512] = a1;
    red[tid] = a0 * a0 + a1 * a1; __syncthreads();
    for (int o = 256; o > 0; o >>= 1) { if (tid < o) red[tid] += red[tid + o]; __syncthreads(); }
    const float rstd = rsqrtf(red[0] / DM + EPS); __syncthreads();
    hn[tid] = a0 * rstd * g_ffn[tid]; hn[tid + 512] = a1 * rstd * g_ffn[tid + 512]; __syncthreads();
    if (tid < 4) { float s = 0.f; for (int k = 0; k < 1024; ++k) s += hn[k] * w_group[k * 4 + tid]; lg[tid] = s; }
    __syncthreads();
    if (tid == 0) { int g = 0; float mx = lg[0]; for (int j = 1; j < 4; ++j) if (lg[j] > mx) { mx = lg[j]; g = j; } float den = 0.f; for (int j = 0; j < 4; ++j) den += expf(lg[j] - mx); sel[0] = g; lg[8] = 1.f / den; }
    __syncthreads();
    const int grp = sel[0];
    if (tid < 8) { float s = 0.f; const float* w = w_er + (size_t)grp * 8192; for (int k = 0; k < 1024; ++k) s += hn[k] * w[k * 8 + tid]; lg[tid] = s; }
    __syncthreads();
    if (tid == 0) {
        const float gw = lg[8];
        int i0 = 0; for (int j = 1; j < 8; ++j) if (lg[j] > lg[i0]) i0 = j;
        int i1 = (i0 == 0) ? 1 : 0; for (int j = 0; j < 8; ++j) if (j != i0 && lg[j] > lg[i1]) i1 = j;
        const float p0 = 1.f / (1.f + expf(lg[i1] - lg[i0]));
        sel[1] = grp * 8 + i0; sel[2] = grp * 8 + i1; selw[0] = gw * p0; selw[1] = gw * (1.f - p0);
    }
    __syncthreads();
    float y0 = 0.f, y1 = 0.f;
    for (int kk = 0; kk < 2; ++kk) {
        const int e = sel[1 + kk]; const float wk = selw[kk];
        const float* wg = w_gate + (size_t)e * 1024 * 512; const float* wu = w_up + (size_t)e * 1024 * 512; const float* wd = w_down + (size_t)e * 512 * 1024;
        float g = 0.f, u = 0.f;
        for (int k = 0; k < 1024; ++k) { const float xv = hn[k]; g += xv * wg[(size_t)k * 512 + tid]; u += xv * wu[(size_t)k * 512 + tid]; }
        __syncthreads();
        hb[tid] = g / (1.f + expf(-g)) * u; __syncthreads();
        float s0 = 0.f, s1 = 0.f;
        for (int j = 0; j < 512; ++j) { const float hv = hb[j]; s0 += hv * wd[(size_t)j * 1024 + tid]; s1 += hv * wd[(size_t)j * 1024 + tid + 512]; }
        y0 += wk * s0; y1 += wk * s1;
    }
    const float z0 = a0 + y0, z1 = a1 + y1;
    __syncthreads();
    red[tid] = z0 * z0 + z1 * z1; __syncthreads();
    for (int o = 256; o > 0; o >>= 1) { if (tid < o) red[tid] += red[tid + o]; __syncthreads(); }
    const float rs2 = rsqrtf(red[0] / DM + EPS);
    xr[tid] = z0 * rs2 * g_fin[tid]; xr[tid + 512] = z1 * rs2 * g_fin[tid + 512];
}

extern "C" void kernel_launch(void* const* d_in, const int* in_sizes, int n_in, void* d_out, int out_size, void* d_ws, size_t ws_size, hipStream_t stream) {
    if (n_in != 22 || out_size != NTOK * DM || ws_size < WS_END) { fprintf(stderr, "kernel_launch: unexpected shapes (n_in %d out %d ws %zu)\n", n_in, out_size, ws_size); return; }
    const float* x = (const float*)d_in[0];
    unsigned char* ws = (unsigned char*)d_ws;
    bf16* XN = (bf16*)(ws + WS_XN); bf16* Qb = (bf16*)(ws + WS_Q); bf16* Kb = (bf16*)(ws + WS_K); bf16* Vb = (bf16*)(ws + WS_V);
    bf16* XR = (bf16*)(ws + WS_XR); bf16* GY = (bf16*)(ws + WS_GY); bf16* AL = (bf16*)(ws + WS_AL); bf16* MERGED = (bf16*)(ws + WS_MERGED);
    bf16* GATES = (bf16*)d_out;
    n_rmsnorm<<<NTOK, 256, 0, stream>>>(x, (const float*)d_in[1], XN);
    n_gemm<EpiInProj><<<dim3(INC / 64, NTOK / 64), dim3(16, 16), 0, stream>>>(XN, DM, (const float*)d_in[2], INC, DM, EpiInProj{Qb, Kb, Vb, XR, GY, GATES});
    n_attn<<<dim3(NTOK, 4), 256, 0, stream>>>(Qb, Kb, Vb, (const float*)d_in[3], (const float*)d_in[4], AL);
    n_lru<<<16, 64, 0, stream>>>(XR, GY, (const float*)d_in[5], (const float*)d_in[6], (const float*)d_in[7], (const float*)d_in[8], (const float*)d_in[9], (const float*)d_in[10], (const float*)d_in[11], AL);
    n_gemm_mix<<<dim3(DM / 64, NTOK / 64), dim3(16, 16), 0, stream>>>(AL, (const float*)d_in[12], (const float*)d_in[13], GATES, MERGED);
    n_gemm<EpiResid><<<dim3(DM / 64, NTOK / 64), dim3(16, 16), 0, stream>>>(MERGED, DM, (const float*)d_in[14], DM, DM, EpiResid{x, (float*)d_out});
    n_moe_final<<<NTOK, 512, 0, stream>>>((float*)d_out, (const float*)d_in[15], (const float*)d_in[16], (const float*)d_in[17], (const float*)d_in[18], (const float*)d_in[19], (const float*)d_in[20], (const float*)d_in[21]);
}
```

```cpp
#include <hip/hip_runtime.h>
#include <cstdio>
#include <cstdint>
#include <cmath>

constexpr int NTOK = 16384, SEQ = 8192, DM = 1024, INC = 4608;
constexpr float C2 = 0.125f * 1.4426950408889634f;
constexpr float LOG2E = 1.4426950408889634f;
constexpr float EPS = 1e-6f;
typedef unsigned short bf16;

__device__ __forceinline__ unsigned f2bf(float f) { unsigned u = __builtin_bit_cast(unsigned, f); return (u + 0x7fffu + ((u >> 16) & 1u)) >> 16; }
__device__ __forceinline__ unsigned pk2(float lo, float hi) { return f2bf(lo) | (f2bf(hi) << 16); }
__device__ __forceinline__ float bf2f(bf16 b) { return __builtin_bit_cast(float, (unsigned)b << 16); }
__device__ __forceinline__ float sigmoidf_(float x) { return 1.f / (1.f + __expf(-x)); }
__device__ __forceinline__ float gelu_tanh(float x) { const float z = 0.7978845608028654f * (x + 0.044715f * x * x * x); return 0.5f * x * (1.f + tanhf(z)); }
__device__ __forceinline__ float sigmoid_fast(float x) { return __builtin_amdgcn_rcpf(1.f + __builtin_amdgcn_exp2f(-LOG2E * x)); }
__device__ __forceinline__ float gelu_fast(float x) { const float z2 = 1.5957691216057308f * (x + 0.044715f * x * x * x); return x * sigmoid_fast(z2); }

constexpr size_t MiB = 1u << 20;
constexpr size_t WS_CTL = 0, CTL_ZERO_BYTES = 1 * MiB;
constexpr size_t WS_WIN = 1 * MiB, WS_WMIX = 10 * MiB, WS_WOUT = 12 * MiB, WS_WGU = 14 * MiB, WS_WD = 78 * MiB;
constexpr size_t WS_XN = 110 * MiB, WS_Q = 142 * MiB, WS_K = 158 * MiB, WS_V = 174 * MiB, WS_XR = 190 * MiB, WS_GY = 206 * MiB, WS_AL = 222 * MiB;
constexpr size_t WS_PG = 110 * MiB, WS_QG = 126 * MiB;
constexpr size_t WS_MERGED = 142 * MiB;
constexpr size_t WS_XS = 110 * MiB, WS_HB = 190 * MiB, WS_YB = 110 * MiB;
constexpr size_t WS_MISC = 254 * MiB;
constexpr size_t WS_END = 256 * MiB;
constexpr int CW_QKMAX = 64;
constexpr int CW_CNT = 128;
constexpr int CW_BAR = 4096;
namespace pg8 {
#define PG8_LAS __attribute__((address_space(3)))
typedef unsigned short bf16_t;
typedef short bf16x8 __attribute__((ext_vector_type(8)));
typedef float f32x4 __attribute__((ext_vector_type(4)));
typedef unsigned u32x4 __attribute__((ext_vector_type(4)));
constexpr int BM = 256, BK = 64, HALF = 128, HTB = HALF * BK * 2  , STAGE_BYTES = 8 * HTB, NXCD = 8, WGM = 8;

__host__ __device__ __forceinline__ int lds_byte(int r, int c) { const int st = (r >> 4) * 2 + (c >> 5), rr = r & 15, cc = c & 31, ob = rr * 64 + cc * 2; return st * 1024 + (ob ^ (((ob >> 9) & 1) << 5)); }
__host__ __device__ __forceinline__ void stage_rc(int b, int& R, int& C) { const int st = b / 1024, sb = b % 1024, swz = sb ^ (((sb >> 9) & 1) << 5); R = (st >> 1) * 16 + swz / 64; C = (st & 1) * 32 + (swz % 64) / 2; }
__host__ __device__ __forceinline__ int perm32(int rho) { const int n = rho >> 4, i = rho & 15; return 8 * (i >> 2) + 4 * n + (i & 3); }

struct Unit { int pm, pn, bt; };
struct Gemm { const bf16_t* A; const bf16_t* Bt; int M, N, K; };

struct StaticOrder {
    int nM, nN, nwg, G, c;
    __host__ __device__ void init(int M, int N, int G_, int c_) { nM = M / BM; nN = N / BM; nwg = nM * nN; G = G_; c = c_; }
    __host__ __device__ bool next(int i, Unit& u) const {
        const long L = (long)i * G + c; if (L >= nwg) return false;
        int wgid = (int)L; { const int q = nwg / NXCD, r = nwg % NXCD, xcd = wgid % NXCD, off = wgid / NXCD; wgid = (xcd < r ? xcd * (q + 1) : r * (q + 1) + (xcd - r) * q) + off; }
        const int nig = WGM * nN, gid = wgid / nig, fm = gid * WGM, gsz = (nM - fm) < WGM ? (nM - fm) : WGM;
        u.pm = fm + ((wgid % nig) % gsz); u.pn = (wgid % nig) / gsz; u.bt = u.pn; return true;
    }
    __device__ __forceinline__ void a_ready(const Unit&) const {}
    __device__ __forceinline__ void done(const Unit&) const {}
};

typedef float f32x2 __attribute__((ext_vector_type(2))); typedef __bf16 bf16x2_t __attribute__((ext_vector_type(2)));
__device__ __forceinline__ unsigned cvt_pk_bf16(float lo, float hi) { const f32x2 v = {lo, hi}; const bf16x2_t b = __builtin_convertvector(v, bf16x2_t); return __builtin_bit_cast(unsigned, b); }
struct EpiInProj {
    static constexpr bool PERM = true, AFTER_DRAIN = false, HAS_MID = false;
#ifdef NO_NORMS
    static constexpr bool NORMS = false;
#else
    static constexpr bool NORMS = true;
#endif
    bf16_t *Q, *K, *V, *XR, *GY, *GATES; unsigned* qkmax;
    template <int CAT> __device__ __forceinline__ void run(const f32x4 (&acc)[2][2][4][2], bf16_t* base, int ldc, int row0, int col0, unsigned* mx) const {
        float nrm = 0.f;
#pragma unroll
        for (int ai = 0; ai < 2; ++ai)
#pragma unroll
            for (int m = 0; m < 4; ++m) { bf16_t* rowp = base + (size_t)(row0 + ai * HALF + m * 16) * ldc + col0; float ss = 0.f;
#pragma unroll
                for (int bj = 0; bj < 2; ++bj) { f32x4 v0 = acc[ai][bj][m][0], v1 = acc[ai][bj][m][1];
                    if (CAT == 0) { v0 = v0 * C2; v1 = v1 * C2; }
                    if (CAT == 4) {
#pragma unroll
                        for (int j = 0; j < 4; ++j) { v0[j] = gelu_fast(v0[j]); v1[j] = gelu_fast(v1[j]); } }
                    if (CAT == 5) {
#pragma unroll
                        for (int j = 0; j < 4; ++j) { v0[j] = sigmoid_fast(v0[j]); v1[j] = sigmoid_fast(v1[j]); } }
                    if (NORMS && CAT <= 1) ss += (v0[0] * v0[0] + v0[1] * v0[1]) + (v0[2] * v0[2] + v0[3] * v0[3]) + (v1[0] * v1[0] + v1[1] * v1[1]) + (v1[2] * v1[2] + v1[3] * v1[3]);
                    u32x4 w; w.x = cvt_pk_bf16(v0[0], v0[1]); w.y = cvt_pk_bf16(v0[2], v0[3]); w.z = cvt_pk_bf16(v1[0], v1[1]); w.w = cvt_pk_bf16(v1[2], v1[3]);
                    *(u32x4*)(rowp + bj * 32) = w; }
                if (NORMS && CAT <= 1) { ss += __shfl_xor(ss, 16); ss += __shfl_xor(ss, 32); nrm = fmaxf(nrm, ss); } }
        if (NORMS && CAT <= 1) {
#pragma unroll
            for (int o = 1; o < 16; o <<= 1) nrm = fmaxf(nrm, __shfl_xor(nrm, o));
            if ((threadIdx.x & 63) == 0) atomicMax(mx, __builtin_bit_cast(unsigned, nrm * 1.02f)); }
    }
    __device__ __forceinline__ void operator()(const f32x4 (&acc)[2][2][4][2], const Unit& u, int wr, int wc, int fr, int fq) const {
        const int pn = u.pn, row0 = u.pm * BM + wr * 64 + fr, cw = wc * 64 + 8 * fq, b = u.pm >> 5;
        if (pn < 2)       run<0>(acc, Q, 512, row0, pn * 256 + cw, qkmax + b * 16 + 0 + (pn & 1) * 4 + wc);
        else if (pn < 4)  run<1>(acc, K, 512, row0, (pn - 2) * 256 + cw, qkmax + b * 16 + 8 + (pn & 1) * 4 + wc);
        else if (pn < 6)  run<2>(acc, V, 512, row0, (pn - 4) * 256 + cw, nullptr);
        else if (pn < 8)  run<3>(acc, XR, 512, row0, (pn - 6) * 256 + cw, nullptr);
        else if (pn < 10) run<4>(acc, GY, 512, row0, (pn - 8) * 256 + cw, nullptr);
        else              run<5>(acc, GATES, 2048, row0, (pn - 10) * 256 + cw, nullptr);
    }
};
struct EpiMix {
    static constexpr bool PERM = true, AFTER_DRAIN = false, HAS_MID = true;
    const bf16_t* GATES; bf16_t* OUT;
    __device__ __forceinline__ void mid(f32x4 (&acc)[2][2][4][2], const Unit& u, int wr, int wc, int fr, int fq) const {
        int row0 = u.pm * BM + wr * 64 + fr; const int col0 = u.pn * BM + wc * 32 + 8 * fq;
        asm volatile("" : "+v"(row0));
#pragma unroll
        for (int ai = 0; ai < 2; ++ai)
#pragma unroll
            for (int m = 0; m < 4; ++m) { const bf16_t* gp = GATES + (size_t)(row0 + ai * HALF + m * 16) * 2048 + col0;
#pragma unroll
                for (int bj = 0; bj < 2; ++bj) { const u32x4 ga = *(const u32x4*)(gp + bj * HALF), gl = *(const u32x4*)(gp + 1024 + bj * HALF);
#pragma unroll
                    for (int e = 0; e < 4; ++e) { const float a0 = __builtin_bit_cast(float, ga[e] << 16), a1 = __builtin_bit_cast(float, ga[e] & 0xffff0000u);
                        const float l0 = __builtin_bit_cast(float, gl[e] << 16), l1 = __builtin_bit_cast(float, gl[e] & 0xffff0000u);
                        acc[ai][bj][m][e >> 1][(e & 1) * 2] *= a0 * __builtin_amdgcn_rcpf(l0); acc[ai][bj][m][e >> 1][(e & 1) * 2 + 1] *= a1 * __builtin_amdgcn_rcpf(l1); } }
                asm volatile("" ::: "memory"); }
    }
    __device__ __forceinline__ void operator()(const f32x4 (&acc)[2][2][4][2], const Unit& u, int wr, int wc, int fr, int fq) const {
        const int row0 = u.pm * BM + wr * 64 + fr, col0 = u.pn * BM + wc * 32 + 8 * fq;
#pragma unroll
        for (int ai = 0; ai < 2; ++ai)
#pragma unroll
            for (int m = 0; m < 4; ++m) { const size_t r = (size_t)(row0 + ai * HALF + m * 16);
#pragma unroll
                for (int bj = 0; bj < 2; ++bj) { const u32x4 gl = *(const u32x4*)(GATES + r * 2048 + 1024 + col0 + bj * HALF);
                    const f32x4 v0 = acc[ai][bj][m][0], v1 = acc[ai][bj][m][1]; u32x4 w;
                    w.x = cvt_pk_bf16(v0[0] * __builtin_bit_cast(float, gl[0] << 16), v0[1] * __builtin_bit_cast(float, gl[0] & 0xffff0000u));
                    w.y = cvt_pk_bf16(v0[2] * __builtin_bit_cast(float, gl[1] << 16), v0[3] * __builtin_bit_cast(float, gl[1] & 0xffff0000u));
                    w.z = cvt_pk_bf16(v1[0] * __builtin_bit_cast(float, gl[2] << 16), v1[1] * __builtin_bit_cast(float, gl[2] & 0xffff0000u));
                    w.w = cvt_pk_bf16(v1[2] * __builtin_bit_cast(float, gl[3] << 16), v1[3] * __builtin_bit_cast(float, gl[3] & 0xffff0000u));
                    *(u32x4*)(OUT + r * 1024 + col0 + bj * HALF) = w; }
                asm volatile("" ::: "memory"); }
    }
};
struct EpiResidF32 {
    static constexpr bool PERM = false, AFTER_DRAIN = false, HAS_MID = false;
    const float* base; float* out;
    __device__ __forceinline__ void operator()(const f32x4 (&acc)[2][2][4][2], const Unit& u, int wr, int wc, int fr, int fq) const {
        const int row0 = u.pm * BM + wr * 64 + fr, col0 = u.pn * BM + wc * 32 + 4 * fq;
#pragma unroll
        for (int ai = 0; ai < 2; ++ai)
#pragma unroll
            for (int m = 0; m < 4; ++m) { const size_t off = (size_t)(row0 + ai * HALF + m * 16) * 1024 + col0;
#pragma unroll
                for (int bj = 0; bj < 2; ++bj)
#pragma unroll
                    for (int n = 0; n < 2; ++n) *(f32x4*)(out + off + bj * HALF + n * 16) = *(const f32x4*)(base + off + bj * HALF + n * 16) + acc[ai][bj][m][n];
                asm volatile("" ::: "memory"); }
    }
};
struct MoeOrder {
    const PG8_LAS int* pad; int nunits, G, c;
    __device__ __forceinline__ void init(const PG8_LAS int* pad_, int G_, int c_) { pad = pad_; nunits = (pad_[32] >> 8) * 4; G = G_; c = c_; }
    __device__ __forceinline__ bool next(int i, Unit& u) const {
        const int L = i * G + c; if (L >= nunits) return false;
        const int tile = L >> 2, pn = L & 3, slot = tile << 8; int e = 0;
        for (int j = 1; j < 32; ++j) e += (pad[j] <= slot) ? 1 : 0;
        u.pm = tile; u.pn = pn; u.bt = e * 4 + pn; return true;
    }
    __device__ __forceinline__ void a_ready(const Unit&) const {}
    __device__ __forceinline__ void done(const Unit&) const {}
};
struct EpiSwiGLU {
    static constexpr bool PERM = true, AFTER_DRAIN = false, HAS_MID = false;
    bf16_t* H;
    __device__ __forceinline__ void operator()(const f32x4 (&acc)[2][2][4][2], const Unit& u, int wr, int wc, int fr, int fq) const {
        const int row0 = u.pm * BM + wr * 64 + fr, col0 = u.pn * HALF + wc * 32 + 8 * fq;
#pragma unroll
        for (int ai = 0; ai < 2; ++ai)
#pragma unroll
            for (int m = 0; m < 4; ++m) { float h[8];
#pragma unroll
                for (int n = 0; n < 2; ++n)
#pragma unroll
                    for (int e = 0; e < 4; ++e) { const float g = acc[ai][0][m][n][e], up = acc[ai][1][m][n][e]; h[n * 4 + e] = g * sigmoid_fast(g) * up; }
                u32x4 w; w.x = cvt_pk_bf16(h[0], h[1]); w.y = cvt_pk_bf16(h[2], h[3]); w.z = cvt_pk_bf16(h[4], h[5]); w.w = cvt_pk_bf16(h[6], h[7]);
                *(u32x4*)(H + (size_t)(row0 + ai * HALF + m * 16) * 512 + col0) = w; }
    }
};
struct EpiStoreBf16 {
    static constexpr bool PERM = true, AFTER_DRAIN = false, HAS_MID = false;
    bf16_t* O; int ldc;
    __device__ __forceinline__ void operator()(const f32x4 (&acc)[2][2][4][2], const Unit& u, int wr, int wc, int fr, int fq) const {
        const int row0 = u.pm * BM + wr * 64 + fr, col0 = u.pn * BM + wc * 32 + 8 * fq;
#pragma unroll
        for (int ai = 0; ai < 2; ++ai)
#pragma unroll
            for (int m = 0; m < 4; ++m) { bf16_t* rowp = O + (size_t)(row0 + ai * HALF + m * 16) * ldc + col0;
#pragma unroll
                for (int bj = 0; bj < 2; ++bj) { const f32x4 v0 = acc[ai][bj][m][0], v1 = acc[ai][bj][m][1]; u32x4 w;
                    w.x = cvt_pk_bf16(v0[0], v0[1]); w.y = cvt_pk_bf16(v0[2], v0[3]); w.z = cvt_pk_bf16(v1[0], v1[1]); w.w = cvt_pk_bf16(v1[2], v1[3]);
                    *(u32x4*)(rowp + bj * HALF) = w; } }
    }
};
template <class Epi, class Sched, bool ALIGN_EPI = false, bool SP2 = false>
__device__ __forceinline__ void gemm_phase(PG8_LAS unsigned char* lds, const Gemm g, const Sched& S, const Epi& E) {
    int tid_ = threadIdx.x; asm volatile("" : "+v"(tid_));
    const int tid = tid_, wid = __builtin_amdgcn_readfirstlane(tid >> 6), lane = tid & 63, wr = wid >> 2, wc = wid & 3, fr = lane & 15, fq = lane >> 4;
    const int K = g.K, nt = K / BK;
    unsigned voffA[2], voffB[2];
#pragma unroll
    for (int i = 0; i < 2; ++i) { int R, C; stage_rc(tid * 16 + i * 8192, R, C); const int Rb = Epi::PERM ? ((R & ~31) + perm32(R & 31)) : R;
        voffA[i] = (unsigned)(R * K + C) * 2u; voffB[i] = (unsigned)(Rb * K + C) * 2u; }
    const size_t kstep = (size_t)(BK * 2);
    const size_t hstep = (size_t)HALF * K * 2;
    const size_t tstep = 2 * hstep;
    const unsigned ldsw = (unsigned)wid * 1024u;
    const int aoff = lds_byte(wr * 64 + fr, fq * 8), boff = lds_byte(wc * 32 + fr, fq * 8);
#define PG8_SA(b, h) (((b) * 2 + (h)) * HTB)
#define PG8_SB(b, h) ((4 + (b) * 2 + (h)) * HTB)
#define PG8_STAGE(bufoff, gbase, voff) do { _Pragma("unroll") for (int _i = 0; _i < 2; ++_i) \
        __builtin_amdgcn_global_load_lds((const unsigned*)((const char*)(gbase) + (voff)[_i]), (PG8_LAS unsigned*)(lds + (bufoff) + ldsw + _i * 8192), 16, 0, 0); } while (0)
#define PG8_LDA(dst, b, h) do { _Pragma("unroll") for (int m = 0; m < 4; ++m) _Pragma("unroll") for (int k = 0; k < 2; ++k) dst[m][k] = *(const PG8_LAS bf16x8*)(lds + PG8_SA(b, h) + aoff + m * 2048 + k * 1024); } while (0)
#define PG8_LDB(dst, b, h) do { _Pragma("unroll") for (int n = 0; n < 2; ++n) _Pragma("unroll") for (int k = 0; k < 2; ++k) dst[n][k] = *(const PG8_LAS bf16x8*)(lds + PG8_SB(b, h) + boff + n * 2048 + k * 1024); } while (0)
#define PG8_MMA(ai, bj, At, Bt) do { __builtin_amdgcn_s_setprio(1); _Pragma("unroll") for (int m = 0; m < 4; ++m) _Pragma("unroll") for (int n = 0; n < 2; ++n) _Pragma("unroll") for (int k = 0; k < 2; ++k) \
        acc[ai][bj][m][n] = __builtin_amdgcn_mfma_f32_16x16x32_bf16(Bt[n][k], At[m][k], acc[ai][bj][m][n], 0, 0, 0); __builtin_amdgcn_s_setprio(0); } while (0)
#define PG8_WAIT_V(n) asm volatile("s_waitcnt vmcnt(" #n ")" ::: "memory")
#define PG8_WAIT_L(n) asm volatile("s_waitcnt lgkmcnt(" #n ")" ::: "memory")
#define PG8_BAR __builtin_amdgcn_s_barrier()
#define PG8_SCHED __builtin_amdgcn_sched_barrier(0)
    Unit cur, nxt; int ui = 0;
    if (!S.next(0, cur)) return;
    f32x4 acc[2][2][4][2];
#pragma unroll
    for (int a = 0; a < 2; ++a)
#pragma unroll
        for (int b = 0; b < 2; ++b)
#pragma unroll
            for (int m = 0; m < 4; ++m)
#pragma unroll
                for (int n = 0; n < 2; ++n) acc[a][b][m][n] = (f32x4){0.f, 0.f, 0.f, 0.f};
    bf16x8 At[4][2], B0[2][2], B1[2][2];
    const char* cA = (const char*)g.A + (size_t)cur.pm * tstep; const char* cB = (const char*)g.Bt + (size_t)cur.bt * tstep;
    S.a_ready(cur);
    if constexpr (SP2) {
        PG8_STAGE(PG8_SB(0, 0), cB, voffB); PG8_STAGE(PG8_SB(0, 1), cB + hstep, voffB); PG8_STAGE(PG8_SA(0, 0), cA, voffA); PG8_STAGE(PG8_SA(0, 1), cA + hstep, voffA);
        if (wr == 1) PG8_BAR;
        PG8_WAIT_V(2); PG8_BAR;
        PG8_STAGE(PG8_SB(1, 0), cB + kstep, voffB); PG8_STAGE(PG8_SA(1, 0), cA + kstep, voffA); PG8_STAGE(PG8_SB(1, 1), cB + hstep + kstep, voffB);
        PG8_WAIT_V(6); PG8_BAR;
    } else {
        PG8_STAGE(PG8_SB(0, 0), cB, voffB); PG8_STAGE(PG8_SA(0, 0), cA, voffA); PG8_STAGE(PG8_SB(0, 1), cB + hstep, voffB); PG8_STAGE(PG8_SA(0, 1), cA + hstep, voffA);
        if (wr == 1) PG8_BAR;
        PG8_WAIT_V(4); PG8_BAR;
        PG8_STAGE(PG8_SB(1, 0), cB + kstep, voffB); PG8_STAGE(PG8_SA(1, 0), cA + kstep, voffA); PG8_STAGE(PG8_SB(1, 1), cB + hstep + kstep, voffB);
        PG8_WAIT_V(6); PG8_BAR;
    }
    for (;;) {
        const bool has_next = S.next(ui + 1, nxt);
        const char* nA = has_next ? (const char*)g.A + (size_t)nxt.pm * tstep : cA; const char* nB = has_next ? (const char*)g.Bt + (size_t)nxt.bt * tstep : cB;
        for (int t = 0; t < nt; t += 2) {
            const bool last = (t == nt - 2);
            if constexpr (Epi::HAS_MID) { if (t == (nt >> 1)) E.mid(acc, cur, wr, wc, fr, fq); }
            const char* a1 = cA + (size_t)(t + 1) * kstep;
            const char* a2 = last ? nA : cA + (size_t)(t + 2) * kstep; const char* b2 = last ? nB : cB + (size_t)(t + 2) * kstep;
            const char* a3 = a2 + kstep; const char* b3 = b2 + kstep;
            if (last && has_next) S.a_ready(nxt);
            if constexpr (SP2) {
            PG8_LDB(B0, 0, 0); PG8_LDB(B1, 0, 1); PG8_SCHED; PG8_LDA(At, 0, 0); PG8_STAGE(PG8_SA(1, 1), a1 + hstep, voffA);
            PG8_WAIT_V(8); PG8_WAIT_L(0); PG8_BAR; PG8_MMA(0, 0, At, B0); PG8_MMA(0, 1, At, B1); PG8_BAR; PG8_SCHED;
            PG8_LDA(At, 0, 1); PG8_STAGE(PG8_SB(0, 0), b2, voffB); PG8_STAGE(PG8_SB(0, 1), b2 + hstep, voffB); PG8_STAGE(PG8_SA(0, 0), a2, voffA);
            PG8_WAIT_V(8); PG8_WAIT_L(0); PG8_BAR; PG8_MMA(1, 0, At, B0); PG8_MMA(1, 1, At, B1); PG8_BAR; PG8_SCHED;
            PG8_LDB(B0, 1, 0); PG8_LDB(B1, 1, 1); PG8_SCHED; PG8_LDA(At, 1, 0); PG8_STAGE(PG8_SA(0, 1), a2 + hstep, voffA);
            PG8_WAIT_V(8); PG8_WAIT_L(0); PG8_BAR; PG8_MMA(0, 0, At, B0); PG8_MMA(0, 1, At, B1); PG8_BAR; PG8_SCHED;
            PG8_LDA(At, 1, 1); PG8_STAGE(PG8_SB(1, 0), b3, voffB); PG8_STAGE(PG8_SB(1, 1), b3 + hstep, voffB); PG8_STAGE(PG8_SA(1, 0), a3, voffA);
            PG8_WAIT_V(8); PG8_WAIT_L(0); PG8_BAR; PG8_MMA(1, 0, At, B0); PG8_MMA(1, 1, At, B1); PG8_BAR; PG8_SCHED;
            } else {
            PG8_LDB(B0, 0, 0); PG8_SCHED; PG8_LDA(At, 0, 0); PG8_STAGE(PG8_SA(1, 1), a1 + hstep, voffA);
            PG8_WAIT_L(8); PG8_BAR; PG8_WAIT_L(0); PG8_MMA(0, 0, At, B0); PG8_BAR; PG8_SCHED;
            PG8_LDB(B1, 0, 1); PG8_STAGE(PG8_SB(0, 0), b2, voffB);
            PG8_BAR; PG8_WAIT_L(0); PG8_MMA(0, 1, At, B1); PG8_BAR;
            PG8_LDA(At, 0, 1); PG8_STAGE(PG8_SA(0, 0), a2, voffA);
            PG8_BAR; PG8_WAIT_L(0); PG8_MMA(1, 0, At, B0); PG8_BAR; PG8_SCHED;
            PG8_STAGE(PG8_SB(0, 1), b2 + hstep, voffB);
            PG8_WAIT_V(6); PG8_BAR; PG8_MMA(1, 1, At, B1); PG8_BAR;
            PG8_LDB(B0, 1, 0); PG8_SCHED; PG8_LDA(At, 1, 0); PG8_STAGE(PG8_SA(0, 1), a2 + hstep, voffA);
            PG8_WAIT_L(8); PG8_BAR; PG8_WAIT_L(0); PG8_MMA(0, 0, At, B0); PG8_BAR; PG8_SCHED;
            PG8_LDB(B1, 1, 1); PG8_STAGE(PG8_SB(1, 0), b3, voffB);
            PG8_BAR; PG8_WAIT_L(0); PG8_MMA(0, 1, At, B1); PG8_BAR;
            PG8_LDA(At, 1, 1); PG8_STAGE(PG8_SA(1, 0), a3, voffA);
            PG8_BAR; PG8_WAIT_L(0); PG8_MMA(1, 0, At, B0); PG8_BAR; PG8_SCHED;
            PG8_STAGE(PG8_SB(1, 1), b3 + hstep, voffB);
            PG8_WAIT_V(6); PG8_BAR; PG8_MMA(1, 1, At, B1); PG8_BAR;
            }
        }
        if constexpr (ALIGN_EPI) { if (wr == 0) PG8_BAR; }
        if constexpr (!Epi::AFTER_DRAIN) { E(acc, cur, wr, wc, fr, fq); S.done(cur); }
        if (!has_next) break;
#pragma unroll
        for (int a = 0; a < 2; ++a)
#pragma unroll
            for (int b = 0; b < 2; ++b)
#pragma unroll
                for (int m = 0; m < 4; ++m)
#pragma unroll
                    for (int n = 0; n < 2; ++n) acc[a][b][m][n] = (f32x4){0.f, 0.f, 0.f, 0.f};
        cur = nxt; cA = nA; cB = nB; ++ui;
        if constexpr (ALIGN_EPI) { if (wr == 1) PG8_BAR; }
    }
    PG8_WAIT_V(0);
    if constexpr (!ALIGN_EPI) { if (wr == 0) PG8_BAR; }
    PG8_BAR;
    if constexpr (Epi::AFTER_DRAIN) { E.fused(acc, cur, wr, wc, fr, fq, lds, wid, lane); S.done(cur); }
#undef PG8_SA
#undef PG8_SB
#undef PG8_STAGE
#undef PG8_LDA
#undef PG8_LDB
#undef PG8_MMA
#undef PG8_WAIT_V
#undef PG8_WAIT_L
#undef PG8_BAR
#undef PG8_SCHED
}
}
#define GAS __attribute__((address_space(1)))
#define LAS __attribute__((address_space(3)))
typedef unsigned v4u __attribute__((ext_vector_type(4)));
typedef float f32x4 __attribute__((ext_vector_type(4)));
typedef short bf16x8 __attribute__((ext_vector_type(8)));
typedef GAS unsigned gu32;
typedef GAS unsigned long long gu64;
#define RLX_AGENT __ATOMIC_RELAXED, __HIP_MEMORY_SCOPE_AGENT
#define LDS_WAIT() asm volatile("s_waitcnt lgkmcnt(0)" ::: "memory")
#define VM_WAIT() asm volatile("s_waitcnt vmcnt(0)" ::: "memory")
#define XB_TMO      128
#define XB_XCNT(j)  (256  + 64 * (j))
#define XB_XSUB(j)  (1280 + 64 * (j))
#define XB_XGEN(j)  (2304 + 64 * (j))
#define XB_TOP      3328
#define XB_TOPGEN   3392
#define XCD_BAR_WORDS 3456
#define XB_SPIN_CAP (1u << 18)

__device__ __forceinline__ unsigned xb_ld(unsigned* p)              { return __hip_atomic_load(p, __ATOMIC_RELAXED, __HIP_MEMORY_SCOPE_AGENT); }
__device__ __forceinline__ unsigned xb_add(unsigned* p, unsigned v) { return __hip_atomic_fetch_add(p, v, __ATOMIC_RELAXED, __HIP_MEMORY_SCOPE_AGENT); }
__device__ __forceinline__ unsigned xb_xcc_id() { return (unsigned)__builtin_amdgcn_s_getreg((3 << 11) | 20) & 0xFu; }
#define XB_SPIN(cond, bar) do { unsigned _sp = 0; while (cond) { __builtin_amdgcn_s_sleep(1); \
    if ((++_sp & 255u) == 0u) { if (xb_ld(&(bar)[XB_TMO])) break; if (_sp > XB_SPIN_CAP) { atomicAdd(&(bar)[XB_TMO], 1u); break; } } } } while (0)

struct XcdBarrier {
    unsigned* bar; unsigned x;
    volatile LAS unsigned* st;
};

__device__ __forceinline__ XcdBarrier xcd_barrier_post(unsigned* bar, volatile LAS unsigned* st) {
    XcdBarrier b; b.bar = bar; b.x = xb_xcc_id(); b.st = st;
    if (threadIdx.x == 0) (void)xb_add(&bar[XB_XCNT(b.x)], 1u);
    return b;
}
__device__ __forceinline__ void xcd_barrier_complete(unsigned* bar, unsigned x, unsigned& nloc, unsigned& nx) {
    const unsigned G = gridDim.x * gridDim.y * gridDim.z;
    unsigned sum, cnt, mine, sp = 0u;
    for (;;) {
        sum = 0u; cnt = 0u; mine = 0u;
#pragma unroll
        for (unsigned j = 0; j < 16; ++j) { const unsigned c = xb_ld(&bar[XB_XCNT(j)]); sum += c; cnt += (c > 0u) ? 1u : 0u; mine = (j == x) ? c : mine; }
        if (sum == G) break;
        __builtin_amdgcn_s_sleep(1);
        if ((++sp & 255u) == 0u) { if (xb_ld(&bar[XB_TMO])) break; if (sp > XB_SPIN_CAP) { atomicAdd(&bar[XB_TMO], 1u); break; } }
    }
    nloc = mine > 0u ? mine : 1u; nx = cnt > 0u ? cnt : 1u;
}

__device__ __forceinline__ void xcd_barrier(const XcdBarrier& b) {
    asm volatile("s_waitcnt vmcnt(0)" ::: "memory");
    __syncthreads();
    if (threadIdx.x == 0) {
        unsigned* bar = b.bar;
        __builtin_amdgcn_s_waitcnt(0);
        unsigned nloc = b.st[0], nx = b.st[1];
        if (nloc == 0u) { xcd_barrier_complete(bar, b.x, nloc, nx); b.st[0] = nloc; b.st[1] = nx; }
        const unsigned old = xb_add(&bar[XB_XSUB(b.x)], 1u);
        const unsigned gen = old / nloc;
        if (old + 1u == (gen + 1u) * nloc) {
            __builtin_amdgcn_fence(__ATOMIC_RELEASE, "agent");
            asm volatile("s_waitcnt vmcnt(0)" ::: "memory");
            const unsigned og = xb_add(&bar[XB_TOP], 1u);
            const unsigned tg = og / nx;
            if (og + 1u == (tg + 1u) * nx) xb_add(&bar[XB_TOPGEN], 1u);
            else XB_SPIN(xb_ld(&bar[XB_TOPGEN]) == tg, bar);
            __builtin_amdgcn_fence(__ATOMIC_ACQUIRE, "agent");
            xb_add(&bar[XB_XGEN(b.x)], 1u);
            asm volatile("s_waitcnt vmcnt(0)" ::: "memory");
        } else {
            XB_SPIN(xb_ld(&bar[XB_XGEN(b.x)]) == gen, bar);
            __builtin_amdgcn_fence(__ATOMIC_ACQUIRE, "agent");
            asm volatile("s_waitcnt vmcnt(0)" ::: "memory");
        }
    }
    __syncthreads();
}

constexpr int NWAVES = 8;
constexpr int RING_OFF = 0, RING_BYTES = 131072;
constexpr int SCR_BYTES = 147456;
constexpr int LDSCTL_OFF = SCR_BYTES, MISC_OFF = LDSCTL_OFF + 320;
constexpr int LDS_BYTES = SCR_BYTES + 4096;
static_assert(MISC_OFF + 128 <= LDS_BYTES && LDS_BYTES <= 163840, "LDS map");

struct Frame {
    LAS unsigned char* lds;
    volatile LAS unsigned* MISC;
    gu32* ctl;
    int tid, lane, wave, vcu, G;
    const float* in[22]; float* out; unsigned char* ws;
};
__device__ __forceinline__ float wave_sum(float v) {
#pragma unroll
    for (int o = 1; o < 64; o <<= 1) v += __shfl_xor(v, o);
    return v;
}

__device__ __forceinline__ void p0_tr64(const float* W, int ldn, int k0, int n0, bf16* dst, int ldk, LAS float* scr, int lane) {
    const int lr = lane >> 4, lc = (lane & 15) * 4;
#pragma unroll 4
    for (int i = 0; i < 16; ++i) { const int kk = 4 * i + lr; const f32x4 v = *(const GAS f32x4*)(W + (size_t)(k0 + kk) * ldn + n0 + lc);
        LAS float* s = scr + kk * 65 + lc; s[0] = v[0]; s[1] = v[1]; s[2] = v[2]; s[3] = v[3]; }
    LDS_WAIT(); asm volatile("" ::: "memory");
    const int c = lane & 7;
#pragma unroll
    for (int j = 0; j < 8; ++j) { const int n = (lane >> 3) + 8 * j; const LAS float* s = scr + (8 * c) * 65 + n;
        v4u o; o.x = pk2(s[0 * 65], s[1 * 65]); o.y = pk2(s[2 * 65], s[3 * 65]); o.z = pk2(s[4 * 65], s[5 * 65]); o.w = pk2(s[6 * 65], s[7 * 65]);
        *(GAS v4u*)(dst + (size_t)n * ldk + 8 * c) = o; }
    LDS_WAIT(); asm volatile("" ::: "memory");
}
__device__ __forceinline__ int incol_row(int c) { const int w = c & 255; return (c & ~255) + ((w >> 5) & 1) * 128 + (w >> 6) * 32 + (w & 31); }

__device__ __forceinline__ void p0_prologue(Frame& F) {
    LAS float* scr = (LAS float*)(F.lds + F.wave * 16640);
    const int gw = F.vcu * NWAVES + F.wave, NGW = F.G * NWAVES, lane = F.lane;
    bf16* Wt_in = (bf16*)(F.ws + WS_WIN); bf16* Wt_mix = (bf16*)(F.ws + WS_WMIX); bf16* Wt_out = (bf16*)(F.ws + WS_WOUT); bf16* Wt_gu = (bf16*)(F.ws + WS_WGU); bf16* Wt_d = (bf16*)(F.ws + WS_WD);
    constexpr int I_IN = 16 * 72, I_OA = 8 * 16, I_OL = 8 * 16, I_OUT = 16 * 16, I_G = 32 * 16 * 8, I_U = I_G, I_D = 32 * 8 * 16;
    constexpr int NITEMS = I_IN + I_OA + I_OL + I_OUT + I_G + I_U + I_D;
    for (int it = gw; it < NITEMS; it += NGW) {
        int r = it;
        if (r < I_IN) { const int kb = r / 72, nb = r % 72, n0 = nb * 64; const int w = n0 & 255;
            const int lr = lane >> 4, lc = (lane & 15) * 4; const float* W = F.in[2];
#pragma unroll 4
            for (int i = 0; i < 16; ++i) { const int kk = 4 * i + lr; const f32x4 v = *(const GAS f32x4*)(W + (size_t)(kb * 64 + kk) * INC + n0 + lc);
                LAS float* s = scr + kk * 65 + lc; s[0] = v[0]; s[1] = v[1]; s[2] = v[2]; s[3] = v[3]; }
            LDS_WAIT(); asm volatile("" ::: "memory");
            const int c = lane & 7;
#pragma unroll
            for (int j = 0; j < 8; ++j) { const int n = (lane >> 3) + 8 * j; const LAS float* s = scr + (8 * c) * 65 + n;
                v4u o; o.x = pk2(s[0 * 65], s[1 * 65]); o.y = pk2(s[2 * 65], s[3 * 65]); o.z = pk2(s[4 * 65], s[5 * 65]); o.w = pk2(s[6 * 65], s[7 * 65]);
                *(GAS v4u*)(Wt_in + (size_t)incol_row(n0 + n) * 1024 + kb * 64 + 8 * c) = o; }
            LDS_WAIT(); asm volatile("" ::: "memory"); (void)w;
            continue; } r -= I_IN;
        if (r < I_OA) { const int kb = r / 16, nb = r % 16; p0_tr64(F.in[12], 1024, kb * 64, nb * 64, Wt_mix + (size_t)(nb * 64) * 1024 + kb * 64, 1024, scr, lane); continue; } r -= I_OA;
        if (r < I_OL) { const int kb = r / 16, nb = r % 16; p0_tr64(F.in[13], 1024, kb * 64, nb * 64, Wt_mix + (size_t)(nb * 64) * 1024 + 512 + kb * 64, 1024, scr, lane); continue; } r -= I_OL;
        if (r < I_OUT) { const int kb = r / 16, nb = r % 16; p0_tr64(F.in[14], 1024, kb * 64, nb * 64, Wt_out + (size_t)(nb * 64) * 1024 + kb * 64, 1024, scr, lane); continue; } r -= I_OUT;
        if (r < I_G) { const int e = r / 128, q = r % 128, kb = q / 8, nb = q % 8, n0 = nb * 64;
            p0_tr64(F.in[18] + (size_t)e * 1024 * 512, 512, kb * 64, n0, Wt_gu + (size_t)(e * 1024 + (n0 >> 7) * 256 + (n0 & 127)) * 1024 + kb * 64, 1024, scr, lane); continue; } r -= I_G;
        if (r < I_U) { const int e = r / 128, q = r % 128, kb = q / 8, nb = q % 8, n0 = nb * 64;
            p0_tr64(F.in[19] + (size_t)e * 1024 * 512, 512, kb * 64, n0, Wt_gu + (size_t)(e * 1024 + (n0 >> 7) * 256 + 128 + (n0 & 127)) * 1024 + kb * 64, 1024, scr, lane); continue; } r -= I_U;
        { const int e = r / 128, q = r % 128, kb = q / 16, nb = q % 16;
            p0_tr64(F.in[20] + (size_t)e * 512 * 1024, 1024, kb * 64, nb * 64, Wt_d + (size_t)(e * 1024 + nb * 64) * 512 + kb * 64, 512, scr, lane); }
    }
    bf16* XN = (bf16*)(F.ws + WS_XN); const float* x = F.in[0]; const float* g = F.in[1];
    f32x4 gv[4];
#pragma unroll
    for (int j = 0; j < 4; ++j) gv[j] = ((const GAS f32x4*)g)[lane + 64 * j];
    for (int m = gw; m < NTOK; m += NGW) {
        const GAS f32x4* xr = (const GAS f32x4*)(x + (size_t)m * DM) + lane;
        f32x4 v[4]; float s = 0.f;
#pragma unroll
        for (int j = 0; j < 4; ++j) { v[j] = xr[64 * j]; s += (v[j].x * v[j].x + v[j].y * v[j].y) + (v[j].z * v[j].z + v[j].w * v[j].w); }
        const float rstd = rsqrtf(wave_sum(s) * (1.f / DM) + EPS);
        GAS unsigned long long* o8 = (GAS unsigned long long*)(XN + (size_t)m * DM) + lane;
#pragma unroll
        for (int j = 0; j < 4; ++j) o8[64 * j] = (unsigned long long)pk2(v[j].x * rstd * gv[j].x, v[j].y * rstd * gv[j].y) | ((unsigned long long)pk2(v[j].z * rstd * gv[j].z, v[j].w * rstd * gv[j].w) << 32);
    }
}

namespace att {
typedef float f32x16 __attribute__((ext_vector_type(16)));
typedef short s16x4 __attribute__((ext_vector_type(4)));
typedef short v4i16_t __attribute__((ext_vector_type(4)));
constexpr int KROW = 144;
constexpr int KT = 64 * KROW;
constexpr int STAGE = 2 * KT + 16384;
constexpr int VOFF = 2 * KT;
constexpr int XCH_BYTES = 4 * 64 * 64 * 4;
__device__ __forceinline__ int crow(int r, int hi) { return (r & 3) + 8 * (r >> 2) + 4 * hi; }
__device__ __forceinline__ s16x4 vtr(const LAS unsigned char* p) { return __builtin_bit_cast(s16x4, __builtin_amdgcn_ds_read_tr16_b64_v4i16((LAS v4i16_t*)p)); }

__device__ __forceinline__ void attn_unit(Frame& F, int b, int h, int qblk, float lam, int t_lo) {
    const int tid = F.tid, lane = F.lane, wid = F.wave, r32 = lane & 31, hi = lane >> 5;
    const int m = wid >> 2, j4 = wid & 3;
    const bf16* Qb = (const bf16*)(F.ws + WS_Q); const bf16* Kb = (const bf16*)(F.ws + WS_K); const bf16* Vb = (const bf16*)(F.ws + WS_V);
    bf16* AL = (bf16*)(F.ws + WS_AL);
    LAS unsigned char* lds = F.lds;
    const size_t rowbase = (size_t)b * SEQ;
    const int qpos = qblk * 128 + j4 * 32 + r32;
    const float slope2 = __builtin_amdgcn_exp2f(-2.f * (float)(h + 1)) * LOG2E;
    bf16x8 qr[4];
#pragma unroll
    for (int d0 = 0; d0 < 4; ++d0) qr[d0] = *(const GAS bf16x8*)(Qb + (rowbase + qpos) * 512 + h * 128 + m * 64 + d0 * 16 + hi * 8);
    const int krow = tid >> 3, kch = tid & 7;
    const bf16* ksrc0 = Kb + (rowbase + krow) * 512 + h * 128 + kch * 8;
    const int kdst = krow * KROW + kch * 16;
    const int vrow0 = tid >> 4, vch = tid & 15;
    const bf16* vsrc = Vb + (rowbase + vrow0) * 512 + h * 128 + vch * 8;
    const int vdst = VOFF + (vch >> 2) * 4096 + vrow0 * 64 + (vch & 3) * 16;
    v4u sk0, sk1, sv0, sv1;
#define ATT_LOAD(t) do { const size_t to_ = (size_t)(t) * 64 * 512; sk0 = *(const GAS v4u*)(ksrc0 + to_); sk1 = *(const GAS v4u*)(ksrc0 + to_ + 64); \
        sv0 = *(const GAS v4u*)(vsrc + to_); sv1 = *(const GAS v4u*)(vsrc + to_ + 32 * 512); } while (0)
#define ATT_WRITE(sb) do { LAS unsigned char* s_ = lds + (sb); *(LAS v4u*)(s_ + kdst) = sk0; *(LAS v4u*)(s_ + KT + kdst) = sk1; *(LAS v4u*)(s_ + vdst) = sv0; *(LAS v4u*)(s_ + vdst + 32 * 64) = sv1; } while (0)
    const int kfoff = m * KT + r32 * KROW + hi * 16;
    const int vfoff = VOFF + ((lane >> 4) & 1) * 32 + (lane & 3) * 8 + (4 * hi + ((lane & 15) >> 2)) * 64;
    f32x16 o[4];
#pragma unroll
    for (int vb = 0; vb < 4; ++vb)
#pragma unroll
        for (int r = 0; r < 16; ++r) o[vb][r] = 0.f;
    float mrun = -1e30f, lrun = 0.f;
    const int t_hi = 2 * qblk + 1;
    const int qmin = qblk * 128 + j4 * 32;
    ATT_LOAD(t_hi); ATT_WRITE(0);
    __syncthreads();
    int cur = 0;
    for (int t = t_hi; t >= t_lo; --t) {
        if (t > t_lo) ATT_LOAD(t - 1);
        const LAS unsigned char* sb = lds + cur * STAGE;
        if (64 * t <= qmin + 31) {
            f32x16 p0, p1;
#pragma unroll
            for (int r = 0; r < 16; ++r) { p0[r] = 0.f; p1[r] = 0.f; }
#pragma unroll
            for (int d0 = 0; d0 < 4; ++d0) {
                const bf16x8 k0 = *(const LAS bf16x8*)(sb + kfoff + d0 * 32);
                const bf16x8 k1 = *(const LAS bf16x8*)(sb + kfoff + 32 * KROW + d0 * 32);
                p0 = __builtin_amdgcn_mfma_f32_32x32x16_bf16(k0, qr[d0], p0, 0, 0, 0);
                p1 = __builtin_amdgcn_mfma_f32_32x32x16_bf16(k1, qr[d0], p1, 0, 0, 0);
            }
            const float bb = slope2 * (float)(64 * t + 4 * hi - qpos);
            const bool diag = (64 * t + 63 > qmin);
            float rm = -1e30f;
#pragma unroll
            for (int r = 0; r < 16; ++r) { const int kk = (r & 3) + 8 * (r >> 2);
                float x0 = p0[r] + (bb + slope2 * (float)kk), x1 = p1[r] + (bb + slope2 * (float)(kk + 32));
                if (diag) { const int key = 64 * t + 4 * hi + kk; if (key > qpos) x0 = -1e30f; if (key + 32 > qpos) x1 = -1e30f; }
                p0[r] = x0; p1[r] = x1; rm = fmaxf(rm, fmaxf(x0, x1)); }
            rm = fmaxf(rm, __shfl_xor(rm, 32));
            const float mnew = fmaxf(mrun, rm), alpha = __builtin_amdgcn_exp2f(mrun - mnew);
            mrun = mnew;
            float ls = 0.f;
#pragma unroll
            for (int r = 0; r < 16; ++r) { p0[r] = __builtin_amdgcn_exp2f(p0[r] - mnew); p1[r] = __builtin_amdgcn_exp2f(p1[r] - mnew); ls += p0[r] + p1[r]; }
            lrun = lrun * alpha + ls;
#pragma unroll
            for (int vb = 0; vb < 4; ++vb)
#pragma unroll
                for (int r = 0; r < 16; ++r) o[vb][r] *= alpha;
            bf16x8 pa[4];
#pragma unroll
            for (int s = 0; s < 4; ++s) { v4u w;
#pragma unroll
                for (int e = 0; e < 4; ++e) { const int r = 8 * (s & 1) + 2 * e; w[e] = (s < 2) ? pg8::cvt_pk_bf16(p0[r], p0[r + 1]) : pg8::cvt_pk_bf16(p1[r], p1[r + 1]); }
                pa[s] = __builtin_bit_cast(bf16x8, w); }
#pragma unroll
            for (int vb = 0; vb < 4; ++vb)
#pragma unroll
                for (int s = 0; s < 4; ++s) {
                    const s16x4 lo = vtr(sb + vfoff + vb * 4096 + s * 1024), hh = vtr(sb + vfoff + vb * 4096 + s * 1024 + 512);
                    const bf16x8 vf = (bf16x8){lo[0], lo[1], lo[2], lo[3], hh[0], hh[1], hh[2], hh[3]};
                    o[vb] = __builtin_amdgcn_mfma_f32_32x32x16_bf16(vf, pa[s], o[vb], 0, 0, 0);
                }
        }
        if (t > t_lo) ATT_WRITE((cur ^ 1) * STAGE);
        __syncthreads();
        cur ^= 1;
    }
#undef ATT_LOAD
#undef ATT_WRITE
    lrun += __shfl_xor(lrun, 32);
    const float inv = 1.f / lrun;
    LAS float* xch = (LAS float*)lds;
    if (m == 1) {
#pragma unroll
        for (int vb = 0; vb < 4; ++vb)
#pragma unroll
            for (int r = 0; r < 16; ++r) xch[(j4 * 64 + vb * 16 + r) * 64 + lane] = o[vb][r] * inv;
    }
    __syncthreads();
    if (m == 0) {
        float ss = 0.f;
#pragma unroll
        for (int vb = 0; vb < 4; ++vb)
#pragma unroll
            for (int r = 0; r < 16; ++r) { const float v = o[vb][r] * inv - lam * xch[(j4 * 64 + vb * 16 + r) * 64 + lane]; o[vb][r] = v; ss += v * v; }
        ss += __shfl_xor(ss, 32);
        const float rstd = rsqrtf(ss * (1.f / 128.f) + EPS) * 0.8f;
        const float* sg = F.in[4];
        bf16* orow = AL + (rowbase + qpos) * 1024 + h * 128;
#pragma unroll
        for (int vb = 0; vb < 4; ++vb)
#pragma unroll
            for (int g = 0; g < 4; ++g) { const int vd = vb * 32 + 8 * g + 4 * hi; const f32x4 gg = *(const GAS f32x4*)(sg + vd);
                const unsigned w0 = pk2(o[vb][4 * g] * rstd * gg[0], o[vb][4 * g + 1] * rstd * gg[1]), w1 = pk2(o[vb][4 * g + 2] * rstd * gg[2], o[vb][4 * g + 3] * rstd * gg[3]);
                *(GAS unsigned long long*)(orow + vd) = (unsigned long long)w0 | ((unsigned long long)w1 << 32); }
    }
    __syncthreads();
}

__device__ __forceinline__ void attn_phase(Frame& F) {
    const float* lp = F.in[3];
    float a = (F.lane < 64) ? lp[F.lane] * lp[64 + F.lane] : 0.f, c = lp[128 + F.lane] * lp[192 + F.lane];
    a = wave_sum(a); c = wave_sum(c);
    const float lam = __expf(a) - __expf(c) + 0.2f;
    const int bh = F.vcu >> 5, s = F.vcu & 31;
    if (F.G == 256) {
        attn_unit(F, bh >> 2, bh & 3, 63 - s, lam, 0);
        attn_unit(F, bh >> 2, bh & 3, s, lam, 0);
    } else {
        for (int u = F.vcu; u < 512; u += F.G) attn_unit(F, u >> 8, (u >> 6) & 3, u & 63, lam, 0);
    }
}
}

namespace lru {
typedef float f32x16 __attribute__((ext_vector_type(16)));
constexpr int ROWB = 144;
constexpr int L_WT = 0, L_XC = 128 * ROWB, L_PRE = 2 * 128 * ROWB, L_AGG = L_PRE + 128 * 128 * 4;
constexpr size_t AGG_OFF = WS_MISC;

__device__ __forceinline__ void l1_unit(Frame& F, int b, int n, int k) {
    const int tid = F.tid, lane = F.lane, wid = F.wave, r32 = lane & 31, hi = lane >> 5;
    LAS unsigned char* lds = F.lds;
    const bf16* XR = (const bf16*)(F.ws + WS_XR); const bf16* GY = (const bf16*)(F.ws + WS_GY);
    bf16* PG = (bf16*)(F.ws + WS_PG); bf16* QG = (bf16*)(F.ws + WS_QG); float* AGG = (float*)(F.ws + AGG_OFF);
    const size_t rowbase = (size_t)b * SEQ; const int p0 = k * 128;
    { const float* wr = F.in[7] + (size_t)n * 4096; const float* wi = F.in[9] + (size_t)n * 4096;
#pragma unroll 4
      for (int i = 0; i < 8; ++i) { const int e = tid + 512 * i, c = e >> 6, d = e & 63;
          *(LAS bf16*)(lds + L_WT + d * ROWB + c * 2) = (bf16)f2bf(wr[e]); *(LAS bf16*)(lds + L_WT + (64 + d) * ROWB + c * 2) = (bf16)f2bf(wi[e]); } }
    { const int t = tid >> 2, cg = tid & 3, ch0 = n * 64 + cg * 16;
      float acc[16];
      const float* cb = F.in[6] + ch0;
#pragma unroll
      for (int i = 0; i < 16; ++i) acc[i] = cb[i];
#pragma unroll
      for (int j = 0; j < 4; ++j) { const int p = p0 + t - 3 + j;
          const float* cw = F.in[5] + j * 512 + ch0;
          if (p >= 0) { const v4u x0 = *(const GAS v4u*)(XR + (rowbase + p) * 512 + ch0), x1 = *(const GAS v4u*)(XR + (rowbase + p) * 512 + ch0 + 8);
#pragma unroll
              for (int i = 0; i < 4; ++i) { acc[2 * i] += cw[2 * i] * __builtin_bit_cast(float, x0[i] << 16); acc[2 * i + 1] += cw[2 * i + 1] * __builtin_bit_cast(float, x0[i] & 0xffff0000u);
                                            acc[8 + 2 * i] += cw[8 + 2 * i] * __builtin_bit_cast(float, x1[i] << 16); acc[8 + 2 * i + 1] += cw[8 + 2 * i + 1] * __builtin_bit_cast(float, x1[i] & 0xffff0000u); } } }
      v4u o0, o1;
#pragma unroll
      for (int i = 0; i < 4; ++i) { o0[i] = pk2(acc[2 * i], acc[2 * i + 1]); o1[i] = pk2(acc[8 + 2 * i], acc[8 + 2 * i + 1]); }
      *(LAS v4u*)(lds + L_XC + t * ROWB + cg * 32) = o0; *(LAS v4u*)(lds + L_XC + t * ROWB + cg * 32 + 16) = o1; }
    __syncthreads();
    { const int tb = wid & 3, dh = wid >> 2;
      f32x16 d0, d1;
#pragma unroll
      for (int r = 0; r < 16; ++r) { d0[r] = 0.f; d1[r] = 0.f; }
#pragma unroll
      for (int s = 0; s < 4; ++s) {
          const bf16x8 a = *(const LAS bf16x8*)(lds + L_XC + (tb * 32 + r32) * ROWB + s * 32 + hi * 16);
          const bf16x8 w0 = *(const LAS bf16x8*)(lds + L_WT + (dh * 64 + r32) * ROWB + s * 32 + hi * 16);
          const bf16x8 w1 = *(const LAS bf16x8*)(lds + L_WT + (dh * 64 + 32 + r32) * ROWB + s * 32 + hi * 16);
          d0 = __builtin_amdgcn_mfma_f32_32x32x16_bf16(a, w0, d0, 0, 0, 0);
          d1 = __builtin_amdgcn_mfma_f32_32x32x16_bf16(a, w1, d1, 0, 0, 0); }
      LAS float* pre = (LAS float*)(lds + L_PRE);
#pragma unroll
      for (int r = 0; r < 16; ++r) { const int tok = tb * 32 + (r & 3) + 8 * (r >> 2) + 4 * hi;
          pre[tok * 128 + dh * 64 + r32] = d0[r]; pre[tok * 128 + dh * 64 + 32 + r32] = d1[r]; } }
    __syncthreads();
    const int c = tid & 63, ts = wid, ch = n * 64 + c;
    const float br = F.in[8][ch], bi = F.in[10][ch], sp = log1pf(__expf(-F.in[11][ch]));
    float hv[16], cv[16];
    { const LAS float* pre = (const LAS float*)(lds + L_PRE);
      float h = 0.f, cum = 1.f;
#pragma unroll
      for (int i = 0; i < 16; ++i) { const int tt = ts * 16 + i;
          const float r = sigmoidf_(pre[tt * 128 + c] + br), ig = sigmoidf_(pre[tt * 128 + 64 + c] + bi);
          const float log_a = -8.f * r * sp, a = __expf(log_a);
          const float mult = (p0 + tt == 0) ? 1.f : sqrtf(-expm1f(2.f * log_a));
          const float xc = bf2f(*(const LAS bf16*)(lds + L_XC + tt * ROWB + c * 2));
          h = a * h + xc * ig * mult; cum *= a; hv[i] = h; cv[i] = cum; }
      LAS float* ag = (LAS float*)(lds + L_AGG);
      ag[(ts * 64 + c) * 2] = cum; ag[(ts * 64 + c) * 2 + 1] = h; }
    __syncthreads();
    { const LAS float* ag = (const LAS float*)(lds + L_AGG);
      float carry = 0.f, pprev = 1.f;
      for (int s = 0; s < ts; ++s) { const float as = ag[(s * 64 + c) * 2], hs = ag[(s * 64 + c) * 2 + 1]; carry = as * carry + hs; pprev *= as; }
      if (ts == 7) { float* g = AGG + ((size_t)((b * 8 + n) * 64 + k) * 64 + c) * 2; g[0] = pprev * cv[15]; g[1] = cv[15] * carry + hv[15]; }
#pragma unroll
      for (int i = 0; i < 16; ++i) { const size_t row = rowbase + p0 + ts * 16 + i;
          const float gy = bf2f(GY[row * 512 + ch]);
          PG[row * 512 + ch] = (bf16)f2bf(cv[i] * pprev * gy); QG[row * 512 + ch] = (bf16)f2bf((hv[i] + cv[i] * carry) * gy); } }
    __syncthreads();
}
__device__ __forceinline__ void l1_phase(Frame& F) { for (int u = F.vcu; u < 1024; u += F.G) l1_unit(F, u >> 9, (u >> 6) & 7, u & 63); }

__device__ __forceinline__ void l2_phase(Frame& F) {
    const bf16* PG = (const bf16*)(F.ws + WS_PG); const bf16* QG = (const bf16*)(F.ws + WS_QG); const float* AGG = (const float*)(F.ws + AGG_OFF);
    bf16* AL = (bf16*)(F.ws + WS_AL);
    const int c = F.tid & 63, ts = F.wave;
    for (int u = F.vcu; u < 1024; u += F.G) { const int b = u >> 9, n = (u >> 6) & 7, k = u & 63, ch = n * 64 + c;
        float carry = 0.f;
        const float* g = AGG + ((size_t)((b * 8 + n) * 64) * 64 + c) * 2;
        for (int j = 0; j < k; ++j) carry = g[(size_t)j * 128] * carry + g[(size_t)j * 128 + 1];
#pragma unroll 4
        for (int i = 0; i < 16; ++i) { const size_t row = (size_t)b * SEQ + k * 128 + ts * 16 + i;
            AL[row * 1024 + 512 + ch] = (bf16)f2bf(bf2f(QG[row * 512 + ch]) + bf2f(PG[row * 512 + ch]) * carry); } }
}
}

namespace moe {
constexpr int L_HN = 0;
constexpr int L_TOK = LDSCTL_OFF + 1024;
constexpr int L_HIST = LDSCTL_OFF + 2560, L_BASE = LDSCTL_OFF + 2688, L_PAD = LDSCTL_OFF + 2816;
constexpr size_t TOKSLOT_OFF = WS_MISC + 1 * MiB;
static_assert(L_PAD + 33 * 4 <= LDS_BYTES, "LDS control map");

__device__ __forceinline__ void route_phase(Frame& F) {
    const int lane = F.lane, wave = F.wave;
    LAS unsigned char* lds = F.lds;
    const float* x1 = F.out; const float* gf = F.in[15]; const float* wgp = F.in[16]; const float* wer = F.in[17];
    f32x4 gv[4];
#pragma unroll
    for (int j = 0; j < 4; ++j) gv[j] = ((const GAS f32x4*)gf)[lane + 64 * j];
    for (int i = 0; i < 8; ++i) {
        const int lt = wave * 8 + i, tok = F.vcu * 64 + lt;
        const GAS f32x4* xr = (const GAS f32x4*)(x1 + (size_t)tok * DM) + lane;
        f32x4 v[4]; float s = 0.f;
#pragma unroll
        for (int j = 0; j < 4; ++j) { v[j] = xr[64 * j]; s += (v[j].x * v[j].x + v[j].y * v[j].y) + (v[j].z * v[j].z + v[j].w * v[j].w); }
        const float rstd = rsqrtf(wave_sum(s) * (1.f / DM) + EPS);
#pragma unroll
        for (int j = 0; j < 4; ++j) { v[j] = v[j] * rstd * gv[j];
            *(LAS unsigned long long*)(lds + L_HN + lt * 2048 + (64 * j + lane) * 8) = (unsigned long long)pk2(v[j].x, v[j].y) | ((unsigned long long)pk2(v[j].z, v[j].w) << 32); }
        f32x4 lg = {0.f, 0.f, 0.f, 0.f};
#pragma unroll
        for (int j = 0; j < 4; ++j) { const GAS f32x4* wp = (const GAS f32x4*)wgp + (size_t)(64 * j + lane) * 4;
#pragma unroll
            for (int e = 0; e < 4; ++e) lg += wp[e] * v[j][e]; }
#pragma unroll
        for (int e = 0; e < 4; ++e) lg[e] = wave_sum(lg[e]);
        int grp = 0; float mx = lg[0];
#pragma unroll
        for (int e = 1; e < 4; ++e) if (lg[e] > mx) { mx = lg[e]; grp = e; }
        float den = 0.f;
#pragma unroll
        for (int e = 0; e < 4; ++e) den += __expf(lg[e] - mx);
        const float gw = 1.f / den;
        f32x4 la = {0.f, 0.f, 0.f, 0.f}, lb = {0.f, 0.f, 0.f, 0.f};
        const float* wg2 = wer + (size_t)grp * 8192;
#pragma unroll
        for (int j = 0; j < 4; ++j) { const GAS f32x4* wp = (const GAS f32x4*)wg2 + (size_t)(64 * j + lane) * 8;
#pragma unroll
            for (int e = 0; e < 4; ++e) { la += wp[2 * e] * v[j][e]; lb += wp[2 * e + 1] * v[j][e]; } }
        float le[8];
#pragma unroll
        for (int e = 0; e < 4; ++e) { le[e] = wave_sum(la[e]); le[4 + e] = wave_sum(lb[e]); }
        int i0 = 0; float m0 = le[0];
#pragma unroll
        for (int e = 1; e < 8; ++e) if (le[e] > m0) { m0 = le[e]; i0 = e; }
        int i1 = -1; float m1 = -INFINITY;
#pragma unroll
        for (int e = 0; e < 8; ++e) if (e != i0 && le[e] > m1) { m1 = le[e]; i1 = e; }
        const float pa = 1.f / (1.f + __expf(m1 - m0));
        if (lane == 0) { const int e0 = grp * 8 + i0, e1 = grp * 8 + i1;
            const int l0 = atomicAdd((int*)(lds + L_HIST) + e0, 1), l1 = atomicAdd((int*)(lds + L_HIST) + e1, 1);
            LAS int* tk = (LAS int*)(lds + L_TOK + lt * 24); tk[0] = e0; tk[1] = e1; ((LAS float*)tk)[2] = gw * pa; ((LAS float*)tk)[3] = gw * (1.f - pa); tk[4] = l0; tk[5] = l1; }
    }
    __syncthreads();
    if (F.tid < 32) { const int h = ((LAS int*)(lds + L_HIST))[F.tid];
        ((LAS int*)(lds + L_BASE))[F.tid] = (int)atomicAdd((unsigned*)(F.ctl + CW_CNT) + F.tid, (unsigned)h); }
}
__device__ __forceinline__ void scatter_phase(Frame& F) {
    const int lane = F.lane, wave = F.wave;
    LAS unsigned char* lds = F.lds;
    if (F.tid == 0) { int acc = 0; LAS int* pad = (LAS int*)(lds + L_PAD);
        for (int e = 0; e < 32; ++e) { pad[e] = acc; const int c = (int)__hip_atomic_load(F.ctl + CW_CNT + e, RLX_AGENT); acc += (c + 255) & ~255; }
        pad[32] = acc; }
    __syncthreads();
    bf16* XS = (bf16*)(F.ws + WS_XS); int* TS = (int*)(F.ws + TOKSLOT_OFF);
    const LAS int* pad = (const LAS int*)(lds + L_PAD); const LAS int* base = (const LAS int*)(lds + L_BASE);
    for (int i = 0; i < 8; ++i) { const int lt = wave * 8 + i, tok = F.vcu * 64 + lt;
        const LAS int* tk = (const LAS int*)(lds + L_TOK + lt * 24);
        const int e0 = tk[0], e1 = tk[1];
        const int s0 = pad[e0] + base[e0] + tk[4], s1 = pad[e1] + base[e1] + tk[5];
        const v4u a = *(const LAS v4u*)(lds + L_HN + lt * 2048 + lane * 16), b = *(const LAS v4u*)(lds + L_HN + lt * 2048 + 1024 + lane * 16);
        *(GAS v4u*)(XS + (size_t)s0 * 1024 + lane * 8) = a; *(GAS v4u*)(XS + (size_t)s0 * 1024 + 512 + lane * 8) = b;
        *(GAS v4u*)(XS + (size_t)s1 * 1024 + lane * 8) = a; *(GAS v4u*)(XS + (size_t)s1 * 1024 + 512 + lane * 8) = b;
        if (lane == 0) { int* t = TS + (size_t)tok * 4; t[0] = s0; t[1] = s1; t[2] = tk[2]; t[3] = tk[3]; } }
}
__device__ __forceinline__ void final_phase(Frame& F) {
    const int lane = F.lane; const int gw = F.vcu * NWAVES + F.wave, NGW = F.G * NWAVES;
    const bf16* YB = (const bf16*)(F.ws + WS_YB); const int* TS = (const int*)(F.ws + TOKSLOT_OFF); const float* gfin = F.in[21];
    f32x4 gv[4];
#pragma unroll
    for (int j = 0; j < 4; ++j) gv[j] = ((const GAS f32x4*)gfin)[lane + 64 * j];
    for (int tok = gw; tok < NTOK; tok += NGW) {
        const int* t = TS + (size_t)tok * 4; const int s0 = t[0], s1 = t[1]; const float w0 = __builtin_bit_cast(float, t[2]), w1 = __builtin_bit_cast(float, t[3]);
        GAS f32x4* xr = (GAS f32x4*)(F.out + (size_t)tok * DM) + lane;
        const GAS unsigned long long* y0 = (const GAS unsigned long long*)(YB + (size_t)s0 * 1024) + lane; const GAS unsigned long long* y1 = (const GAS unsigned long long*)(YB + (size_t)s1 * 1024) + lane;
        f32x4 v[4]; float s = 0.f;
#pragma unroll
        for (int j = 0; j < 4; ++j) { v[j] = xr[64 * j]; const unsigned long long a = y0[64 * j], b = y1[64 * j];
            v[j].x += w0 * __builtin_bit_cast(float, (unsigned)a << 16) + w1 * __builtin_bit_cast(float, (unsigned)b << 16);
            v[j].y += w0 * __builtin_bit_cast(float, (unsigned)a & 0xffff0000u) + w1 * __builtin_bit_cast(float, (unsigned)b & 0xffff0000u);
            v[j].z += w0 * __builtin_bit_cast(float, (unsigned)(a >> 32) << 16) + w1 * __builtin_bit_cast(float, (unsigned)(b >> 32) << 16);
            v[j].w += w0 * __builtin_bit_cast(float, (unsigned)(a >> 32) & 0xffff0000u) + w1 * __builtin_bit_cast(float, (unsigned)(b >> 32) & 0xffff0000u);
            s += (v[j].x * v[j].x + v[j].y * v[j].y) + (v[j].z * v[j].z + v[j].w * v[j].w); }
        const float rstd = rsqrtf(wave_sum(s) * (1.f / DM) + EPS);
#pragma unroll
        for (int j = 0; j < 4; ++j) xr[64 * j] = v[j] * rstd * gv[j];
    }
}
}

struct Args { const float* in[22]; float* out; unsigned char* ws; int ph_lo, ph_hi, li, pad; };
constexpr int N_PHASES = 2;
__global__ void __launch_bounds__(NWAVES * 64, 2) mega(Args args) {
    extern __shared__ __attribute__((aligned(16))) unsigned char lds[];
    Frame F;
    F.lds = (LAS unsigned char*)lds;
    F.MISC = (volatile LAS unsigned*)(F.lds + MISC_OFF);
    F.tid = threadIdx.x; F.lane = F.tid & 63; F.wave = __builtin_amdgcn_readfirstlane(F.tid >> 6);
    F.G = gridDim.x; { const int bx = blockIdx.x; F.vcu = (F.G % 8 == 0) ? (bx % 8) * (F.G / 8) + bx / 8 : bx; }
    F.ws = args.ws; F.out = args.out; F.ctl = (gu32*)(args.ws + WS_CTL);
#pragma unroll
    for (int i = 0; i < 22; ++i) F.in[i] = args.in[i];
    for (int u = F.tid; u < (LDS_BYTES - LDSCTL_OFF) / 4; u += NWAVES * 64) ((LAS unsigned*)(F.lds + LDSCTL_OFF))[u] = 0u;
    __syncthreads();
    XcdBarrier bar = xcd_barrier_post((unsigned*)(F.ctl + CW_BAR) + args.li * XCD_BAR_WORDS, F.MISC + 8);
    const int lo = args.ph_lo, hi = args.ph_hi;
#define IN(k) (lo <= (k) && (k) < hi)
#define BOTH(k) (IN(k) && IN((k) + 1))
#define GRID_BAR() xcd_barrier(bar)
#define REFRESH() do { int t_ = threadIdx.x; asm volatile("" : "+v"(t_)); F.tid = t_; F.lane = t_ & 63; } while (0)

    if (IN(0)) { REFRESH(); p0_prologue(F); if (BOTH(0)) GRID_BAR(); }

    if (IN(1)) {
        pg8::Gemm g{(const bf16*)(F.ws + WS_XN), (const bf16*)(F.ws + WS_WIN), NTOK, INC, DM}; pg8::StaticOrder S; S.init(NTOK, INC, F.G, (int)blockIdx.x);
        pg8::EpiInProj E{(bf16*)(F.ws + WS_Q), (bf16*)(F.ws + WS_K), (bf16*)(F.ws + WS_V), (bf16*)(F.ws + WS_XR), (bf16*)(F.ws + WS_GY), (bf16*)F.out, (unsigned*)(F.ctl + CW_QKMAX)};
        pg8::gemm_phase<pg8::EpiInProj, pg8::StaticOrder, true, true>(F.lds + RING_OFF, g, S, E);
        if (BOTH(1)) GRID_BAR();
    }
    if (IN(2)) { REFRESH(); lru::l1_phase(F); REFRESH(); att::attn_phase(F); if (BOTH(2)) GRID_BAR(); }

    if (IN(3)) { REFRESH(); lru::l2_phase(F); if (BOTH(3)) GRID_BAR(); }
#ifndef NO_P4
    if (IN(4)) {
        pg8::Gemm g{(const bf16*)(F.ws + WS_AL), (const bf16*)(F.ws + WS_WMIX), NTOK, DM, DM}; pg8::StaticOrder S; S.init(NTOK, DM, F.G, (int)blockIdx.x);
        pg8::EpiMix E{(const bf16*)F.out, (bf16*)(F.ws + WS_MERGED)};
        pg8::gemm_phase<pg8::EpiMix, pg8::StaticOrder, true, true>(F.lds + RING_OFF, g, S, E);
        if (BOTH(4)) GRID_BAR();
    }
#endif
#ifndef NO_P5
    if (IN(5)) {
        pg8::Gemm g{(const bf16*)(F.ws + WS_MERGED), (const bf16*)(F.ws + WS_WOUT), NTOK, DM, DM}; pg8::StaticOrder S; S.init(NTOK, DM, F.G, (int)blockIdx.x);
        pg8::EpiResidF32 E{F.in[0], F.out};
        pg8::gemm_phase<pg8::EpiResidF32, pg8::StaticOrder, true, true>(F.lds + RING_OFF, g, S, E);
        if (BOTH(5)) GRID_BAR();
    }
#endif
    if (IN(6)) { REFRESH(); moe::route_phase(F); if (BOTH(6)) GRID_BAR(); }
    if (IN(7)) { REFRESH(); moe::scatter_phase(F); if (BOTH(7)) GRID_BAR(); }
    if (IN(8)) {
        pg8::Gemm g{(const bf16*)(F.ws + WS_XS), (const bf16*)(F.ws + WS_WGU), 0, 0, 1024}; pg8::MoeOrder S; S.init((const LAS int*)(F.lds + moe::L_PAD), F.G, (int)blockIdx.x);
        pg8::EpiSwiGLU E{(bf16*)(F.ws + WS_HB)};
        pg8::gemm_phase<pg8::EpiSwiGLU, pg8::MoeOrder, true, true>(F.lds + RING_OFF, g, S, E);
        if (BOTH(8)) GRID_BAR();
    }
    if (IN(9)) {
        pg8::Gemm g{(const bf16*)(F.ws + WS_HB), (const bf16*)(F.ws + WS_WD), 0, 0, 512}; pg8::MoeOrder S; S.init((const LAS int*)(F.lds + moe::L_PAD), F.G, (int)blockIdx.x);
        pg8::EpiStoreBf16 E{(bf16*)(F.ws + WS_YB), 1024};
        pg8::gemm_phase<pg8::EpiStoreBf16, pg8::MoeOrder, true, true>(F.lds + RING_OFF, g, S, E);
        if (BOTH(9)) GRID_BAR();
    }
    if (IN(10)) { REFRESH(); moe::final_phase(F); }
#undef IN
#undef BOTH
#undef GRID_BAR
#undef REFRESH
}
__global__ void n_rmsnorm(const float* __restrict__ x, const float* __restrict__ g, bf16* __restrict__ xn) {
    const int row = blockIdx.x, tid = threadIdx.x;
    const float4 v = ((const float4*)(x + (size_t)row * DM))[tid];
    float s = v.x * v.x + v.y * v.y + v.z * v.z + v.w * v.w;
    __shared__ float red[256];
    red[tid] = s; __syncthreads();
    for (int o = 128; o > 0; o >>= 1) { if (tid < o) red[tid] += red[tid + o]; __syncthreads(); }
    const float rstd = rsqrtf(red[0] / DM + EPS);
    const float4 gg = ((const float4*)g)[tid];
    bf16* o = xn + (size_t)row * DM + tid * 4;
    o[0] = f2bf(v.x * rstd * gg.x); o[1] = f2bf(v.y * rstd * gg.y); o[2] = f2bf(v.z * rstd * gg.z); o[3] = f2bf(v.w * rstd * gg.w);
}

template <class Epi>
__global__ void n_gemm(const bf16* __restrict__ A, int lda, const float* __restrict__ W, int ldw, int K, Epi epi) {
    __shared__ float As[16][65]; __shared__ float Ws[16][64];
    const int tx = threadIdx.x, ty = threadIdx.y, tid = ty * 16 + tx;
    const int row0 = blockIdx.y * 64, col0 = blockIdx.x * 64;
    float acc[4][4];
#pragma unroll
    for (int i = 0; i < 4; ++i)
#pragma unroll
        for (int j = 0; j < 4; ++j) acc[i][j] = 0.f;
    for (int k0 = 0; k0 < K; k0 += 16) {
#pragma unroll
        for (int i = 0; i < 4; ++i) { const int idx = tid + i * 256; const int r = idx >> 4, kk = idx & 15; As[kk][r] = bf2f(A[(size_t)(row0 + r) * lda + k0 + kk]); }
#pragma unroll
        for (int i = 0; i < 4; ++i) { const int idx = tid + i * 256; const int kk = idx >> 6, c = idx & 63; Ws[kk][c] = W[(size_t)(k0 + kk) * ldw + col0 + c]; }
        __syncthreads();
#pragma unroll
        for (int kk = 0; kk < 16; ++kk) {
            float a[4], b[4];
#pragma unroll
            for (int i = 0; i < 4; ++i) a[i] = As[kk][ty * 4 + i];
#pragma unroll
            for (int j = 0; j < 4; ++j) b[j] = Ws[kk][tx * 4 + j];
#pragma unroll
            for (int i = 0; i < 4; ++i)
#pragma unroll
                for (int j = 0; j < 4; ++j) acc[i][j] += a[i] * b[j];
        }
        __syncthreads();
    }
#pragma unroll
    for (int i = 0; i < 4; ++i)
#pragma unroll
        for (int j = 0; j < 4; ++j) epi(row0 + ty * 4 + i, col0 + tx * 4 + j, acc[i][j]);
}

struct EpiInProjN {
    bf16 *Q, *K, *V, *XR, *GY, *GATES;
    __device__ void operator()(int r, int c, float v) const {
        if (c < 512) Q[(size_t)r * 512 + c] = f2bf(v * C2);
        else if (c < 1024) K[(size_t)r * 512 + c - 512] = f2bf(v);
        else if (c < 1536) V[(size_t)r * 512 + c - 1024] = f2bf(v);
        else if (c < 2048) XR[(size_t)r * 512 + c - 1536] = f2bf(v);
        else if (c < 2560) GY[(size_t)r * 512 + c - 2048] = f2bf(gelu_tanh(v));
        else GATES[(size_t)r * 2048 + c - 2560] = f2bf(sigmoidf_(v));
    }
};
struct EpiResid { const float* x; float* out; __device__ void operator()(int r, int c, float v) const { out[(size_t)r * DM + c] = x[(size_t)r * DM + c] + v; } };

__global__ void n_gemm_mix(const bf16* __restrict__ AL, const float* __restrict__ Woa, const float* __restrict__ Wol, const bf16* __restrict__ GATES, bf16* __restrict__ MERGED) {
    __shared__ float As[2][16][65]; __shared__ float Ws[2][16][64];
    const int tx = threadIdx.x, ty = threadIdx.y, tid = ty * 16 + tx;
    const int row0 = blockIdx.y * 64, col0 = blockIdx.x * 64;
    float acc[2][4][4];
#pragma unroll
    for (int s = 0; s < 2; ++s)
#pragma unroll
        for (int i = 0; i < 4; ++i)
#pragma unroll
            for (int j = 0; j < 4; ++j) acc[s][i][j] = 0.f;
    for (int k0 = 0; k0 < 512; k0 += 16) {
#pragma unroll
        for (int i = 0; i < 4; ++i) { const int idx = tid + i * 256; const int r = idx >> 4, kk = idx & 15;
            As[0][kk][r] = bf2f(AL[(size_t)(row0 + r) * 1024 + k0 + kk]); As[1][kk][r] = bf2f(AL[(size_t)(row0 + r) * 1024 + 512 + k0 + kk]); }
#pragma unroll
        for (int i = 0; i < 4; ++i) { const int idx = tid + i * 256; const int kk = idx >> 6, c = idx & 63;
            Ws[0][kk][c] = Woa[(size_t)(k0 + kk) * 1024 + col0 + c]; Ws[1][kk][c] = Wol[(size_t)(k0 + kk) * 1024 + col0 + c]; }
        __syncthreads();
#pragma unroll
        for (int s = 0; s < 2; ++s)
#pragma unroll
            for (int kk = 0; kk < 16; ++kk) {
                float a[4], b[4];
#pragma unroll
                for (int i = 0; i < 4; ++i) a[i] = As[s][kk][ty * 4 + i];
#pragma unroll
                for (int j = 0; j < 4; ++j) b[j] = Ws[s][kk][tx * 4 + j];
#pragma unroll
                for (int i = 0; i < 4; ++i)
#pragma unroll
                    for (int j = 0; j < 4; ++j) acc[s][i][j] += a[i] * b[j];
            }
        __syncthreads();
    }
#pragma unroll
    for (int i = 0; i < 4; ++i)
#pragma unroll
        for (int j = 0; j < 4; ++j) { const int r = row0 + ty * 4 + i, c = col0 + tx * 4 + j;
            const float ga = bf2f(GATES[(size_t)r * 2048 + c]), gl = bf2f(GATES[(size_t)r * 2048 + 1024 + c]);
            MERGED[(size_t)r * 1024 + c] = f2bf(ga * acc[0][i][j] + gl * acc[1][i][j]); }
}

__global__ void n_attn(const bf16* __restrict__ Q, const bf16* __restrict__ K, const bf16* __restrict__ V, const float* __restrict__ lambda_qk, const float* __restrict__ subln_g, bf16* __restrict__ AL) {
    const int row = blockIdx.x, h = blockIdx.y, tid = threadIdx.x;
    const int b = row / SEQ, qpos = row % SEQ;
    __shared__ float sc[SEQ]; __shared__ float qv[64]; __shared__ float red[256]; __shared__ float o0[128]; __shared__ float part[256];
    const float slope2 = exp2f(-2.f * (h + 1)) * LOG2E;
    float lam;
    { float s0 = 0.f, s1 = 0.f; for (int d = 0; d < 64; ++d) { s0 += lambda_qk[d] * lambda_qk[64 + d]; s1 += lambda_qk[128 + d] * lambda_qk[192 + d]; } lam = expf(s0) - expf(s1) + 0.2f; }
    float ofin = 0.f;
    for (int m = 0; m < 2; ++m) {
        __syncthreads();
        if (tid < 64) qv[tid] = bf2f(Q[(size_t)row * 512 + h * 128 + m * 64 + tid]);
        __syncthreads();
        float lmax = -INFINITY;
        for (int key = tid; key <= qpos; key += 256) {
            const bf16* kr = K + (size_t)(b * SEQ + key) * 512 + h * 128 + m * 64;
            float s = 0.f;
            for (int d = 0; d < 64; ++d) s += qv[d] * bf2f(kr[d]);
            s += slope2 * (float)(key - qpos);
            sc[key] = s; lmax = fmaxf(lmax, s);
        }
        red[tid] = lmax; __syncthreads();
        for (int o = 128; o > 0; o >>= 1) { if (tid < o) red[tid] = fmaxf(red[tid], red[tid + o]); __syncthreads(); }
        const float mx = red[0]; __syncthreads();
        float lsum = 0.f;
        for (int key = tid; key <= qpos; key += 256) { const float p = exp2f(sc[key] - mx); sc[key] = p; lsum += p; }
        red[tid] = lsum; __syncthreads();
        for (int o = 128; o > 0; o >>= 1) { if (tid < o) red[tid] += red[tid + o]; __syncthreads(); }
        const float inv = 1.f / red[0]; __syncthreads();
        const int vd = tid & 127, half = tid >> 7;
        float acc = 0.f;
        for (int key = half; key <= qpos; key += 2) acc += sc[key] * bf2f(V[(size_t)(b * SEQ + key) * 512 + h * 128 + vd]);
        part[tid] = acc; __syncthreads();
        if (tid < 128) { const float o = (part[tid] + part[tid + 128]) * inv; if (m == 0) ofin = o; else ofin = ofin - lam * o; }
    }
    __syncthreads();
    red[tid] = (tid < 128) ? ofin * ofin : 0.f; __syncthreads();
    for (int o = 128; o > 0; o >>= 1) { if (tid < o) red[tid] += red[tid + o]; __syncthreads(); }
    const float rstd = rsqrtf(red[0] / 128.f + EPS);
    if (tid < 128) AL[(size_t)row * 1024 + h * 128 + tid] = f2bf(ofin * rstd * subln_g[tid] * 0.8f);
}

__global__ void n_lru(const bf16* __restrict__ XR, const bf16* __restrict__ GY, const float* __restrict__ conv_w, const float* __restrict__ conv_b, const float* __restrict__ w_r, const float* __restrict__ b_r,
                      const float* __restrict__ w_i, const float* __restrict__ b_i, const float* __restrict__ lru_lambda, bf16* __restrict__ AL) {
    const int b = blockIdx.x >> 3, n = blockIdx.x & 7, d = threadIdx.x, ch = n * 64 + d;
    __shared__ float Wr[64][64]; __shared__ float Wi[64][64]; __shared__ float xs[64];
    for (int c = 0; c < 64; ++c) { Wr[c][d] = w_r[(size_t)n * 4096 + c * 64 + d]; Wi[c][d] = w_i[(size_t)n * 4096 + c * 64 + d]; }
    const float cw0 = conv_w[ch], cw1 = conv_w[512 + ch], cw2 = conv_w[1024 + ch], cw3 = conv_w[1536 + ch], cb = conv_b[ch];
    const float br = b_r[ch], bi = b_i[ch];
    const float sp = log1pf(expf(-lru_lambda[ch]));
    float xm3 = 0.f, xm2 = 0.f, xm1 = 0.f, hst = 0.f;
    __syncthreads();
    for (int t = 0; t < SEQ; ++t) {
        const size_t row = (size_t)b * SEQ + t;
        const float xt = bf2f(XR[row * 512 + ch]);
        const float xc = cw0 * xm3 + cw1 * xm2 + cw2 * xm1 + cw3 * xt + cb;
        xm3 = xm2; xm2 = xm1; xm1 = xt;
        xs[d] = xc; __syncthreads();
        float rp = br, ip = bi;
        for (int c = 0; c < 64; ++c) { const float xv = xs[c]; rp += xv * Wr[c][d]; ip += xv * Wi[c][d]; }
        __syncthreads();
        const float r = sigmoidf_(rp), ig = sigmoidf_(ip);
        const float log_a = -8.f * r * sp;
        const float a = expf(log_a);
        const float mult = (t == 0) ? 1.f : sqrtf(-expm1f(2.f * log_a));
        hst = a * hst + xc * ig * mult;
        AL[row * 1024 + 512 + ch] = f2bf(hst * bf2f(GY[row * 512 + ch]));
    }
}

__global__ void n_moe_final(float* __restrict__ xio, const float* __restrict__ g_ffn, const float* __restrict__ w_group, const float* __restrict__ w_er, const float* __restrict__ w_gate, const float* __restrict__ w_up,
                            const float* __restrict__ w_down, const float* __restrict__ g_fin) {
    const int row = blockIdx.x, tid = threadIdx.x;
    __shared__ float x1[1024]; __shared__ float hn[1024]; __shared__ float hb[512]; __shared__ float red[512]; __shared__ float lg[16]; __shared__ int sel[4]; __shared__ float selw[2];
    float* xr = xio + (size_t)row * DM;
    const float a0 = xr[tid], a1 = xr[tid + 512];
    x1[tid] = a0; x1[tid + 512] = a1;
    red[tid] = a0 * a0 + a1 * a1; __syncthreads();
    for (int o = 256; o > 0; o >>= 1) { if (tid < o) red[tid] += red[tid + o]; __syncthreads(); }
    const float rstd = rsqrtf(red[0] / DM + EPS); __syncthreads();
    hn[tid] = a0 * rstd * g_ffn[tid]; hn[tid + 512] = a1 * rstd * g_ffn[tid + 512]; __syncthreads();
    if (tid < 4) { float s = 0.f; for (int k = 0; k < 1024; ++k) s += hn[k] * w_group[k * 4 + tid]; lg[tid] = s; }
    __syncthreads();
    if (tid == 0) { int g = 0; float mx = lg[0]; for (int j = 1; j < 4; ++j) if (lg[j] > mx) { mx = lg[j]; g = j; } float den = 0.f; for (int j = 0; j < 4; ++j) den += expf(lg[j] - mx); sel[0] = g; lg[8] = 1.f / den; }
    __syncthreads();
    const int grp = sel[0];
    if (tid < 8) { float s = 0.f; const float* w = w_er + (size_t)grp * 8192; for (int k = 0; k < 1024; ++k) s += hn[k] * w[k * 8 + tid]; lg[tid] = s; }
    __syncthreads();
    if (tid == 0) {
        const float gw = lg[8];
        int i0 = 0; for (int j = 1; j < 8; ++j) if (lg[j] > lg[i0]) i0 = j;
        int i1 = (i0 == 0) ? 1 : 0; for (int j = 0; j < 8; ++j) if (j != i0 && lg[j] > lg[i1]) i1 = j;
        const float p0 = 1.f / (1.f + expf(lg[i1] - lg[i0]));
        sel[1] = grp * 8 + i0; sel[2] = grp * 8 + i1; selw[0] = gw * p0; selw[1] = gw * (1.f - p0);
    }
    __syncthreads();
    float y0 = 0.f, y1 = 0.f;
    for (int kk = 0; kk < 2; ++kk) {
        const int e = sel[1 + kk]; const float wk = selw[kk];
        const float* wg = w_gate + (size_t)e * 1024 * 512; const float* wu = w_up + (size_t)e * 1024 * 512; const float* wd = w_down + (size_t)e * 512 * 1024;
        float g = 0.f, u = 0.f;
        for (int k = 0; k < 1024; ++k) { const float xv = hn[k]; g += xv * wg[(size_t)k * 512 + tid]; u += xv * wu[(size_t)k * 512 + tid]; }
        __syncthreads();
        hb[tid] = g / (1.f + expf(-g)) * u; __syncthreads();
        float s0 = 0.f, s1 = 0.f;
        for (int j = 0; j < 512; ++j) { const float hv = hb[j]; s0 += hv * wd[(size_t)j * 1024 + tid]; s1 += hv * wd[(size_t)j * 1024 + tid + 512]; }
        y0 += wk * s0; y1 += wk * s1;
    }
    const float z0 = a0 + y0, z1 = a1 + y1;
    __syncthreads();
    red[tid] = z0 * z0 + z1 * z1; __syncthreads();
    for (int o = 256; o > 0; o >>= 1) { if (tid < o) red[tid] += red[tid + o]; __syncthreads(); }
    const float rs2 = rsqrtf(red[0] / DM + EPS);
    xr[tid] = z0 * rs2 * g_fin[tid]; xr[tid + 512] = z1 * rs2 * g_fin[tid + 512];
}


__global__ void n_conv_win(const float* __restrict__ W, bf16* __restrict__ WT) {
    const int c = blockIdx.x * 256 + threadIdx.x, k = blockIdx.y;
    const int w = c & 255; const int row = (c & ~255) + ((w >> 5) & 1) * 128 + (w >> 6) * 32 + (w & 31);
    WT[(size_t)row * 1024 + k] = (bf16)f2bf(W[(size_t)k * INC + c]);
}
#ifndef MEGA_HI
#define MEGA_HI 11
#endif
static void launch_mega(const Args& a0, int lo, int hi, int li, int grid, hipStream_t stream) {
    Args a = a0; a.ph_lo = lo; a.ph_hi = hi; a.li = li;
    hipLaunchKernelGGL(mega, dim3(grid), dim3(NWAVES * 64), LDS_BYTES, stream, a);
    const hipError_t le = hipPeekAtLastError();
    if (le != hipSuccess) fprintf(stderr, "kernel_launch: mega launch [%d,%d) failed: %s\n", lo, hi, hipGetErrorName(le));
}
extern "C" void kernel_launch(void* const* d_in, const int* in_sizes, int n_in, void* d_out, int out_size, void* d_ws, size_t ws_size, hipStream_t stream) {
    static int grid = 0;
    if (grid == 0) {
        if (n_in != 22 || out_size != NTOK * DM || ws_size < WS_END) { fprintf(stderr, "kernel_launch: unexpected shapes (n_in %d out %d ws %zu)\n", n_in, out_size, ws_size); grid = -1; return; }
        int dev = 0, cus = 0, per_cu = 0;
        if (hipGetDevice(&dev) != hipSuccess || hipDeviceGetAttribute(&cus, hipDeviceAttributeMultiprocessorCount, dev) != hipSuccess) { grid = -1; return; }
        if (hipFuncSetAttribute((const void*)mega, hipFuncAttributeMaxDynamicSharedMemorySize, LDS_BYTES) != hipSuccess) { fprintf(stderr, "kernel_launch: hipFuncSetAttribute failed\n"); grid = -1; return; }
        if (hipOccupancyMaxActiveBlocksPerMultiprocessor(&per_cu, (const void*)mega, NWAVES * 64, LDS_BYTES) != hipSuccess || per_cu < 1) fprintf(stderr, "kernel_launch: occupancy query says %d\n", per_cu);
        (void)hipGetLastError();
        grid = cus;
    }
    if (grid < 0) return;
    (void)hipMemsetAsync((char*)d_ws + WS_CTL, 0, CTL_ZERO_BYTES, stream);
    Args a{};
    for (int i = 0; i < 22; ++i) a.in[i] = (const float*)d_in[i];
    a.out = (float*)d_out; a.ws = (unsigned char*)d_ws;
    const float* x = (const float*)d_in[0];
    unsigned char* ws = (unsigned char*)d_ws;
    bf16* XN = (bf16*)(ws + WS_XN); bf16* Qb = (bf16*)(ws + WS_Q); bf16* Kb = (bf16*)(ws + WS_K); bf16* Vb = (bf16*)(ws + WS_V);
    bf16* XR = (bf16*)(ws + WS_XR); bf16* GY = (bf16*)(ws + WS_GY); bf16* AL = (bf16*)(ws + WS_AL); bf16* MERGED = (bf16*)(ws + WS_MERGED);
    bf16* GATES = (bf16*)d_out;
#ifdef PROBE_P1_ONLY
    n_rmsnorm<<<NTOK, 256, 0, stream>>>(x, (const float*)d_in[1], XN);
    n_conv_win<<<dim3(INC / 256, 1024), 256, 0, stream>>>((const float*)d_in[2], (bf16*)(ws + WS_WIN));
    launch_mega(a, 1, 2, 0, grid, stream);
#elif defined(MEGA_SPLIT)
    for (int ph = 0; ph < MEGA_HI; ++ph) launch_mega(a, ph, ph + 1, ph, grid, stream);
#else
    if (MEGA_HI > 0) launch_mega(a, 0, MEGA_HI, 0, grid, stream);
#endif
    if (MEGA_HI < 1) n_rmsnorm<<<NTOK, 256, 0, stream>>>(x, (const float*)d_in[1], XN);
    if (MEGA_HI < 2) n_gemm<EpiInProjN><<<dim3(INC / 64, NTOK / 64), dim3(16, 16), 0, stream>>>(XN, DM, (const float*)d_in[2], INC, DM, EpiInProjN{Qb, Kb, Vb, XR, GY, GATES});
    if (MEGA_HI < 3) n_attn<<<dim3(NTOK, 4), 256, 0, stream>>>(Qb, Kb, Vb, (const float*)d_in[3], (const float*)d_in[4], AL);
    if (MEGA_HI < 4) n_lru<<<16, 64, 0, stream>>>(XR, GY, (const float*)d_in[5], (const float*)d_in[6], (const float*)d_in[7], (const float*)d_in[8], (const float*)d_in[9], (const float*)d_in[10], (const float*)d_in[11], AL);
    if (MEGA_HI < 5) n_gemm_mix<<<dim3(DM / 64, NTOK / 64), dim3(16, 16), 0, stream>>>(AL, (const float*)d_in[12], (const float*)d_in[13], GATES, MERGED);
    if (MEGA_HI < 6) n_gemm<EpiResid><<<dim3(DM / 64, NTOK / 64), dim3(16, 16), 0, stream>>>(MERGED, DM, (const float*)d_in[14], DM, DM, EpiResid{x, (float*)d_out});
    if (MEGA_HI < 11) n_moe_final<<<NTOK, 512, 0, stream>>>((float*)d_out, (const float*)d_in[15], (const float*)d_in[16], (const float*)d_in[17], (const float*)d_in[18], (const float*)d_in[19], (const float*)d_in[20], (const float*)d_in[21]);
}
```

```cpp
#include <hip/hip_runtime.h>
#include <cstdio>
#include <cstdint>
#include <cmath>

constexpr int NTOK = 16384, SEQ = 8192, DM = 1024, INC = 4608;
constexpr float C2 = 0.125f * 1.4426950408889634f;
constexpr float LOG2E = 1.4426950408889634f;
constexpr float EPS = 1e-6f;
typedef unsigned short bf16;

__device__ __forceinline__ unsigned f2bf(float f) { unsigned u = __builtin_bit_cast(unsigned, f); return (u + 0x7fffu + ((u >> 16) & 1u)) >> 16; }
__device__ __forceinline__ unsigned pk2(float lo, float hi) { return f2bf(lo) | (f2bf(hi) << 16); }
__device__ __forceinline__ float bf2f(bf16 b) { return __builtin_bit_cast(float, (unsigned)b << 16); }
__device__ __forceinline__ float sigmoidf_(float x) { return 1.f / (1.f + __expf(-x)); }
__device__ __forceinline__ float gelu_tanh(float x) { const float z = 0.7978845608028654f * (x + 0.044715f * x * x * x); return 0.5f * x * (1.f + tanhf(z)); }
__device__ __forceinline__ float sigmoid_fast(float x) { return __builtin_amdgcn_rcpf(1.f + __builtin_amdgcn_exp2f(-LOG2E * x)); }
__device__ __forceinline__ float gelu_fast(float x) { const float z2 = 1.5957691216057308f * (x + 0.044715f * x * x * x); return x * sigmoid_fast(z2); }

constexpr size_t MiB = 1u << 20;
constexpr size_t WS_CTL = 0, CTL_ZERO_BYTES = 1 * MiB;
constexpr size_t WS_WIN = 1 * MiB, WS_WMIX = 10 * MiB, WS_WOUT = 12 * MiB, WS_WGU = 14 * MiB, WS_WD = 78 * MiB;
constexpr size_t WS_XN = 110 * MiB, WS_Q = 142 * MiB, WS_K = 158 * MiB, WS_V = 174 * MiB, WS_XR = 190 * MiB, WS_GY = 206 * MiB, WS_AL = 222 * MiB;
constexpr size_t WS_PG = 110 * MiB, WS_QG = 126 * MiB;
constexpr size_t WS_MERGED = 142 * MiB;
constexpr size_t WS_XS = 110 * MiB, WS_HB = 190 * MiB, WS_YB = 110 * MiB;
constexpr size_t WS_MISC = 254 * MiB;
constexpr size_t WS_END = 256 * MiB;
constexpr int CW_QKMAX = 64;
constexpr int CW_CNT = 128;
constexpr int CW_BAR = 4096;
namespace pg8 {
#define PG8_LAS __attribute__((address_space(3)))
typedef unsigned short bf16_t;
typedef short bf16x8 __attribute__((ext_vector_type(8)));
typedef float f32x4 __attribute__((ext_vector_type(4)));
typedef unsigned u32x4 __attribute__((ext_vector_type(4)));
constexpr int BM = 256, BK = 64, HALF = 128, HTB = HALF * BK * 2  , STAGE_BYTES = 8 * HTB, NXCD = 8, WGM = 8;

__host__ __device__ __forceinline__ int lds_byte(int r, int c) { const int st = (r >> 4) * 2 + (c >> 5), rr = r & 15, cc = c & 31, ob = rr * 64 + cc * 2; return st * 1024 + (ob ^ (((ob >> 9) & 1) << 5)); }
__host__ __device__ __forceinline__ void stage_rc(int b, int& R, int& C) { const int st = b / 1024, sb = b % 1024, swz = sb ^ (((sb >> 9) & 1) << 5); R = (st >> 1) * 16 + swz / 64; C = (st & 1) * 32 + (swz % 64) / 2; }
__host__ __device__ __forceinline__ int perm32(int rho) { const int n = rho >> 4, i = rho & 15; return 8 * (i >> 2) + 4 * n + (i & 3); }

struct Unit { int pm, pn, bt; };
struct Gemm { const bf16_t* A; const bf16_t* Bt; int M, N, K; };

struct StaticOrder {
    int nM, nN, nwg, G, c;
    __host__ __device__ void init(int M, int N, int G_, int c_) { nM = M / BM; nN = N / BM; nwg = nM * nN; G = G_; c = c_; }
    __host__ __device__ bool next(int i, Unit& u) const {
        const long L = (long)i * G + c; if (L >= nwg) return false;
        int wgid = (int)L; { const int q = nwg / NXCD, r = nwg % NXCD, xcd = wgid % NXCD, off = wgid / NXCD; wgid = (xcd < r ? xcd * (q + 1) : r * (q + 1) + (xcd - r) * q) + off; }
        const int nig = WGM * nN, gid = wgid / nig, fm = gid * WGM, gsz = (nM - fm) < WGM ? (nM - fm) : WGM;
        u.pm = fm + ((wgid % nig) % gsz); u.pn = (wgid % nig) / gsz; u.bt = u.pn; return true;
    }
    __device__ __forceinline__ void a_ready(const Unit&) const {}
    __device__ __forceinline__ void done(const Unit&) const {}
};

typedef float f32x2 __attribute__((ext_vector_type(2))); typedef __bf16 bf16x2_t __attribute__((ext_vector_type(2)));
__device__ __forceinline__ unsigned cvt_pk_bf16(float lo, float hi) { const f32x2 v = {lo, hi}; const bf16x2_t b = __builtin_convertvector(v, bf16x2_t); return __builtin_bit_cast(unsigned, b); }
struct EpiInProj {
    static constexpr bool PERM = true, AFTER_DRAIN = false, HAS_MID = false;
#ifdef NO_NORMS
    static constexpr bool NORMS = false;
#else
    static constexpr bool NORMS = true;
#endif
    bf16_t *Q, *K, *V, *XR, *GY, *GATES; unsigned* qkmax;
    template <int CAT> __device__ __forceinline__ void run(const f32x4 (&acc)[2][2][4][2], bf16_t* base, int ldc, int row0, int col0, unsigned* mx) const {
        float nrm = 0.f;
#pragma unroll
        for (int ai = 0; ai < 2; ++ai)
#pragma unroll
            for (int m = 0; m < 4; ++m) { bf16_t* rowp = base + (size_t)(row0 + ai * HALF + m * 16) * ldc + col0; float ss = 0.f;
#pragma unroll
                for (int bj = 0; bj < 2; ++bj) { f32x4 v0 = acc[ai][bj][m][0], v1 = acc[ai][bj][m][1];
                    if (CAT == 0) { v0 = v0 * C2; v1 = v1 * C2; }
                    if (CAT == 4) {
#pragma unroll
                        for (int j = 0; j < 4; ++j) { v0[j] = gelu_fast(v0[j]); v1[j] = gelu_fast(v1[j]); } }
                    if (CAT == 5) {
#pragma unroll
                        for (int j = 0; j < 4; ++j) { v0[j] = sigmoid_fast(v0[j]); v1[j] = sigmoid_fast(v1[j]); } }
                    if (NORMS && CAT <= 1) ss += (v0[0] * v0[0] + v0[1] * v0[1]) + (v0[2] * v0[2] + v0[3] * v0[3]) + (v1[0] * v1[0] + v1[1] * v1[1]) + (v1[2] * v1[2] + v1[3] * v1[3]);
                    u32x4 w; w.x = cvt_pk_bf16(v0[0], v0[1]); w.y = cvt_pk_bf16(v0[2], v0[3]); w.z = cvt_pk_bf16(v1[0], v1[1]); w.w = cvt_pk_bf16(v1[2], v1[3]);
                    *(u32x4*)(rowp + bj * 32) = w; }
                if (NORMS && CAT <= 1) { ss += __shfl_xor(ss, 16); ss += __shfl_xor(ss, 32); nrm = fmaxf(nrm, ss); } }
        if (NORMS && CAT <= 1) {
#pragma unroll
            for (int o = 1; o < 16; o <<= 1) nrm = fmaxf(nrm, __shfl_xor(nrm, o));
            if ((threadIdx.x & 63) == 0) atomicMax(mx, __builtin_bit_cast(unsigned, nrm * 1.02f)); }
    }
    __device__ __forceinline__ void operator()(const f32x4 (&acc)[2][2][4][2], const Unit& u, int wr, int wc, int fr, int fq) const {
        const int pn = u.pn, row0 = u.pm * BM + wr * 64 + fr, cw = wc * 64 + 8 * fq, b = u.pm >> 5;
        if (pn < 2)       run<0>(acc, Q, 512, row0, pn * 256 + cw, qkmax + b * 16 + 0 + (pn & 1) * 4 + wc);
        else if (pn < 4)  run<1>(acc, K, 512, row0, (pn - 2) * 256 + cw, qkmax + b * 16 + 8 + (pn & 1) * 4 + wc);
        else if (pn < 6)  run<2>(acc, V, 512, row0, (pn - 4) * 256 + cw, nullptr);
        else if (pn < 8)  run<3>(acc, XR, 512, row0, (pn - 6) * 256 + cw, nullptr);
        else if (pn < 10) run<4>(acc, GY, 512, row0, (pn - 8) * 256 + cw, nullptr);
        else              run<5>(acc, GATES, 2048, row0, (pn - 10) * 256 + cw, nullptr);
    }
};
struct EpiMix {
    static constexpr bool PERM = true, AFTER_DRAIN = false, HAS_MID = true;
    const bf16_t* GATES; bf16_t* OUT;
    __device__ __forceinline__ void mid(f32x4 (&acc)[2][2][4][2], const Unit& u, int wr, int wc, int fr, int fq) const {
        int row0 = u.pm * BM + wr * 64 + fr; const int col0 = u.pn * BM + wc * 32 + 8 * fq;
        asm volatile("" : "+v"(row0));
#pragma unroll
        for (int ai = 0; ai < 2; ++ai)
#pragma unroll
            for (int m = 0; m < 4; ++m) { const bf16_t* gp = GATES + (size_t)(row0 + ai * HALF + m * 16) * 2048 + col0;
#pragma unroll
                for (int bj = 0; bj < 2; ++bj) { const u32x4 ga = *(const u32x4*)(gp + bj * HALF), gl = *(const u32x4*)(gp + 1024 + bj * HALF);
#pragma unroll
                    for (int e = 0; e < 4; ++e) { const float a0 = __builtin_bit_cast(float, ga[e] << 16), a1 = __builtin_bit_cast(float, ga[e] & 0xffff0000u);
                        const float l0 = __builtin_bit_cast(float, gl[e] << 16), l1 = __builtin_bit_cast(float, gl[e] & 0xffff0000u);
                        acc[ai][bj][m][e >> 1][(e & 1) * 2] *= a0 * __builtin_amdgcn_rcpf(l0); acc[ai][bj][m][e >> 1][(e & 1) * 2 + 1] *= a1 * __builtin_amdgcn_rcpf(l1); } }
                asm volatile("" ::: "memory"); }
    }
    __device__ __forceinline__ void operator()(const f32x4 (&acc)[2][2][4][2], const Unit& u, int wr, int wc, int fr, int fq) const {
        const int row0 = u.pm * BM + wr * 64 + fr, col0 = u.pn * BM + wc * 32 + 8 * fq;
#pragma unroll
        for (int ai = 0; ai < 2; ++ai)
#pragma unroll
            for (int m = 0; m < 4; ++m) { const size_t r = (size_t)(row0 + ai * HALF + m * 16);
#pragma unroll
                for (int bj = 0; bj < 2; ++bj) { const u32x4 gl = *(const u32x4*)(GATES + r * 2048 + 1024 + col0 + bj * HALF);
                    const f32x4 v0 = acc[ai][bj][m][0], v1 = acc[ai][bj][m][1]; u32x4 w;
                    w.x = cvt_pk_bf16(v0[0] * __builtin_bit_cast(float, gl[0] << 16), v0[1] * __builtin_bit_cast(float, gl[0] & 0xffff0000u));
                    w.y = cvt_pk_bf16(v0[2] * __builtin_bit_cast(float, gl[1] << 16), v0[3] * __builtin_bit_cast(float, gl[1] & 0xffff0000u));
                    w.z = cvt_pk_bf16(v1[0] * __builtin_bit_cast(float, gl[2] << 16), v1[1] * __builtin_bit_cast(float, gl[2] & 0xffff0000u));
                    w.w = cvt_pk_bf16(v1[2] * __builtin_bit_cast(float, gl[3] << 16), v1[3] * __builtin_bit_cast(float, gl[3] & 0xffff0000u));
                    *(u32x4*)(OUT + r * 1024 + col0 + bj * HALF) = w; }
                asm volatile("" ::: "memory"); }
    }
};
struct EpiResidF32 {
    static constexpr bool PERM = false, AFTER_DRAIN = false, HAS_MID = false;
    const float* base; float* out;
    __device__ __forceinline__ void operator()(const f32x4 (&acc)[2][2][4][2], const Unit& u, int wr, int wc, int fr, int fq) const {
        const int row0 = u.pm * BM + wr * 64 + fr, col0 = u.pn * BM + wc * 32 + 4 * fq;
#pragma unroll
        for (int ai = 0; ai < 2; ++ai)
#pragma unroll
            for (int m = 0; m < 4; ++m) { const size_t off = (size_t)(row0 + ai * HALF + m * 16) * 1024 + col0;
#pragma unroll
                for (int bj = 0; bj < 2; ++bj)
#pragma unroll
                    for (int n = 0; n < 2; ++n) *(f32x4*)(out + off + bj * HALF + n * 16) = *(const f32x4*)(base + off + bj * HALF + n * 16) + acc[ai][bj][m][n];
                asm volatile("" ::: "memory"); }
    }
};
struct MoeOrder {
    const PG8_LAS int* pad; int nunits, G, c;
    __device__ __forceinline__ void init(const PG8_LAS int* pad_, int G_, int c_) { pad = pad_; nunits = (pad_[32] >> 8) * 4; G = G_; c = c_; }
    __device__ __forceinline__ bool next(int i, Unit& u) const {
        const int L = i * G + c; if (L >= nunits) return false;
        const int tile = L >> 2, pn = L & 3, slot = tile << 8; int e = 0;
        for (int j = 1; j < 32; ++j) e += (pad[j] <= slot) ? 1 : 0;
        u.pm = tile; u.pn = pn; u.bt = e * 4 + pn; return true;
    }
    __device__ __forceinline__ void a_ready(const Unit&) const {}
    __device__ __forceinline__ void done(const Unit&) const {}
};
struct EpiSwiGLU {
    static constexpr bool PERM = true, AFTER_DRAIN = false, HAS_MID = false;
    bf16_t* H;
    __device__ __forceinline__ void operator()(const f32x4 (&acc)[2][2][4][2], const Unit& u, int wr, int wc, int fr, int fq) const {
        const int row0 = u.pm * BM + wr * 64 + fr, col0 = u.pn * HALF + wc * 32 + 8 * fq;
#pragma unroll
        for (int ai = 0; ai < 2; ++ai)
#pragma unroll
            for (int m = 0; m < 4; ++m) { float h[8];
#pragma unroll
                for (int n = 0; n < 2; ++n)
#pragma unroll
                    for (int e = 0; e < 4; ++e) { const float g = acc[ai][0][m][n][e], up = acc[ai][1][m][n][e]; h[n * 4 + e] = g * sigmoid_fast(g) * up; }
                u32x4 w; w.x = cvt_pk_bf16(h[0], h[1]); w.y = cvt_pk_bf16(h[2], h[3]); w.z = cvt_pk_bf16(h[4], h[5]); w.w = cvt_pk_bf16(h[6], h[7]);
                *(u32x4*)(H + (size_t)(row0 + ai * HALF + m * 16) * 512 + col0) = w; }
    }
};
struct EpiStoreBf16 {
    static constexpr bool PERM = true, AFTER_DRAIN = false, HAS_MID = false;
    bf16_t* O; int ldc;
    __device__ __forceinline__ void operator()(const f32x4 (&acc)[2][2][4][2], const Unit& u, int wr, int wc, int fr, int fq) const {
        const int row0 = u.pm * BM + wr * 64 + fr, col0 = u.pn * BM + wc * 32 + 8 * fq;
#pragma unroll
        for (int ai = 0; ai < 2; ++ai)
#pragma unroll
            for (int m = 0; m < 4; ++m) { bf16_t* rowp = O + (size_t)(row0 + ai * HALF + m * 16) * ldc + col0;
#pragma unroll
                for (int bj = 0; bj < 2; ++bj) { const f32x4 v0 = acc[ai][bj][m][0], v1 = acc[ai][bj][m][1]; u32x4 w;
                    w.x = cvt_pk_bf16(v0[0], v0[1]); w.y = cvt_pk_bf16(v0[2], v0[3]); w.z = cvt_pk_bf16(v1[0], v1[1]); w.w = cvt_pk_bf16(v1[2], v1[3]);
                    *(u32x4*)(rowp + bj * HALF) = w; } }
    }
};
template <class Epi, class Sched, bool ALIGN_EPI = false, bool SP2 = false>
__device__ __forceinline__ void gemm_phase(PG8_LAS unsigned char* lds, const Gemm g, const Sched& S, const Epi& E) {
    int tid_ = threadIdx.x; asm volatile("" : "+v"(tid_));
    const int tid = tid_, wid = __builtin_amdgcn_readfirstlane(tid >> 6), lane = tid & 63, wr = wid >> 2, wc = wid & 3, fr = lane & 15, fq = lane >> 4;
    const int K = g.K, nt = K / BK;
    unsigned voffA[2], voffB[2];
#pragma unroll
    for (int i = 0; i < 2; ++i) { int R, C; stage_rc(tid * 16 + i * 8192, R, C); const int Rb = Epi::PERM ? ((R & ~31) + perm32(R & 31)) : R;
        voffA[i] = (unsigned)(R * K + C) * 2u; voffB[i] = (unsigned)(Rb * K + C) * 2u; }
    const size_t kstep = (size_t)(BK * 2);
    const size_t hstep = (size_t)HALF * K * 2;
    const size_t tstep = 2 * hstep;
    const unsigned ldsw = (unsigned)wid * 1024u;
    const int aoff = lds_byte(wr * 64 + fr, fq * 8), boff = lds_byte(wc * 32 + fr, fq * 8);
#define PG8_SA(b, h) (((b) * 2 + (h)) * HTB)
#define PG8_SB(b, h) ((4 + (b) * 2 + (h)) * HTB)
#define PG8_STAGE(bufoff, gbase, voff) do { _Pragma("unroll") for (int _i = 0; _i < 2; ++_i) \
        __builtin_amdgcn_global_load_lds((const unsigned*)((const char*)(gbase) + (voff)[_i]), (PG8_LAS unsigned*)(lds + (bufoff) + ldsw + _i * 8192), 16, 0, 0); } while (0)
#define PG8_LDA(dst, b, h) do { _Pragma("unroll") for (int m = 0; m < 4; ++m) _Pragma("unroll") for (int k = 0; k < 2; ++k) dst[m][k] = *(const PG8_LAS bf16x8*)(lds + PG8_SA(b, h) + aoff + m * 2048 + k * 1024); } while (0)
#define PG8_LDB(dst, b, h) do { _Pragma("unroll") for (int n = 0; n < 2; ++n) _Pragma("unroll") for (int k = 0; k < 2; ++k) dst[n][k] = *(const PG8_LAS bf16x8*)(lds + PG8_SB(b, h) + boff + n * 2048 + k * 1024); } while (0)
#define PG8_MMA(ai, bj, At, Bt) do { __builtin_amdgcn_s_setprio(1); _Pragma("unroll") for (int m = 0; m < 4; ++m) _Pragma("unroll") for (int n = 0; n < 2; ++n) _Pragma("unroll") for (int k = 0; k < 2; ++k) \
        acc[ai][bj][m][n] = __builtin_amdgcn_mfma_f32_16x16x32_bf16(Bt[n][k], At[m][k], acc[ai][bj][m][n], 0, 0, 0); __builtin_amdgcn_s_setprio(0); } while (0)
#define PG8_WAIT_V(n) asm volatile("s_waitcnt vmcnt(" #n ")" ::: "memory")
#define PG8_WAIT_L(n) asm volatile("s_waitcnt lgkmcnt(" #n ")" ::: "memory")
#define PG8_BAR __builtin_amdgcn_s_barrier()
#define PG8_SCHED __builtin_amdgcn_sched_barrier(0)
    Unit cur, nxt; int ui = 0;
    if (!S.next(0, cur)) return;
    f32x4 acc[2][2][4][2];
#pragma unroll
    for (int a = 0; a < 2; ++a)
#pragma unroll
        for (int b = 0; b < 2; ++b)
#pragma unroll
            for (int m = 0; m < 4; ++m)
#pragma unroll
                for (int n = 0; n < 2; ++n) acc[a][b][m][n] = (f32x4){0.f, 0.f, 0.f, 0.f};
    bf16x8 At[4][2], B0[2][2], B1[2][2];
    const char* cA = (const char*)g.A + (size_t)cur.pm * tstep; const char* cB = (const char*)g.Bt + (size_t)cur.bt * tstep;
    S.a_ready(cur);
    if constexpr (SP2) {
        PG8_STAGE(PG8_SB(0, 0), cB, voffB); PG8_STAGE(PG8_SB(0, 1), cB + hstep, voffB); PG8_STAGE(PG8_SA(0, 0), cA, voffA); PG8_STAGE(PG8_SA(0, 1), cA + hstep, voffA);
        if (wr == 1) PG8_BAR;
        PG8_WAIT_V(2); PG8_BAR;
        PG8_STAGE(PG8_SB(1, 0), cB + kstep, voffB); PG8_STAGE(PG8_SA(1, 0), cA + kstep, voffA); PG8_STAGE(PG8_SB(1, 1), cB + hstep + kstep, voffB);
        PG8_WAIT_V(6); PG8_BAR;
    } else {
        PG8_STAGE(PG8_SB(0, 0), cB, voffB); PG8_STAGE(PG8_SA(0, 0), cA, voffA); PG8_STAGE(PG8_SB(0, 1), cB + hstep, voffB); PG8_STAGE(PG8_SA(0, 1), cA + hstep, voffA);
        if (wr == 1) PG8_BAR;
        PG8_WAIT_V(4); PG8_BAR;
        PG8_STAGE(PG8_SB(1, 0), cB + kstep, voffB); PG8_STAGE(PG8_SA(1, 0), cA + kstep, voffA); PG8_STAGE(PG8_SB(1, 1), cB + hstep + kstep, voffB);
        PG8_WAIT_V(6); PG8_BAR;
    }
    for (;;) {
        const bool has_next = S.next(ui + 1, nxt);
        const char* nA = has_next ? (const char*)g.A + (size_t)nxt.pm * tstep : cA; const char* nB = has_next ? (const char*)g.Bt + (size_t)nxt.bt * tstep : cB;
        for (int t = 0; t < nt; t += 2) {
            const bool last = (t == nt - 2);
            if constexpr (Epi::HAS_MID) { if (t == (nt >> 1)) E.mid(acc, cur, wr, wc, fr, fq); }
            const char* a1 = cA + (size_t)(t + 1) * kstep;
            const char* a2 = last ? nA : cA + (size_t)(t + 2) * kstep; const char* b2 = last ? nB : cB + (size_t)(t + 2) * kstep;
            const char* a3 = a2 + kstep; const char* b3 = b2 + kstep;
            if (last && has_next) S.a_ready(nxt);
            if constexpr (SP2) {
            PG8_LDB(B0, 0, 0); PG8_LDB(B1, 0, 1); PG8_SCHED; PG8_LDA(At, 0, 0); PG8_STAGE(PG8_SA(1, 1), a1 + hstep, voffA);
            PG8_WAIT_V(8); PG8_WAIT_L(0); PG8_BAR; PG8_MMA(0, 0, At, B0); PG8_MMA(0, 1, At, B1); PG8_BAR; PG8_SCHED;
            PG8_LDA(At, 0, 1); PG8_STAGE(PG8_SB(0, 0), b2, voffB); PG8_STAGE(PG8_SB(0, 1), b2 + hstep, voffB); PG8_STAGE(PG8_SA(0, 0), a2, voffA);
            PG8_WAIT_V(8); PG8_WAIT_L(0); PG8_BAR; PG8_MMA(1, 0, At, B0); PG8_MMA(1, 1, At, B1); PG8_BAR; PG8_SCHED;
            PG8_LDB(B0, 1, 0); PG8_LDB(B1, 1, 1); PG8_SCHED; PG8_LDA(At, 1, 0); PG8_STAGE(PG8_SA(0, 1), a2 + hstep, voffA);
            PG8_WAIT_V(8); PG8_WAIT_L(0); PG8_BAR; PG8_MMA(0, 0, At, B0); PG8_MMA(0, 1, At, B1); PG8_BAR; PG8_SCHED;
            PG8_LDA(At, 1, 1); PG8_STAGE(PG8_SB(1, 0), b3, voffB); PG8_STAGE(PG8_SB(1, 1), b3 + hstep, voffB); PG8_STAGE(PG8_SA(1, 0), a3, voffA);
            PG8_WAIT_V(8); PG8_WAIT_L(0); PG8_BAR; PG8_MMA(1, 0, At, B0); PG8_MMA(1, 1, At, B1); PG8_BAR; PG8_SCHED;
            } else {
            PG8_LDB(B0, 0, 0); PG8_SCHED; PG8_LDA(At, 0, 0); PG8_STAGE(PG8_SA(1, 1), a1 + hstep, voffA);
            PG8_WAIT_L(8); PG8_BAR; PG8_WAIT_L(0); PG8_MMA(0, 0, At, B0); PG8_BAR; PG8_SCHED;
            PG8_LDB(B1, 0, 1); PG8_STAGE(PG8_SB(0, 0), b2, voffB);
            PG8_BAR; PG8_WAIT_L(0); PG8_MMA(0, 1, At, B1); PG8_BAR;
            PG8_LDA(At, 0, 1); PG8_STAGE(PG8_SA(0, 0), a2, voffA);
            PG8_BAR; PG8_WAIT_L(0); PG8_MMA(1, 0, At, B0); PG8_BAR; PG8_SCHED;
            PG8_STAGE(PG8_SB(0, 1), b2 + hstep, voffB);
            PG8_WAIT_V(6); PG8_BAR; PG8_MMA(1, 1, At, B1); PG8_BAR;
            PG8_LDB(B0, 1, 0); PG8_SCHED; PG8_LDA(At, 1, 0); PG8_STAGE(PG8_SA(0, 1), a2 + hstep, voffA);
            PG8_WAIT_L(8); PG8_BAR; PG8_WAIT_L(0); PG8_MMA(0, 0, At, B0); PG8_BAR; PG8_SCHED;
            PG8_LDB(B1, 1, 1); PG8_STAGE(PG8_SB(1, 0), b3, voffB);
            PG8_BAR; PG8_WAIT_L(0); PG8_MMA(0, 1, At, B1); PG8_BAR;
            PG8_LDA(At, 1, 1); PG8_STAGE(PG8_SA(1, 0), a3, voffA);
            PG8_BAR; PG8_WAIT_L(0); PG8_MMA(1, 0, At, B0); PG8_BAR; PG8_SCHED;
            PG8_STAGE(PG8_SB(1, 1), b3 + hstep, voffB);
            PG8_WAIT_V(6); PG8_BAR; PG8_MMA(1, 1, At, B1); PG8_BAR;
            }
        }
        if constexpr (ALIGN_EPI) { if (wr == 0) PG8_BAR; }
        if constexpr (!Epi::AFTER_DRAIN) { E(acc, cur, wr, wc, fr, fq); S.done(cur); }
        if (!has_next) break;
#pragma unroll
        for (int a = 0; a < 2; ++a)
#pragma unroll
            for (int b = 0; b < 2; ++b)
#pragma unroll
                for (int m = 0; m < 4; ++m)
#pragma unroll
                    for (int n = 0; n < 2; ++n) acc[a][b][m][n] = (f32x4){0.f, 0.f, 0.f, 0.f};
        cur = nxt; cA = nA; cB = nB; ++ui;
        if constexpr (ALIGN_EPI) { if (wr == 1) PG8_BAR; }
    }
    PG8_WAIT_V(0);
    if constexpr (!ALIGN_EPI) { if (wr == 0) PG8_BAR; }
    PG8_BAR;
    if constexpr (Epi::AFTER_DRAIN) { E.fused(acc, cur, wr, wc, fr, fq, lds, wid, lane); S.done(cur); }
#undef PG8_SA
#undef PG8_SB
#undef PG8_STAGE
#undef PG8_LDA
#undef PG8_LDB
#undef PG8_MMA
#undef PG8_WAIT_V
#undef PG8_WAIT_L
#undef PG8_BAR
#undef PG8_SCHED
}
}
#define GAS __attribute__((address_space(1)))
#define LAS __attribute__((address_space(3)))
typedef unsigned v4u __attribute__((ext_vector_type(4)));
typedef float f32x4 __attribute__((ext_vector_type(4)));
typedef short bf16x8 __attribute__((ext_vector_type(8)));
typedef GAS unsigned gu32;
typedef GAS unsigned long long gu64;
#define RLX_AGENT __ATOMIC_RELAXED, __HIP_MEMORY_SCOPE_AGENT
#define LDS_WAIT() asm volatile("s_waitcnt lgkmcnt(0)" ::: "memory")
#define VM_WAIT() asm volatile("s_waitcnt vmcnt(0)" ::: "memory")
#define XB_TMO      128
#define XB_XCNT(j)  (256  + 64 * (j))
#define XB_XSUB(j)  (1280 + 64 * (j))
#define XB_XGEN(j)  (2304 + 64 * (j))
#define XB_TOP      3328
#define XB_TOPGEN   3392
#define XCD_BAR_WORDS 3456
#define XB_SPIN_CAP (1u << 18)

__device__ __forceinline__ unsigned xb_ld(unsigned* p)              { return __hip_atomic_load(p, __ATOMIC_RELAXED, __HIP_MEMORY_SCOPE_AGENT); }
__device__ __forceinline__ unsigned xb_add(unsigned* p, unsigned v) { return __hip_atomic_fetch_add(p, v, __ATOMIC_RELAXED, __HIP_MEMORY_SCOPE_AGENT); }
__device__ __forceinline__ unsigned xb_xcc_id() { return (unsigned)__builtin_amdgcn_s_getreg((3 << 11) | 20) & 0xFu; }
#define XB_SPIN(cond, bar) do { unsigned _sp = 0; while (cond) { __builtin_amdgcn_s_sleep(1); \
    if ((++_sp & 255u) == 0u) { if (xb_ld(&(bar)[XB_TMO])) break; if (_sp > XB_SPIN_CAP) { atomicAdd(&(bar)[XB_TMO], 1u); break; } } } } while (0)

struct XcdBarrier {
    unsigned* bar; unsigned x;
    volatile LAS unsigned* st;
};

__device__ __forceinline__ XcdBarrier xcd_barrier_post(unsigned* bar, volatile LAS unsigned* st) {
    XcdBarrier b; b.bar = bar; b.x = xb_xcc_id(); b.st = st;
    if (threadIdx.x == 0) (void)xb_add(&bar[XB_XCNT(b.x)], 1u);
    return b;
}
__device__ __forceinline__ void xcd_barrier_complete(unsigned* bar, unsigned x, unsigned& nloc, unsigned& nx) {
    const unsigned G = gridDim.x * gridDim.y * gridDim.z;
    unsigned sum, cnt, mine, sp = 0u;
    for (;;) {
        sum = 0u; cnt = 0u; mine = 0u;
#pragma unroll
        for (unsigned j = 0; j < 16; ++j) { const unsigned c = xb_ld(&bar[XB_XCNT(j)]); sum += c; cnt += (c > 0u) ? 1u : 0u; mine = (j == x) ? c : mine; }
        if (sum == G) break;
        __builtin_amdgcn_s_sleep(1);
        if ((++sp & 255u) == 0u) { if (xb_ld(&bar[XB_TMO])) break; if (sp > XB_SPIN_CAP) { atomicAdd(&bar[XB_TMO], 1u); break; } }
    }
    nloc = mine > 0u ? mine : 1u; nx = cnt > 0u ? cnt : 1u;
}

__device__ __forceinline__ void xcd_barrier(const XcdBarrier& b) {
    asm volatile("s_waitcnt vmcnt(0)" ::: "memory");
    __syncthreads();
    if (threadIdx.x == 0) {
        unsigned* bar = b.bar;
        __builtin_amdgcn_s_waitcnt(0);
        unsigned nloc = b.st[0], nx = b.st[1];
        if (nloc == 0u) { xcd_barrier_complete(bar, b.x, nloc, nx); b.st[0] = nloc; b.st[1] = nx; }
        const unsigned old = xb_add(&bar[XB_XSUB(b.x)], 1u);
        const unsigned gen = old / nloc;
        if (old + 1u == (gen + 1u) * nloc) {
            __builtin_amdgcn_fence(__ATOMIC_RELEASE, "agent");
            asm volatile("s_waitcnt vmcnt(0)" ::: "memory");
            const unsigned og = xb_add(&bar[XB_TOP], 1u);
            const unsigned tg = og / nx;
            if (og + 1u == (tg + 1u) * nx) xb_add(&bar[XB_TOPGEN], 1u);
            else XB_SPIN(xb_ld(&bar[XB_TOPGEN]) == tg, bar);
            __builtin_amdgcn_fence(__ATOMIC_ACQUIRE, "agent");
            xb_add(&bar[XB_XGEN(b.x)], 1u);
            asm volatile("s_waitcnt vmcnt(0)" ::: "memory");
        } else {
            XB_SPIN(xb_ld(&bar[XB_XGEN(b.x)]) == gen, bar);
            __builtin_amdgcn_fence(__ATOMIC_ACQUIRE, "agent");
            asm volatile("s_waitcnt vmcnt(0)" ::: "memory");
        }
    }
    __syncthreads();
}

constexpr int NWAVES = 8;
constexpr int RING_OFF = 0, RING_BYTES = 131072;
constexpr int SCR_BYTES = 147456;
constexpr int LDSCTL_OFF = SCR_BYTES, MISC_OFF = LDSCTL_OFF + 320;
constexpr int LDS_BYTES = SCR_BYTES + 4096;
static_assert(MISC_OFF + 128 <= LDS_BYTES && LDS_BYTES <= 163840, "LDS map");

struct Frame {
    LAS unsigned char* lds;
    volatile LAS unsigned* MISC;
    gu32* ctl;
    int tid, lane, wave, vcu, G;
    const float* in[22]; float* out; unsigned char* ws;
};
__device__ __forceinline__ float wave_sum(float v) {
#pragma unroll
    for (int o = 1; o < 64; o <<= 1) v += __shfl_xor(v, o);
    return v;
}

__device__ __forceinline__ void p0_tr64(const float* W, int ldn, int k0, int n0, bf16* dst, int ldk, LAS float* scr, int lane) {
    const int lr = lane >> 4, lc = (lane & 15) * 4;
#pragma unroll 4
    for (int i = 0; i < 16; ++i) { const int kk = 4 * i + lr; const f32x4 v = *(const GAS f32x4*)(W + (size_t)(k0 + kk) * ldn + n0 + lc);
        LAS float* s = scr + kk * 65 + lc; s[0] = v[0]; s[1] = v[1]; s[2] = v[2]; s[3] = v[3]; }
    LDS_WAIT(); asm volatile("" ::: "memory");
    const int c = lane & 7;
#pragma unroll
    for (int j = 0; j < 8; ++j) { const int n = (lane >> 3) + 8 * j; const LAS float* s = scr + (8 * c) * 65 + n;
        v4u o; o.x = pk2(s[0 * 65], s[1 * 65]); o.y = pk2(s[2 * 65], s[3 * 65]); o.z = pk2(s[4 * 65], s[5 * 65]); o.w = pk2(s[6 * 65], s[7 * 65]);
        *(GAS v4u*)(dst + (size_t)n * ldk + 8 * c) = o; }
    LDS_WAIT(); asm volatile("" ::: "memory");
}
__device__ __forceinline__ int incol_row(int c) { const int w = c & 255; return (c & ~255) + ((w >> 5) & 1) * 128 + (w >> 6) * 32 + (w & 31); }

__device__ __forceinline__ void p0_prologue(Frame& F) {
    LAS float* scr = (LAS float*)(F.lds + F.wave * 16640);
    const int gw = F.vcu * NWAVES + F.wave, NGW = F.G * NWAVES, lane = F.lane;
    bf16* Wt_in = (bf16*)(F.ws + WS_WIN); bf16* Wt_mix = (bf16*)(F.ws + WS_WMIX); bf16* Wt_out = (bf16*)(F.ws + WS_WOUT); bf16* Wt_gu = (bf16*)(F.ws + WS_WGU); bf16* Wt_d = (bf16*)(F.ws + WS_WD);
    constexpr int I_IN = 16 * 72, I_OA = 8 * 16, I_OL = 8 * 16, I_OUT = 16 * 16, I_G = 32 * 16 * 8, I_U = I_G, I_D = 32 * 8 * 16;
    constexpr int NITEMS = I_IN + I_OA + I_OL + I_OUT + I_G + I_U + I_D;
    for (int it = gw; it < NITEMS; it += NGW) {
        int r = it;
        if (r < I_IN) { const int kb = r / 72, nb = r % 72, n0 = nb * 64; const int w = n0 & 255;
            const int lr = lane >> 4, lc = (lane & 15) * 4; const float* W = F.in[2];
#pragma unroll 4
            for (int i = 0; i < 16; ++i) { const int kk = 4 * i + lr; const f32x4 v = *(const GAS f32x4*)(W + (size_t)(kb * 64 + kk) * INC + n0 + lc);
                LAS float* s = scr + kk * 65 + lc; s[0] = v[0]; s[1] = v[1]; s[2] = v[2]; s[3] = v[3]; }
            LDS_WAIT(); asm volatile("" ::: "memory");
            const int c = lane & 7;
#pragma unroll
            for (int j = 0; j < 8; ++j) { const int n = (lane >> 3) + 8 * j; const LAS float* s = scr + (8 * c) * 65 + n;
                v4u o; o.x = pk2(s[0 * 65], s[1 * 65]); o.y = pk2(s[2 * 65], s[3 * 65]); o.z = pk2(s[4 * 65], s[5 * 65]); o.w = pk2(s[6 * 65], s[7 * 65]);
                *(GAS v4u*)(Wt_in + (size_t)incol_row(n0 + n) * 1024 + kb * 64 + 8 * c) = o; }
            LDS_WAIT(); asm volatile("" ::: "memory"); (void)w;
            continue; } r -= I_IN;
        if (r < I_OA) { const int kb = r / 16, nb = r % 16; p0_tr64(F.in[12], 1024, kb * 64, nb * 64, Wt_mix + (size_t)(nb * 64) * 1024 + kb * 64, 1024, scr, lane); continue; } r -= I_OA;
        if (r < I_OL) { const int kb = r / 16, nb = r % 16; p0_tr64(F.in[13], 1024, kb * 64, nb * 64, Wt_mix + (size_t)(nb * 64) * 1024 + 512 + kb * 64, 1024, scr, lane); continue; } r -= I_OL;
        if (r < I_OUT) { const int kb = r / 16, nb = r % 16; p0_tr64(F.in[14], 1024, kb * 64, nb * 64, Wt_out + (size_t)(nb * 64) * 1024 + kb * 64, 1024, scr, lane); continue; } r -= I_OUT;
        if (r < I_G) { const int e = r / 128, q = r % 128, kb = q / 8, nb = q % 8, n0 = nb * 64;
            p0_tr64(F.in[18] + (size_t)e * 1024 * 512, 512, kb * 64, n0, Wt_gu + (size_t)(e * 1024 + (n0 >> 7) * 256 + (n0 & 127)) * 1024 + kb * 64, 1024, scr, lane); continue; } r -= I_G;
        if (r < I_U) { const int e = r / 128, q = r % 128, kb = q / 8, nb = q % 8, n0 = nb * 64;
            p0_tr64(F.in[19] + (size_t)e * 1024 * 512, 512, kb * 64, n0, Wt_gu + (size_t)(e * 1024 + (n0 >> 7) * 256 + 128 + (n0 & 127)) * 1024 + kb * 64, 1024, scr, lane); continue; } r -= I_U;
        { const int e = r / 128, q = r % 128, kb = q / 16, nb = q % 16;
            p0_tr64(F.in[20] + (size_t)e * 512 * 1024, 1024, kb * 64, nb * 64, Wt_d + (size_t)(e * 1024 + nb * 64) * 512 + kb * 64, 512, scr, lane); }
    }
    { bf16* WER = (bf16*)(F.ws + WS_MISC + 1536 * 1024); const float* gf = F.in[15];
      for (int idx = gw * 64 + lane; idx < 36 * 1024; idx += NGW * 64) { const int row = idx >> 10, k = idx & 1023;
          const float w = (row < 32 ? F.in[17][(size_t)(row >> 3) * 8192 + k * 8 + (row & 7)] : F.in[16][k * 4 + (row - 32)]) * gf[k];
          const unsigned h = f2bf(w), l = f2bf(w - __builtin_bit_cast(float, h << 16));
          const int pos = row * 1024 + ((((k >> 3) ^ (row & 15))) << 3) + (k & 7);
          WER[pos] = (bf16)h; WER[36 * 1024 + pos] = (bf16)l; } }
    bf16* XN = (bf16*)(F.ws + WS_XN); const float* x = F.in[0]; const float* g = F.in[1];
    f32x4 gv[4];
#pragma unroll
    for (int j = 0; j < 4; ++j) gv[j] = ((const GAS f32x4*)g)[lane + 64 * j];
    for (int m = gw; m < NTOK; m += NGW) {
        const GAS f32x4* xr = (const GAS f32x4*)(x + (size_t)m * DM) + lane;
        f32x4 v[4]; float s = 0.f;
#pragma unroll
        for (int j = 0; j < 4; ++j) { v[j] = xr[64 * j]; s += (v[j].x * v[j].x + v[j].y * v[j].y) + (v[j].z * v[j].z + v[j].w * v[j].w); }
        const float rstd = rsqrtf(wave_sum(s) * (1.f / DM) + EPS);
        GAS unsigned long long* o8 = (GAS unsigned long long*)(XN + (size_t)m * DM) + lane;
#pragma unroll
        for (int j = 0; j < 4; ++j) o8[64 * j] = (unsigned long long)pk2(v[j].x * rstd * gv[j].x, v[j].y * rstd * gv[j].y) | ((unsigned long long)pk2(v[j].z * rstd * gv[j].z, v[j].w * rstd * gv[j].w) << 32);
    }
}

namespace att {
typedef float f32x16 __attribute__((ext_vector_type(16)));
typedef short s16x4 __attribute__((ext_vector_type(4)));
typedef short v4i16_t __attribute__((ext_vector_type(4)));
constexpr int KROW = 128;
constexpr int KT = 64 * KROW;
constexpr int STAGE = 2 * KT + 16384;
constexpr int VOFF = 2 * KT;
constexpr int CW_AQ = 192;
constexpr float WIN_T = 40.f;
__device__ __forceinline__ s16x4 vtr(const LAS unsigned char* p) { return __builtin_bit_cast(s16x4, __builtin_amdgcn_ds_read_tr16_b64_v4i16((LAS v4i16_t*)p)); }

struct RowState { float mrun, lrun; };
template <int ABL> __device__ __forceinline__ void soft_tile(const LAS unsigned char* lds, int ko, const bf16x8 (&qr)[4], int t, int qpos, int qmin, int hi, float slope2, RowState& st, f32x16 (&o)[4], bf16x8 (&pa)[4]) {
    f32x16 p0, p1;
#pragma unroll
    for (int r = 0; r < 16; ++r) { p0[r] = 0.f; p1[r] = 0.f; }
#pragma unroll
    for (int d0 = 0; d0 < 4; ++d0) {
        const LAS unsigned char* kq = lds + (ko ^ (d0 * 32));
        const bf16x8 k0 = *(const LAS bf16x8*)(kq);
        const bf16x8 k1 = *(const LAS bf16x8*)(kq + 32 * KROW);
        if (ABL & 4) { if (d0 == 0) { p0[0] = (float)k0[0]; p1[0] = (float)k1[0]; } continue; }
        p0 = __builtin_amdgcn_mfma_f32_32x32x16_bf16(k0, qr[d0], p0, 0, 0, 0);
        p1 = __builtin_amdgcn_mfma_f32_32x32x16_bf16(k1, qr[d0], p1, 0, 0, 0);
    }
    if (ABL & 1) {
#pragma unroll
        for (int s = 0; s < 4; ++s) { v4u w;
#pragma unroll
            for (int e = 0; e < 4; ++e) { const int r = 8 * (s & 1) + 2 * e; w[e] = (s < 2) ? pg8::cvt_pk_bf16(p0[r], p0[r + 1]) : pg8::cvt_pk_bf16(p1[r], p1[r + 1]); }
            pa[s] = __builtin_bit_cast(bf16x8, w); }
        st.lrun += 1.f; return; }
    const float bb = slope2 * (float)(64 * t + 4 * hi - qpos);
    float rm = -1e30f;
    if (64 * t + 63 > qmin) {
#pragma unroll
        for (int r = 0; r < 16; ++r) { const int kk = (r & 3) + 8 * (r >> 2), key = 64 * t + 4 * hi + kk;
            float x0 = p0[r] + (bb + slope2 * (float)kk), x1 = p1[r] + (bb + slope2 * (float)(kk + 32));
            if (key > qpos) x0 = -1e30f; if (key + 32 > qpos) x1 = -1e30f;
            p0[r] = x0; p1[r] = x1; rm = fmaxf(rm, fmaxf(x0, x1)); }
    } else {
#pragma unroll
        for (int r = 0; r < 16; ++r) { const int kk = (r & 3) + 8 * (r >> 2);
            const float x0 = p0[r] + (bb + slope2 * (float)kk), x1 = p1[r] + (bb + slope2 * (float)(kk + 32));
            p0[r] = x0; p1[r] = x1; rm = fmaxf(rm, fmaxf(x0, x1)); }
    }
    rm = fmaxf(rm, __shfl_xor(rm, 32));
    const float mnew = fmaxf(st.mrun, rm);
    if (__any(mnew > st.mrun)) {
        const float alpha = __builtin_amdgcn_exp2f(st.mrun - mnew);
        st.lrun *= alpha;
#pragma unroll
        for (int vb = 0; vb < 4; ++vb)
#pragma unroll
            for (int r = 0; r < 16; ++r) o[vb][r] *= alpha;
        st.mrun = mnew;
    }
    const float mref = st.mrun;
    float ls = 0.f;
#pragma unroll
    for (int r = 0; r < 16; ++r) { p0[r] = __builtin_amdgcn_exp2f(p0[r] - mref); p1[r] = __builtin_amdgcn_exp2f(p1[r] - mref); ls += p0[r] + p1[r]; }
    st.lrun += ls;
#pragma unroll
    for (int s = 0; s < 4; ++s) { v4u w;
#pragma unroll
        for (int e = 0; e < 4; ++e) { const int r = 8 * (s & 1) + 2 * e; w[e] = (s < 2) ? pg8::cvt_pk_bf16(p0[r], p0[r + 1]) : pg8::cvt_pk_bf16(p1[r], p1[r + 1]); }
        pa[s] = __builtin_bit_cast(bf16x8, w); }
}
template <int ABL> __device__ __forceinline__ void pv_tile(const LAS unsigned char* vp, const bf16x8 (&pa)[4], f32x16 (&o)[4]) {
    if (ABL & 2) { o[0][0] += (float)pa[0][0]; return; }
#pragma unroll
    for (int vb = 0; vb < 4; ++vb)
#pragma unroll
        for (int s = 0; s < 4; ++s) {
            const s16x4 lo = vtr(vp + vb * 4096 + s * 1024), hh = vtr(vp + vb * 4096 + s * 1024 + 512);
            const bf16x8 vf = (bf16x8){lo[0], lo[1], lo[2], lo[3], hh[0], hh[1], hh[2], hh[3]};
            o[vb] = __builtin_amdgcn_mfma_f32_32x32x16_bf16(vf, pa[s], o[vb], 0, 0, 0);
        }
}

template <int ABL> __device__ __forceinline__ void attn_unit(Frame& F, int b, int h, int qblk, float lam, bf16* AL, int ldo) {
    int lane_ = F.lane; asm volatile("" : "+v"(lane_));
    const int lane = lane_, wid = F.wave, r32 = lane & 31, hi = lane >> 5;
    const int m = wid >> 2, j4 = wid & 3;
    const bf16* Qb = (const bf16*)(F.ws + WS_Q); const bf16* Kb = (const bf16*)(F.ws + WS_K); const bf16* Vb = (const bf16*)(F.ws + WS_V);
    LAS unsigned char* lds = F.lds;
    const size_t rowbase = (size_t)b * SEQ;
    const int qpos = qblk * 128 + j4 * 32 + r32;
    const int qmin = qblk * 128 + j4 * 32;
    const float slope2 = __builtin_amdgcn_exp2f(-2.f * (float)(h + 1)) * LOG2E;
    int tlo_w, t_lo;
    { const float q0 = __uint_as_float(__hip_atomic_load(F.ctl + CW_QKMAX + b * 16 + h * 2, RLX_AGENT)), k0 = __uint_as_float(__hip_atomic_load(F.ctl + CW_QKMAX + b * 16 + 8 + h * 2, RLX_AGENT));
      const float q1 = __uint_as_float(__hip_atomic_load(F.ctl + CW_QKMAX + b * 16 + h * 2 + 1, RLX_AGENT)), k1 = __uint_as_float(__hip_atomic_load(F.ctl + CW_QKMAX + b * 16 + 8 + h * 2 + 1, RLX_AGENT));
      const float d0 = (2.f * sqrtf(q0 * k0) + WIN_T) / slope2, d1 = (2.f * sqrtf(q1 * k1) + WIN_T) / slope2;
      const int w0 = (int)fminf(d0, 16384.f), w1 = (int)fminf(d1, 16384.f);
      const int s0 = qblk * 128 - w0 - 1, s1 = qblk * 128 - w1 - 1;
      const int tl0 = s0 > 0 ? s0 >> 6 : 0, tl1 = s1 > 0 ? s1 >> 6 : 0;
      t_lo = __builtin_amdgcn_readfirstlane(tl0 < tl1 ? tl0 : tl1);
      const int sw = qmin - (m ? w1 : w0) - 1; const int tw = sw > 0 ? sw >> 6 : 0;
      tlo_w = __builtin_amdgcn_readfirstlane(tw); }
    bf16x8 qr[4];
#pragma unroll
    for (int d0 = 0; d0 < 4; ++d0) qr[d0] = *(const GAS bf16x8*)(Qb + (rowbase + qpos) * 512 + h * 128 + m * 64 + d0 * 16 + hi * 8);
    const bf16* ksrc; const bf16* vsrc0; const bf16* vsrc1;
    { const int row = 8 * wid + (lane >> 3), c = (lane & 7) ^ ((row >> 1) & 7);
      ksrc = Kb + (rowbase + row) * 512 + h * 128 + c * 8;
      const int q0 = 2 * wid, q1 = 2 * wid + 1;
      vsrc0 = Vb + (rowbase + 16 * (q0 & 3) + (lane >> 2)) * 512 + h * 128 + (q0 >> 2) * 32 + (lane & 3) * 8;
      vsrc1 = Vb + (rowbase + 16 * (q1 & 3) + (lane >> 2)) * 512 + h * 128 + (q1 >> 2) * 32 + (lane & 3) * 8; }
    const int kdst = wid * 1024, vdst0 = VOFF + ((2 * wid) >> 2) * 4096 + ((2 * wid) & 3) * 1024, vdst1 = VOFF + ((2 * wid + 1) >> 2) * 4096 + ((2 * wid + 1) & 3) * 1024;
#define ATT_DMA(t, sb) do { const size_t to_ = (size_t)(t) * 64 * 512; LAS unsigned char* s_ = lds + (sb); \
        __builtin_amdgcn_global_load_lds((const GAS unsigned*)(ksrc + to_), (LAS unsigned*)(s_ + kdst), 16, 0, 0); \
        __builtin_amdgcn_global_load_lds((const GAS unsigned*)(ksrc + to_ + 64), (LAS unsigned*)(s_ + KT + kdst), 16, 0, 0); \
        __builtin_amdgcn_global_load_lds((const GAS unsigned*)(vsrc0 + to_), (LAS unsigned*)(s_ + vdst0), 16, 0, 0); \
        __builtin_amdgcn_global_load_lds((const GAS unsigned*)(vsrc1 + to_), (LAS unsigned*)(s_ + vdst1), 16, 0, 0); } while (0)
#define BAR_L() asm volatile("s_waitcnt lgkmcnt(0)\n\ts_barrier" ::: "memory")
#define BAR_VL() asm volatile("s_waitcnt vmcnt(0) lgkmcnt(0)\n\ts_barrier" ::: "memory")
    const int kfoff = m * KT + r32 * KROW + ((hi ^ ((r32 >> 1) & 7)) * 16);
    const int vfoff = VOFF + ((lane >> 4) & 1) * 32 + (lane & 3) * 8 + (4 * hi + ((lane & 15) >> 2)) * 64;
    f32x16 o[4];
#pragma unroll
    for (int vb = 0; vb < 4; ++vb)
#pragma unroll
        for (int r = 0; r < 16; ++r) o[vb][r] = 0.f;
    RowState st{-1e30f, 0.f};
    bf16x8 pa[4];
    const int t_hi = 2 * qblk + 1;
#define ATT_ACTIVE(t) (64 * (t) <= qmin + 31 && (t) >= tlo_w)
    ATT_DMA(t_hi, 0);
    if (t_hi - 1 >= t_lo) ATT_DMA(t_hi - 1, STAGE);
    BAR_VL();
    if (m == 1) BAR_L();
    int it = 0;
    for (int t = t_hi; t >= t_lo; --t, ++it) {
        const int cur = (it & 3) * STAGE;
        int ko_ = kfoff + cur, vc_ = vfoff + cur; asm volatile("" : "+v"(ko_), "+v"(vc_));
        if (!(ABL & 8)) if (t - 2 >= t_lo) ATT_DMA(t - 2, ((it + 2) & 3) * STAGE);
        const bool act = ATT_ACTIVE(t);
        if (act) soft_tile<ABL>(lds, ko_, qr, t, qpos, qmin, hi, slope2, st, o, pa);
        BAR_L();
        if (act) pv_tile<ABL>(lds + vc_, pa, o);
        BAR_VL();
    }
    if (m == 0) BAR_L();
    BAR_L();
#undef ATT_DMA
#undef ATT_ACTIVE
    st.lrun += __shfl_xor(st.lrun, 32);
    const float inv = 1.f / st.lrun;
    LAS float* xch = (LAS float*)lds;
    if (m == 1) {
#pragma unroll
        for (int vb = 0; vb < 4; ++vb)
#pragma unroll
            for (int r = 0; r < 16; ++r) xch[(j4 * 64 + vb * 16 + r) * 64 + lane] = o[vb][r] * inv;
    }
    __syncthreads();
    if (m == 0) {
        float ss = 0.f;
#pragma unroll
        for (int vb = 0; vb < 4; ++vb)
#pragma unroll
            for (int r = 0; r < 16; ++r) { const float v = o[vb][r] * inv - lam * xch[(j4 * 64 + vb * 16 + r) * 64 + lane]; o[vb][r] = v; ss += v * v;
                if (r == 15) asm volatile("" ::: "memory"); }
        ss += __shfl_xor(ss, 32);
        const float rstd = rsqrtf(ss * (1.f / 128.f) + EPS) * 0.8f;
        const float* sg = F.in[4];
        bf16* orow = AL + (rowbase + qpos) * ldo + h * 128;
#pragma unroll
        for (int vb = 0; vb < 4; ++vb)
#pragma unroll
            for (int g = 0; g < 4; ++g) { const int vd = vb * 32 + 8 * g + 4 * hi; const f32x4 gg = *(const GAS f32x4*)(sg + vd);
                const unsigned w0 = pk2(o[vb][4 * g] * rstd * gg[0], o[vb][4 * g + 1] * rstd * gg[1]), w1 = pk2(o[vb][4 * g + 2] * rstd * gg[2], o[vb][4 * g + 3] * rstd * gg[3]);
                *(GAS unsigned long long*)(orow + vd) = (unsigned long long)w0 | ((unsigned long long)w1 << 32);
                asm volatile("" ::: "memory"); }
    }
    __syncthreads();
}

}

namespace att2 {
using att::f32x16; using att::s16x4; using att::vtr;
constexpr int KSLOT = 32768, VBASE = 65536, VSLOT = 32768, TILEK = 16384, TILEV = 16384, KMAP = 8192;
constexpr int CW_AQ2 = 200;

template <int ABL> __device__ __forceinline__ void pv16(const LAS unsigned char* vp, const bf16x8 (&pa)[4], f32x16 (&o)[4]) {
    if (ABL & 2) { o[0][0] += (float)pa[0][0]; return; }
#pragma unroll
    for (int vb = 0; vb < 4; ++vb)
#pragma unroll
        for (int s = 0; s < 4; ++s) {
            const s16x4 lo = vtr(vp + vb * 4096 + s * 1024), hh = vtr(vp + vb * 4096 + s * 1024 + 512);
            const bf16x8 vf = (bf16x8){lo[0], lo[1], lo[2], lo[3], hh[0], hh[1], hh[2], hh[3]};
            o[vb] = __builtin_amdgcn_mfma_f32_32x32x16_bf16(vf, pa[s], o[vb], 0, 0, 0);
        }
}
__device__ __forceinline__ void qk8(const LAS unsigned char* lds, int ko, const bf16x8 (&qr)[4], const f32x16& c0, const f32x16& c1, f32x16& p0, f32x16& p1) {
#pragma unroll
    for (int d0 = 0; d0 < 4; ++d0) {
        const LAS unsigned char* kq = lds + (ko ^ (d0 * 32));
        const bf16x8 k0 = *(const LAS bf16x8*)(kq), k1 = *(const LAS bf16x8*)(kq + 32 * 128);
        p0 = __builtin_amdgcn_mfma_f32_32x32x16_bf16(k0, qr[d0], d0 == 0 ? c0 : p0, 0, 0, 0);
        p1 = __builtin_amdgcn_mfma_f32_32x32x16_bf16(k1, qr[d0], d0 == 0 ? c1 : p1, 0, 0, 0);
    }
}
__device__ __forceinline__ void pack4(const f32x16& p0, const f32x16& p1, bf16x8 (&pa)[4]) {
#pragma unroll
    for (int s = 0; s < 4; ++s) { v4u w;
#pragma unroll
        for (int e = 0; e < 4; ++e) { const int r = 8 * (s & 1) + 2 * e; w[e] = (s < 2) ? pg8::cvt_pk_bf16(p0[r], p0[r + 1]) : pg8::cvt_pk_bf16(p1[r], p1[r + 1]); }
        pa[s] = __builtin_bit_cast(bf16x8, w); }
}

template <int ABL> __device__ __forceinline__ void attn_unit(Frame& F, int b, int h, int qb, float lam, int w0, int w1, bf16* AL, int ldo) {
    int lane_ = F.lane; asm volatile("" : "+v"(lane_));
    const int lane = lane_, wid = F.wave, r32 = lane & 31, hi = lane >> 5;
    const int m = wid >> 2, ks = (wid >> 1) & 1, rb = wid & 1;
    const bf16* Qb = (const bf16*)(F.ws + WS_Q); const bf16* Kb = (const bf16*)(F.ws + WS_K); const bf16* Vb = (const bf16*)(F.ws + WS_V);
    LAS unsigned char* lds = F.lds;
    const size_t rowbase = (size_t)b * SEQ;
    const int qmin = qb * 64 + rb * 32, qpos = qmin + r32;
    const float slope2 = __builtin_amdgcn_exp2f(-2.f * (float)(h + 1)) * LOG2E;
    const int t_hi = qb;
    int t_lo, nact;
    { const int wmax = w0 > w1 ? w0 : w1, s_u = qb * 64 - wmax - 1; t_lo = s_u > 0 ? s_u >> 6 : 0;
      const int s_w = qmin - (m ? w1 : w0) - 1; const int tlw = s_w > 0 ? s_w >> 6 : 0;
      const int tf = t_hi - ks;
      nact = tf >= tlw ? ((tf - tlw) >> 1) + 1 : 0; }
    const int ntrips = (t_hi - t_lo + 2) >> 1;
    bf16x8 qr[4];
#pragma unroll
    for (int d0 = 0; d0 < 4; ++d0) qr[d0] = *(const GAS bf16x8*)(Qb + (rowbase + qpos) * 512 + h * 128 + m * 64 + d0 * 16 + hi * 8);
    const bf16* ksrc; const bf16* vsrc0; const bf16* vsrc1;
    { const int row = 8 * wid + (lane >> 3), c = (lane & 7) ^ ((row >> 1) & 7);
      ksrc = Kb + (rowbase + row) * 512 + h * 128 + c * 8;
      const int q0 = 2 * wid, q1 = 2 * wid + 1;
      vsrc0 = Vb + (rowbase + 16 * (q0 & 3) + (lane >> 2)) * 512 + h * 128 + (q0 >> 2) * 32 + (lane & 3) * 8;
      vsrc1 = Vb + (rowbase + 16 * (q1 & 3) + (lane >> 2)) * 512 + h * 128 + (q1 >> 2) * 32 + (lane & 3) * 8; }
    const int kdst = wid * 1024, vdst0 = ((2 * wid) >> 2) * 4096 + ((2 * wid) & 3) * 1024, vdst1 = ((2 * wid + 1) >> 2) * 4096 + ((2 * wid + 1) & 3) * 1024;
#define A2_GL(src, dst) __builtin_amdgcn_global_load_lds((const GAS unsigned*)(src), (LAS unsigned*)(dst), 16, 0, 0)
#define A2_DMA_K(j) do { const int tA_ = t_hi - 2 * (j), tB_ = tA_ - 1; LAS unsigned char* s_ = lds + ((j) & 1) * KSLOT + kdst; \
        if (tA_ >= t_lo) { const bf16* g_ = ksrc + (size_t)tA_ * 64 * 512; A2_GL(g_, s_); A2_GL(g_ + 64, s_ + KMAP); } \
        if (tB_ >= t_lo) { const bf16* g_ = ksrc + (size_t)tB_ * 64 * 512; A2_GL(g_, s_ + TILEK); A2_GL(g_ + 64, s_ + TILEK + KMAP); } } while (0)
#define A2_DMA_V(j) do { const int tA_ = t_hi - 2 * (j), tB_ = tA_ - 1; LAS unsigned char* s_ = lds + VBASE + ((j) & 1) * VSLOT; \
        if (tA_ >= t_lo) { const size_t o_ = (size_t)tA_ * 64 * 512; A2_GL(vsrc0 + o_, s_ + vdst0); A2_GL(vsrc1 + o_, s_ + vdst1); } \
        if (tB_ >= t_lo) { const size_t o_ = (size_t)tB_ * 64 * 512; A2_GL(vsrc0 + o_, s_ + TILEV + vdst0); A2_GL(vsrc1 + o_, s_ + TILEV + vdst1); } } while (0)
#define A2_BAR() asm volatile("s_waitcnt vmcnt(0) lgkmcnt(0)\n\ts_barrier" ::: "memory")
    const int kfoff = ks * TILEK + m * KMAP + r32 * 128 + ((hi ^ ((r32 >> 1) & 7)) * 16);
    const int vfoff = VBASE + ks * TILEV + ((lane >> 4) & 1) * 32 + (lane & 3) * 8 + (4 * hi + ((lane & 15) >> 2)) * 64;
    f32x16 o[4];
#pragma unroll
    for (int vb = 0; vb < 4; ++vb)
#pragma unroll
        for (int r = 0; r < 16; ++r) o[vb][r] = 0.f;
    float R = -1e30f, lsum = 0.f;
    bf16x8 pa[4];
    f32x16 cin0;
    const float d32 = 32.f * slope2;
    const float dstep = 128.f * slope2;
    A2_DMA_K(0);
    A2_BAR();
    if (ntrips > 1) A2_DMA_K(1);
    A2_DMA_V(0);
    if (nact > 0) {
        const int t = t_hi - ks;
        const float base = slope2 * (float)(64 * t + 4 * hi - qpos);
#pragma unroll
        for (int r = 0; r < 16; ++r) { const float cb = slope2 * (float)((r & 3) + 8 * (r >> 2)); cin0[r] = cb + base; }
        f32x16 p0, p1;
        { f32x16 c1;
#pragma unroll
          for (int r = 0; r < 16; ++r) c1[r] = cin0[r] + d32;
          qk8(lds, kfoff, qr, cin0, c1, p0, p1); }
        float rm = -1e30f;
        if (ks == 0) {
#pragma unroll
            for (int r = 0; r < 16; ++r) { const int key = 64 * t + 4 * hi + (r & 3) + 8 * (r >> 2);
                if (key > qpos) p0[r] = -1e30f; if (key + 32 > qpos) p1[r] = -1e30f; }
        }
#pragma unroll
        for (int r = 0; r < 16; ++r) rm = fmaxf(rm, fmaxf(p0[r], p1[r]));
        rm = fmaxf(rm, __shfl_xor(rm, 32));
        R = rm;
#pragma unroll
        for (int r = 0; r < 16; ++r) { p0[r] = __builtin_amdgcn_exp2f(p0[r] - R); p1[r] = __builtin_amdgcn_exp2f(p1[r] - R); lsum += p0[r] + p1[r]; }
        pack4(p0, p1, pa);
        const float adj = -R - dstep;
#pragma unroll
        for (int r = 0; r < 16; ++r) cin0[r] += adj;
    }
    A2_BAR();
    for (int i = 1; i < ntrips; ++i) {
        int ko_ = (i & 1) * KSLOT + kfoff, vq_ = ((i - 1) & 1) * VSLOT + vfoff; asm volatile("" : "+v"(ko_), "+v"(vq_));
        if (i + 1 < ntrips) A2_DMA_K(i + 1);
        A2_DMA_V(i);
        if (i < nact) {
            f32x16 p0, p1;
            { f32x16 c1;
#pragma unroll
              for (int r = 0; r < 16; ++r) c1[r] = cin0[r] + d32;
              qk8(lds, ko_, qr, cin0, c1, p0, p1); }
            pv16<ABL>(lds + vq_, pa, o);
            float ls = 0.f;
#pragma unroll
            for (int r = 0; r < 16; ++r) { p0[r] = __builtin_amdgcn_exp2f(p0[r]); p1[r] = __builtin_amdgcn_exp2f(p1[r]); ls += p0[r] + p1[r]; cin0[r] -= dstep; }
            lsum += ls;
            pack4(p0, p1, pa);
        } else if (i == nact) pv16<ABL>(lds + vq_, pa, o);
        A2_BAR();
    }
    if (nact == ntrips) pv16<ABL>(lds + ((ntrips - 1) & 1) * VSLOT + vfoff, pa, o);
    A2_BAR();
#undef A2_GL
#undef A2_DMA_K
#undef A2_DMA_V
    lsum += __shfl_xor(lsum, 32);
    LAS float* x1 = (LAS float*)lds;
    LAS float* x2 = (LAS float*)(lds + 4 * 66 * 64 * 4);
    const int pr = m * 2 + rb;
    if (ks == 1) {
#pragma unroll
        for (int vb = 0; vb < 4; ++vb)
#pragma unroll
            for (int r = 0; r < 16; ++r) x1[(pr * 66 + vb * 16 + r) * 64 + lane] = o[vb][r];
        x1[(pr * 66 + 64) * 64 + lane] = lsum; x1[(pr * 66 + 65) * 64 + lane] = R;
    }
    __syncthreads();
    float inv = 0.f;
    if (ks == 0) {
        const float l1 = x1[(pr * 66 + 64) * 64 + lane], R1 = x1[(pr * 66 + 65) * 64 + lane];
        const float Rm = fmaxf(R, R1), f0 = __builtin_amdgcn_exp2f(R - Rm), f1 = __builtin_amdgcn_exp2f(R1 - Rm);
        inv = 1.f / (lsum * f0 + l1 * f1);
        const float g0 = f0 * inv, g1 = f1 * inv;
#pragma unroll
        for (int vb = 0; vb < 4; ++vb) {
#pragma unroll
            for (int r = 0; r < 16; ++r) { o[vb][r] = o[vb][r] * g0 + x1[(pr * 66 + vb * 16 + r) * 64 + lane] * g1; if (r == 15) asm volatile("" ::: "memory"); } }
        if (m == 1) {
#pragma unroll
            for (int vb = 0; vb < 4; ++vb)
#pragma unroll
                for (int r = 0; r < 16; ++r) x2[(rb * 64 + vb * 16 + r) * 64 + lane] = o[vb][r];
        }
    }
    __syncthreads();
    if (ks == 0 && m == 0) {
        float ss = 0.f;
#pragma unroll
        for (int vb = 0; vb < 4; ++vb) {
#pragma unroll
            for (int r = 0; r < 16; ++r) { const float v = o[vb][r] - lam * x2[(rb * 64 + vb * 16 + r) * 64 + lane]; o[vb][r] = v; ss += v * v; if (r == 15) asm volatile("" ::: "memory"); } }
        ss += __shfl_xor(ss, 32);
        const float rstd = rsqrtf(ss * (1.f / 128.f) + EPS) * 0.8f;
        const float* sg = F.in[4];
        bf16* orow = AL + (rowbase + qpos) * ldo + h * 128;
#pragma unroll
        for (int vb = 0; vb < 4; ++vb)
#pragma unroll
            for (int g = 0; g < 4; ++g) { const int vd = vb * 32 + 8 * g + 4 * hi; const f32x4 gg = *(const GAS f32x4*)(sg + vd);
                const unsigned u0 = pk2(o[vb][4 * g] * rstd * gg[0], o[vb][4 * g + 1] * rstd * gg[1]), u1 = pk2(o[vb][4 * g + 2] * rstd * gg[2], o[vb][4 * g + 3] * rstd * gg[3]);
                *(GAS unsigned long long*)(orow + vd) = (unsigned long long)u0 | ((unsigned long long)u1 << 32);
                asm volatile("" ::: "memory"); }
    }
    __syncthreads();
#undef A2_BAR
}

template <int ABL> __device__ __forceinline__ void attn_phase(Frame& F, bf16* AL, int ldo, int qw) {
    const float* lp = F.in[3];
    float a = lp[F.lane] * lp[64 + F.lane], c = lp[128 + F.lane] * lp[192 + F.lane];
    a = wave_sum(a); c = wave_sum(c);
    const float lam = __expf(a) - __expf(c) + 0.2f;
    volatile LAS unsigned* slot = F.MISC + 12;
    if (F.tid == 0) slot[0] = __hip_atomic_fetch_add(F.ctl + qw, 1u, RLX_AGENT);
    __syncthreads();
    for (;;) {
        const unsigned u = slot[0];
        if (u >= 1024u) break;
        unsigned nxt = 0;
        if (F.tid == 0) nxt = __hip_atomic_fetch_add(F.ctl + qw, 1u, RLX_AGENT);
        const int h = 3 - (int)(u >> 8), r = (int)(u & 255u), b = r & 1, qb = 127 - (r >> 1);
        const float q0 = __uint_as_float(__hip_atomic_load(F.ctl + CW_QKMAX + b * 16 + h * 2, RLX_AGENT)), k0 = __uint_as_float(__hip_atomic_load(F.ctl + CW_QKMAX + b * 16 + 8 + h * 2, RLX_AGENT));
        const float q1 = __uint_as_float(__hip_atomic_load(F.ctl + CW_QKMAX + b * 16 + h * 2 + 1, RLX_AGENT)), k1 = __uint_as_float(__hip_atomic_load(F.ctl + CW_QKMAX + b * 16 + 8 + h * 2 + 1, RLX_AGENT));
        const float B0 = sqrtf(q0 * k0), B1 = sqrtf(q1 * k1), slope2 = __builtin_amdgcn_exp2f(-2.f * (float)(h + 1)) * LOG2E;
        const int w0 = __builtin_amdgcn_readfirstlane((int)fminf((2.f * B0 + att::WIN_T) / slope2, 16384.f)), w1 = __builtin_amdgcn_readfirstlane((int)fminf((2.f * B1 + att::WIN_T) / slope2, 16384.f));
        const bool fixed_ok = __builtin_amdgcn_readfirstlane((int)(2.f * fmaxf(B0, B1) <= 100.f)) != 0;
        if (fixed_ok) attn_unit<ABL>(F, b, h, qb, lam, w0, w1, AL, ldo);
        else if ((qb & 1) == 0) att::attn_unit<ABL>(F, b, h, qb >> 1, lam, AL, ldo);
        if (F.tid == 0) slot[0] = nxt;
        __syncthreads();
    }
}
}

namespace lru {
typedef float f32x16 __attribute__((ext_vector_type(16)));
constexpr int ROWB = 144;
constexpr int L_WT = 0, L_XC = 128 * ROWB, L_PRE = 2 * 128 * ROWB, L_AGG = L_PRE + 128 * 128 * 4;
constexpr size_t AGG_OFF = WS_MISC;

__device__ __forceinline__ void l1_unit(Frame& F, int b, int n, int k) {
    const int tid = F.tid, lane = F.lane, wid = F.wave, r32 = lane & 31, hi = lane >> 5;
    LAS unsigned char* lds = F.lds;
    const bf16* XR = (const bf16*)(F.ws + WS_XR); const bf16* GY = (const bf16*)(F.ws + WS_GY);
    bf16* PG = (bf16*)(F.ws + WS_PG); bf16* QG = (bf16*)(F.ws + WS_QG); float* AGG = (float*)(F.ws + AGG_OFF);
    const size_t rowbase = (size_t)b * SEQ; const int p0 = k * 128;
    { const float* wr = F.in[7] + (size_t)n * 4096; const float* wi = F.in[9] + (size_t)n * 4096;
#pragma unroll 4
      for (int i = 0; i < 8; ++i) { const int e = tid + 512 * i, c = e >> 6, d = e & 63;
          *(LAS bf16*)(lds + L_WT + d * ROWB + c * 2) = (bf16)f2bf(wr[e]); *(LAS bf16*)(lds + L_WT + (64 + d) * ROWB + c * 2) = (bf16)f2bf(wi[e]); } }
    { const int t = tid >> 2, cg = tid & 3, ch0 = n * 64 + cg * 16;
      float acc[16];
      const float* cb = F.in[6] + ch0;
#pragma unroll
      for (int i = 0; i < 16; ++i) acc[i] = cb[i];
#pragma unroll
      for (int j = 0; j < 4; ++j) { const int p = p0 + t - 3 + j;
          const float* cw = F.in[5] + j * 512 + ch0;
          if (p >= 0) { const v4u x0 = *(const GAS v4u*)(XR + (rowbase + p) * 512 + ch0), x1 = *(const GAS v4u*)(XR + (rowbase + p) * 512 + ch0 + 8);
#pragma unroll
              for (int i = 0; i < 4; ++i) { acc[2 * i] += cw[2 * i] * __builtin_bit_cast(float, x0[i] << 16); acc[2 * i + 1] += cw[2 * i + 1] * __builtin_bit_cast(float, x0[i] & 0xffff0000u);
                                            acc[8 + 2 * i] += cw[8 + 2 * i] * __builtin_bit_cast(float, x1[i] << 16); acc[8 + 2 * i + 1] += cw[8 + 2 * i + 1] * __builtin_bit_cast(float, x1[i] & 0xffff0000u); } } }
      v4u o0, o1;
#pragma unroll
      for (int i = 0; i < 4; ++i) { o0[i] = pk2(acc[2 * i], acc[2 * i + 1]); o1[i] = pk2(acc[8 + 2 * i], acc[8 + 2 * i + 1]); }
      *(LAS v4u*)(lds + L_XC + t * ROWB + cg * 32) = o0; *(LAS v4u*)(lds + L_XC + t * ROWB + cg * 32 + 16) = o1; }
    __syncthreads();
    { const int tb = wid & 3, dh = wid >> 2;
      f32x16 d0, d1;
#pragma unroll
      for (int r = 0; r < 16; ++r) { d0[r] = 0.f; d1[r] = 0.f; }
#pragma unroll
      for (int s = 0; s < 4; ++s) {
          const bf16x8 a = *(const LAS bf16x8*)(lds + L_XC + (tb * 32 + r32) * ROWB + s * 32 + hi * 16);
          const bf16x8 w0 = *(const LAS bf16x8*)(lds + L_WT + (dh * 64 + r32) * ROWB + s * 32 + hi * 16);
          const bf16x8 w1 = *(const LAS bf16x8*)(lds + L_WT + (dh * 64 + 32 + r32) * ROWB + s * 32 + hi * 16);
          d0 = __builtin_amdgcn_mfma_f32_32x32x16_bf16(a, w0, d0, 0, 0, 0);
          d1 = __builtin_amdgcn_mfma_f32_32x32x16_bf16(a, w1, d1, 0, 0, 0); }
      LAS float* pre = (LAS float*)(lds + L_PRE);
#pragma unroll
      for (int r = 0; r < 16; ++r) { const int tok = tb * 32 + (r & 3) + 8 * (r >> 2) + 4 * hi;
          pre[tok * 128 + dh * 64 + r32] = d0[r]; pre[tok * 128 + dh * 64 + 32 + r32] = d1[r]; } }
    __syncthreads();
    const int c = tid & 63, ts = wid, ch = n * 64 + c;
    const float br = F.in[8][ch], bi = F.in[10][ch], sp = log1pf(__expf(-F.in[11][ch]));
    float hv[16], cv[16];
    { const LAS float* pre = (const LAS float*)(lds + L_PRE);
      float h = 0.f, cum = 1.f;
#pragma unroll
      for (int i = 0; i < 16; ++i) { const int tt = ts * 16 + i;
          const float r = sigmoidf_(pre[tt * 128 + c] + br), ig = sigmoidf_(pre[tt * 128 + 64 + c] + bi);
          const float log_a = -8.f * r * sp, a = __expf(log_a);
          const float mult = (p0 + tt == 0) ? 1.f : sqrtf(-expm1f(2.f * log_a));
          const float xc = bf2f(*(const LAS bf16*)(lds + L_XC + tt * ROWB + c * 2));
          h = a * h + xc * ig * mult; cum *= a; hv[i] = h; cv[i] = cum; }
      LAS float* ag = (LAS float*)(lds + L_AGG);
      ag[(ts * 64 + c) * 2] = cum; ag[(ts * 64 + c) * 2 + 1] = h; }
    __syncthreads();
    { const LAS float* ag = (const LAS float*)(lds + L_AGG);
      float carry = 0.f, pprev = 1.f;
      for (int s = 0; s < ts; ++s) { const float as = ag[(s * 64 + c) * 2], hs = ag[(s * 64 + c) * 2 + 1]; carry = as * carry + hs; pprev *= as; }
      if (ts == 7) { float* g = AGG + ((size_t)((b * 8 + n) * 64 + k) * 64 + c) * 2; g[0] = pprev * cv[15]; g[1] = cv[15] * carry + hv[15]; }
      float gy[16];
#pragma unroll
      for (int i = 0; i < 16; ++i) gy[i] = bf2f(GY[(rowbase + p0 + ts * 16 + i) * 512 + ch]);
#pragma unroll
      for (int i = 0; i < 16; ++i) { const size_t row = rowbase + p0 + ts * 16 + i;
          PG[row * 512 + ch] = (bf16)f2bf(cv[i] * pprev * gy[i]); QG[row * 512 + ch] = (bf16)f2bf((hv[i] + cv[i] * carry) * gy[i]); } }
    __syncthreads();
}
__device__ __forceinline__ void l1_phase(Frame& F) { for (int u = F.vcu; u < 1024; u += F.G) l1_unit(F, u >> 9, (u >> 6) & 7, u & 63); }

__device__ __forceinline__ void l2_phase(Frame& F) {
    const bf16* PG = (const bf16*)(F.ws + WS_PG); const bf16* QG = (const bf16*)(F.ws + WS_QG); const float* AGG = (const float*)(F.ws + AGG_OFF);
    bf16* AL = (bf16*)(F.ws + WS_AL);
    const int c = F.tid & 63, ts = F.wave;
    for (int u = F.vcu; u < 1024; u += F.G) { const int b = u >> 9, n = (u >> 6) & 7, k = u & 63, ch = n * 64 + c;
        float carry = 0.f;
        const float* g = AGG + ((size_t)((b * 8 + n) * 64) * 64 + c) * 2;
        for (int j = 0; j < k; ++j) carry = g[(size_t)j * 128] * carry + g[(size_t)j * 128 + 1];
        float qv[16], pv[16];
#pragma unroll
        for (int i = 0; i < 16; ++i) { const size_t row = (size_t)b * SEQ + k * 128 + ts * 16 + i; qv[i] = bf2f(QG[row * 512 + ch]); pv[i] = bf2f(PG[row * 512 + ch]); }
#pragma unroll
        for (int i = 0; i < 16; ++i) { const size_t row = (size_t)b * SEQ + k * 128 + ts * 16 + i;
            AL[row * 1024 + 512 + ch] = (bf16)f2bf(qv[i] + pv[i] * carry); } }
}
}

namespace moe {
constexpr int L_TOK = LDSCTL_OFF + 512;
constexpr int L_HIST = LDSCTL_OFF + 2560, L_BASE = LDSCTL_OFF + 2688, L_PAD = LDSCTL_OFF + 2816;
constexpr size_t TOKSLOT_OFF = WS_MISC + 1 * MiB;
constexpr size_t WER_OFF = WS_MISC + 1536 * 1024;
static_assert(L_PAD + 33 * 4 <= LDS_BYTES, "LDS control map");

__device__ __forceinline__ void route_phase(Frame& F, bool dry) {
    const int lane = F.lane, wave = F.wave, tid = F.tid, r32 = lane & 31, hi = lane >> 5;
    LAS unsigned char* lds = F.lds;
    const float* x1 = F.out;
    { const GAS v4u* src = (const GAS v4u*)(F.ws + WER_OFF);
#pragma unroll 6
      for (int i = 0; i < 18; ++i) *(LAS v4u*)(lds + (tid + 512 * i) * 16) = src[tid + 512 * i]; }
    for (int i = 0; i < 8; ++i) { const int lt = wave * 8 + i, tok = F.vcu * 64 + lt;
        const GAS f32x4* xr = (const GAS f32x4*)(x1 + (size_t)tok * DM) + lane; float s = 0.f;
#pragma unroll
        for (int j = 0; j < 4; ++j) { const f32x4 v = xr[64 * j]; s += (v.x * v.x + v.y * v.y) + (v.z * v.z + v.w * v.w); }
        s = wave_sum(s);
        if (lane == 0) ((LAS float*)(lds + L_TOK + lt * 32))[6] = rsqrtf(s * (1.f / DM) + EPS); }
    __syncthreads();
    typedef float f32x16 __attribute__((ext_vector_type(16)));
    f32x16 acc0, acc1;
#pragma unroll
    for (int r = 0; r < 16; ++r) { acc0[r] = 0.f; acc1[r] = 0.f; }
    { const int mb = wave & 1, kq = wave >> 1, lt = mb * 32 + r32, tok = F.vcu * 64 + lt;
      const float rs = ((const LAS float*)(lds + L_TOK + lt * 32))[6];
      const float* xp = x1 + (size_t)tok * DM + kq * 256 + 8 * hi;
      const LAS unsigned char* wp0 = lds + r32 * 2048;
      const LAS unsigned char* wp1 = lds + (32 + (r32 & 3)) * 2048;
      const int c0 = kq * 32 + hi, z0 = r32 & 15, z1 = r32 & 3;
      const bool gz = r32 >= 4;
#pragma unroll 4
      for (int ks = 0; ks < 16; ++ks) {
          const f32x4 xa = *(const GAS f32x4*)(xp + ks * 16), xb = *(const GAS f32x4*)(xp + ks * 16 + 4);
          v4u ah, al;
#pragma unroll
          for (int e = 0; e < 4; ++e) { const float h0 = (e < 2 ? xa[2 * e] : xb[2 * e - 4]) * rs, h1 = (e < 2 ? xa[2 * e + 1] : xb[2 * e - 3]) * rs;
              const unsigned b0 = f2bf(h0), b1 = f2bf(h1); ah[e] = b0 | (b1 << 16);
              al[e] = pk2(h0 - __builtin_bit_cast(float, b0 << 16), h1 - __builtin_bit_cast(float, b1 << 16)); }
          const bf16x8 a_h = __builtin_bit_cast(bf16x8, ah), a_l = __builtin_bit_cast(bf16x8, al);
          const int o0 = ((c0 + 2 * ks) ^ z0) * 16, o1 = ((c0 + 2 * ks) ^ z1) * 16;
          const bf16x8 bh0 = *(const LAS bf16x8*)(wp0 + o0), bl0 = *(const LAS bf16x8*)(wp0 + 73728 + o0);
          bf16x8 bh1 = *(const LAS bf16x8*)(wp1 + o1), bl1 = *(const LAS bf16x8*)(wp1 + 73728 + o1);
          if (gz) { bh1 = (bf16x8){0, 0, 0, 0, 0, 0, 0, 0}; bl1 = bh1; }
          acc0 = __builtin_amdgcn_mfma_f32_32x32x16_bf16(a_h, bh0, acc0, 0, 0, 0); acc0 = __builtin_amdgcn_mfma_f32_32x32x16_bf16(a_h, bl0, acc0, 0, 0, 0); acc0 = __builtin_amdgcn_mfma_f32_32x32x16_bf16(a_l, bh0, acc0, 0, 0, 0);
          acc1 = __builtin_amdgcn_mfma_f32_32x32x16_bf16(a_h, bh1, acc1, 0, 0, 0); acc1 = __builtin_amdgcn_mfma_f32_32x32x16_bf16(a_h, bl1, acc1, 0, 0, 0); acc1 = __builtin_amdgcn_mfma_f32_32x32x16_bf16(a_l, bh1, acc1, 0, 0, 0);
      } }
    __syncthreads();
    { LAS float* part = (LAS float*)lds;
#pragma unroll
      for (int r = 0; r < 16; ++r) { part[((wave * 2 + 0) * 16 + r) * 64 + lane] = acc0[r]; part[((wave * 2 + 1) * 16 + r) * 64 + lane] = acc1[r]; } }
    __syncthreads();
    if (tid < 64) {
        const int lt = tid, mb = lt >> 5, i5 = lt & 31, h2 = (i5 >> 2) & 1, r = (i5 & 3) + 4 * (i5 >> 3);
        const LAS float* part = (const LAS float*)lds;
        float lg[4];
#pragma unroll
        for (int c = 0; c < 4; ++c) { float s = 0.f;
#pragma unroll
            for (int kq = 0; kq < 4; ++kq) s += part[(((mb + 2 * kq) * 2 + 1) * 16 + r) * 64 + h2 * 32 + c];
            lg[c] = s; }
        int grp = 0; float mx = lg[0];
#pragma unroll
        for (int e = 1; e < 4; ++e) if (lg[e] > mx) { mx = lg[e]; grp = e; }
        float den = 0.f;
#pragma unroll
        for (int e = 0; e < 4; ++e) den += __expf(lg[e] - mx);
        const float gw = 1.f / den;
        float le[8];
#pragma unroll
        for (int e = 0; e < 8; ++e) { float s = 0.f;
#pragma unroll
            for (int kq = 0; kq < 4; ++kq) s += part[(((mb + 2 * kq) * 2 + 0) * 16 + r) * 64 + h2 * 32 + grp * 8 + e];
            le[e] = s; }
        int i0 = 0; float m0 = le[0];
#pragma unroll
        for (int e = 1; e < 8; ++e) if (le[e] > m0) { m0 = le[e]; i0 = e; }
        int i1 = -1; float m1 = -INFINITY;
#pragma unroll
        for (int e = 0; e < 8; ++e) if (e != i0 && le[e] > m1) { m1 = le[e]; i1 = e; }
        const float pa = 1.f / (1.f + __expf(m1 - m0));
        if (!dry) { const int e0 = grp * 8 + i0, e1 = grp * 8 + i1;
            const int l0 = atomicAdd((int*)(lds + L_HIST) + e0, 1), l1 = atomicAdd((int*)(lds + L_HIST) + e1, 1);
            LAS int* tk = (LAS int*)(lds + L_TOK + lt * 32); tk[0] = e0; tk[1] = e1; ((LAS float*)tk)[2] = gw * pa; ((LAS float*)tk)[3] = gw * (1.f - pa); tk[4] = l0; tk[5] = l1; }
        else asm volatile("" :: "v"(gw), "v"(pa), "v"(i0), "v"(i1));
    }
    __syncthreads();
    if (dry) return;
    if (tid < 32) { const int h = ((LAS int*)(lds + L_HIST))[tid];
        ((LAS int*)(lds + L_BASE))[tid] = (int)atomicAdd((unsigned*)(F.ctl + CW_CNT) + tid, (unsigned)h); }
}
__device__ __forceinline__ void scatter_phase(Frame& F) {
    const int lane = F.lane, wave = F.wave;
    LAS unsigned char* lds = F.lds;
    if (F.tid == 0) { int cs[32];
#pragma unroll
        for (int e = 0; e < 32; ++e) cs[e] = (int)__hip_atomic_load(F.ctl + CW_CNT + e, RLX_AGENT);
        int acc = 0; LAS int* pad = (LAS int*)(lds + L_PAD);
#pragma unroll
        for (int e = 0; e < 32; ++e) { pad[e] = acc; acc += (cs[e] + 255) & ~255; }
        pad[32] = acc; }
    __syncthreads();
    bf16* XS = (bf16*)(F.ws + WS_XS); int* TS = (int*)(F.ws + TOKSLOT_OFF); const float* x1 = F.out; const float* gf = F.in[15];
    const LAS int* pad = (const LAS int*)(lds + L_PAD); const LAS int* base = (const LAS int*)(lds + L_BASE);
    f32x4 gv[4];
#pragma unroll
    for (int j = 0; j < 4; ++j) gv[j] = ((const GAS f32x4*)gf)[lane + 64 * j];
    for (int i = 0; i < 8; i += 2) {
        f32x4 v[2][4]; int s0[2], s1[2];
#pragma unroll
        for (int q = 0; q < 2; ++q) { const int lt = wave * 8 + i + q, tok = F.vcu * 64 + lt;
            const GAS f32x4* xr = (const GAS f32x4*)(x1 + (size_t)tok * DM) + lane;
#pragma unroll
            for (int j = 0; j < 4; ++j) v[q][j] = xr[64 * j]; }
#pragma unroll
        for (int q = 0; q < 2; ++q) { const int lt = wave * 8 + i + q, tok = F.vcu * 64 + lt;
            const LAS int* tk = (const LAS int*)(lds + L_TOK + lt * 32);
            const int e0 = tk[0], e1 = tk[1]; const float rs = ((const LAS float*)tk)[6];
            s0[q] = pad[e0] + base[e0] + tk[4]; s1[q] = pad[e1] + base[e1] + tk[5];
            GAS unsigned long long* o0 = (GAS unsigned long long*)(XS + (size_t)s0[q] * 1024) + lane; GAS unsigned long long* o1 = (GAS unsigned long long*)(XS + (size_t)s1[q] * 1024) + lane;
#pragma unroll
            for (int j = 0; j < 4; ++j) { const f32x4 h = v[q][j] * rs * gv[j]; const unsigned long long w = (unsigned long long)pk2(h.x, h.y) | ((unsigned long long)pk2(h.z, h.w) << 32); o0[64 * j] = w; o1[64 * j] = w; }
            if (lane == 0) { int* t = TS + (size_t)tok * 4; t[0] = s0[q]; t[1] = s1[q]; t[2] = tk[2]; t[3] = tk[3]; } }
    }
}
__device__ __forceinline__ void final_phase(Frame& F, float* dst) {
    const int lane = F.lane; const int gw = F.vcu * NWAVES + F.wave, NGW = F.G * NWAVES;
    const bf16* YB = (const bf16*)(F.ws + WS_YB); const int* TS = (const int*)(F.ws + TOKSLOT_OFF); const float* gfin = F.in[21];
    f32x4 gv[4];
#pragma unroll
    for (int j = 0; j < 4; ++j) gv[j] = ((const GAS f32x4*)gfin)[lane + 64 * j];
    for (int tok = gw; tok < NTOK; tok += NGW) {
        const int* t = TS + (size_t)tok * 4; const int s0 = t[0], s1 = t[1]; const float w0 = __builtin_bit_cast(float, t[2]), w1 = __builtin_bit_cast(float, t[3]);
        GAS f32x4* xr = (GAS f32x4*)(F.out + (size_t)tok * DM) + lane;
        const GAS unsigned long long* y0 = (const GAS unsigned long long*)(YB + (size_t)s0 * 1024) + lane; const GAS unsigned long long* y1 = (const GAS unsigned long long*)(YB + (size_t)s1 * 1024) + lane;
        f32x4 v[4]; float s = 0.f;
#pragma unroll
        for (int j = 0; j < 4; ++j) { v[j] = xr[64 * j]; const unsigned long long a = y0[64 * j], b = y1[64 * j];
            v[j].x += w0 * __builtin_bit_cast(float, (unsigned)a << 16) + w1 * __builtin_bit_cast(float, (unsigned)b << 16);
            v[j].y += w0 * __builtin_bit_cast(float, (unsigned)a & 0xffff0000u) + w1 * __builtin_bit_cast(float, (unsigned)b & 0xffff0000u);
            v[j].z += w0 * __builtin_bit_cast(float, (unsigned)(a >> 32) << 16) + w1 * __builtin_bit_cast(float, (unsigned)(b >> 32) << 16);
            v[j].w += w0 * __builtin_bit_cast(float, (unsigned)(a >> 32) & 0xffff0000u) + w1 * __builtin_bit_cast(float, (unsigned)(b >> 32) & 0xffff0000u);
            s += (v[j].x * v[j].x + v[j].y * v[j].y) + (v[j].z * v[j].z + v[j].w * v[j].w); }
        const float rstd = rsqrtf(wave_sum(s) * (1.f / DM) + EPS);
        GAS f32x4* orow = (GAS f32x4*)(dst + (size_t)tok * DM) + lane;
#pragma unroll
        for (int j = 0; j < 4; ++j) orow[64 * j] = v[j] * rstd * gv[j];
    }
}
}

struct Args { const float* in[22]; float* out; unsigned char* ws; int ph_lo, ph_hi, li, pad; };
constexpr int N_PHASES = 2;
__global__ void __launch_bounds__(NWAVES * 64, 2) mega(Args args) {
    extern __shared__ __attribute__((aligned(16))) unsigned char lds[];
    Frame F;
    F.lds = (LAS unsigned char*)lds;
    F.MISC = (volatile LAS unsigned*)(F.lds + MISC_OFF);
    F.tid = threadIdx.x; F.lane = F.tid & 63; F.wave = __builtin_amdgcn_readfirstlane(F.tid >> 6);
    F.G = gridDim.x; { const int bx = blockIdx.x; F.vcu = (F.G % 8 == 0) ? (bx % 8) * (F.G / 8) + bx / 8 : bx; }
    F.ws = args.ws; F.out = args.out; F.ctl = (gu32*)(args.ws + WS_CTL);
#pragma unroll
    for (int i = 0; i < 22; ++i) F.in[i] = args.in[i];
    for (int u = F.tid; u < (LDS_BYTES - LDSCTL_OFF) / 4; u += NWAVES * 64) ((LAS unsigned*)(F.lds + LDSCTL_OFF))[u] = 0u;
    __syncthreads();
    XcdBarrier bar = xcd_barrier_post((unsigned*)(F.ctl + CW_BAR) + args.li * XCD_BAR_WORDS, F.MISC + 8);
    const int lo = args.ph_lo, hi = args.ph_hi;
#define IN(k) (lo <= (k) && (k) < hi)
#define BOTH(k) (IN(k) && IN((k) + 1))
#define GRID_BAR() xcd_barrier(bar)
#define REFRESH() do { int t_ = threadIdx.x; asm volatile("" : "+v"(t_)); F.tid = t_; F.lane = t_ & 63; } while (0)

    if (IN(0)) { REFRESH(); p0_prologue(F); if (BOTH(0)) GRID_BAR(); }

    if (IN(1)) {
        pg8::Gemm g{(const bf16*)(F.ws + WS_XN), (const bf16*)(F.ws + WS_WIN), NTOK, INC, DM}; pg8::StaticOrder S; S.init(NTOK, INC, F.G, (int)blockIdx.x);
        pg8::EpiInProj E{(bf16*)(F.ws + WS_Q), (bf16*)(F.ws + WS_K), (bf16*)(F.ws + WS_V), (bf16*)(F.ws + WS_XR), (bf16*)(F.ws + WS_GY), (bf16*)F.out, (unsigned*)(F.ctl + CW_QKMAX)};
        pg8::gemm_phase<pg8::EpiInProj, pg8::StaticOrder, true, true>(F.lds + RING_OFF, g, S, E);
        if (BOTH(1)) GRID_BAR();
    }
    if (IN(2)) { REFRESH(); lru::l1_phase(F);
#ifdef PROBE_L1X2
        REFRESH(); lru::l1_phase(F);
#endif
        REFRESH(); att2::attn_phase<0>(F, (bf16*)(F.ws + WS_AL), 1024, att2::CW_AQ2);
#ifdef PROBE_ATT
        __syncthreads(); REFRESH(); att2::attn_phase<PROBE_ATT>(F, (bf16*)(F.ws + 256 * MiB), 512, att2::CW_AQ2 + 64);
#ifdef PROBE_ATT3
        __syncthreads(); REFRESH(); att2::attn_phase<PROBE_ATT>(F, (bf16*)(F.ws + 256 * MiB), 512, att2::CW_AQ2 + 128);
        __syncthreads(); REFRESH(); att2::attn_phase<PROBE_ATT>(F, (bf16*)(F.ws + 256 * MiB), 512, att2::CW_AQ2 + 192);
#endif
#endif
        if (BOTH(2)) GRID_BAR(); }

    if (IN(3)) { REFRESH(); lru::l2_phase(F); if (BOTH(3)) GRID_BAR(); }
#ifndef NO_P4
    if (IN(4)) {
        pg8::Gemm g{(const bf16*)(F.ws + WS_AL), (const bf16*)(F.ws + WS_WMIX), NTOK, DM, DM}; pg8::StaticOrder S; S.init(NTOK, DM, F.G, (int)blockIdx.x);
        pg8::EpiMix E{(const bf16*)F.out, (bf16*)(F.ws + WS_MERGED)};
        pg8::gemm_phase<pg8::EpiMix, pg8::StaticOrder, true, true>(F.lds + RING_OFF, g, S, E);
        if (BOTH(4)) GRID_BAR();
    }
#endif
#ifndef NO_P5
    if (IN(5)) {
        pg8::Gemm g{(const bf16*)(F.ws + WS_MERGED), (const bf16*)(F.ws + WS_WOUT), NTOK, DM, DM}; pg8::StaticOrder S; S.init(NTOK, DM, F.G, (int)blockIdx.x);
        pg8::EpiResidF32 E{F.in[0], F.out};
        pg8::gemm_phase<pg8::EpiResidF32, pg8::StaticOrder, true, true>(F.lds + RING_OFF, g, S, E);
        if (BOTH(5)) GRID_BAR();
    }
#endif
    if (IN(6)) { REFRESH();
#ifdef PROBE_ROUTEX2
        moe::route_phase(F, true); __syncthreads(); REFRESH();
#endif
        moe::route_phase(F, false); if (BOTH(6)) GRID_BAR(); }
    if (IN(7)) { REFRESH(); moe::scatter_phase(F);
#ifdef PROBE_SCATX2
        __syncthreads(); REFRESH(); moe::scatter_phase(F);
#endif
#ifdef PROBE_BARX10
        for (int i_ = 0; i_ < 10; ++i_) GRID_BAR();
#endif
        if (BOTH(7)) GRID_BAR(); }
#ifdef DUP_PHASE
    if ((IN(8) || IN(9)) && !IN(7)) { if (F.tid == 0) { int acc = 0; LAS int* pad = (LAS int*)(F.lds + moe::L_PAD);
        for (int e = 0; e < 32; ++e) { pad[e] = acc; const int c = (int)__hip_atomic_load(F.ctl + CW_CNT + e, RLX_AGENT); acc += (c + 255) & ~255; } pad[32] = acc; } __syncthreads(); }
#endif
    if (IN(8)) {
        pg8::Gemm g{(const bf16*)(F.ws + WS_XS), (const bf16*)(F.ws + WS_WGU), 0, 0, 1024}; pg8::MoeOrder S; S.init((const LAS int*)(F.lds + moe::L_PAD), F.G, (int)blockIdx.x);
        pg8::EpiSwiGLU E{(bf16*)(F.ws + WS_HB)};
        pg8::gemm_phase<pg8::EpiSwiGLU, pg8::MoeOrder, true, true>(F.lds + RING_OFF, g, S, E);
        if (BOTH(8)) GRID_BAR();
    }
    if (IN(9)) {
        pg8::Gemm g{(const bf16*)(F.ws + WS_HB), (const bf16*)(F.ws + WS_WD), 0, 0, 512}; pg8::MoeOrder S; S.init((const LAS int*)(F.lds + moe::L_PAD), F.G, (int)blockIdx.x);
        pg8::EpiStoreBf16 E{(bf16*)(F.ws + WS_YB), 1024};
        pg8::gemm_phase<pg8::EpiStoreBf16, pg8::MoeOrder, true, true>(F.lds + RING_OFF, g, S, E);
        if (BOTH(9)) GRID_BAR();
    }
    if (IN(10)) { REFRESH();
#ifdef PROBE_FINALX2
        moe::final_phase(F, (float*)(F.ws + 190 * MiB)); REFRESH();
#endif
        moe::final_phase(F, F.out); }
#undef IN
#undef BOTH
#undef GRID_BAR
#undef REFRESH
}
__global__ void n_rmsnorm(const float* __restrict__ x, const float* __restrict__ g, bf16* __restrict__ xn) {
    const int row = blockIdx.x, tid = threadIdx.x;
    const float4 v = ((const float4*)(x + (size_t)row * DM))[tid];
    float s = v.x * v.x + v.y * v.y + v.z * v.z + v.w * v.w;
    __shared__ float red[256];
    red[tid] = s; __syncthreads();
    for (int o = 128; o > 0; o >>= 1) { if (tid < o) red[tid] += red[tid + o]; __syncthreads(); }
    const float rstd = rsqrtf(red[0] / DM + EPS);
    const float4 gg = ((const float4*)g)[tid];
    bf16* o = xn + (size_t)row * DM + tid * 4;
    o[0] = f2bf(v.x * rstd * gg.x); o[1] = f2bf(v.y * rstd * gg.y); o[2] = f2bf(v.z * rstd * gg.z); o[3] = f2bf(v.w * rstd * gg.w);
}

template <class Epi>
__global__ void n_gemm(const bf16* __restrict__ A, int lda, const float* __restrict__ W, int ldw, int K, Epi epi) {
    __shared__ float As[16][65]; __shared__ float Ws[16][64];
    const int tx = threadIdx.x, ty = threadIdx.y, tid = ty * 16 + tx;
    const int row0 = blockIdx.y * 64, col0 = blockIdx.x * 64;
    float acc[4][4];
#pragma unroll
    for (int i = 0; i < 4; ++i)
#pragma unroll
        for (int j = 0; j < 4; ++j) acc[i][j] = 0.f;
    for (int k0 = 0; k0 < K; k0 += 16) {
#pragma unroll
        for (int i = 0; i < 4; ++i) { const int idx = tid + i * 256; const int r = idx >> 4, kk = idx & 15; As[kk][r] = bf2f(A[(size_t)(row0 + r) * lda + k0 + kk]); }
#pragma unroll
        for (int i = 0; i < 4; ++i) { const int idx = tid + i * 256; const int kk = idx >> 6, c = idx & 63; Ws[kk][c] = W[(size_t)(k0 + kk) * ldw + col0 + c]; }
        __syncthreads();
#pragma unroll
        for (int kk = 0; kk < 16; ++kk) {
            float a[4], b[4];
#pragma unroll
            for (int i = 0; i < 4; ++i) a[i] = As[kk][ty * 4 + i];
#pragma unroll
            for (int j = 0; j < 4; ++j) b[j] = Ws[kk][tx * 4 + j];
#pragma unroll
            for (int i = 0; i < 4; ++i)
#pragma unroll
                for (int j = 0; j < 4; ++j) acc[i][j] += a[i] * b[j];
        }
        __syncthreads();
    }
#pragma unroll
    for (int i = 0; i < 4; ++i)
#pragma unroll
        for (int j = 0; j < 4; ++j) epi(row0 + ty * 4 + i, col0 + tx * 4 + j, acc[i][j]);
}

struct EpiInProjN {
    bf16 *Q, *K, *V, *XR, *GY, *GATES;
    __device__ void operator()(int r, int c, float v) const {
        if (c < 512) Q[(size_t)r * 512 + c] = f2bf(v * C2);
        else if (c < 1024) K[(size_t)r * 512 + c - 512] = f2bf(v);
        else if (c < 1536) V[(size_t)r * 512 + c - 1024] = f2bf(v);
        else if (c < 2048) XR[(size_t)r * 512 + c - 1536] = f2bf(v);
        else if (c < 2560) GY[(size_t)r * 512 + c - 2048] = f2bf(gelu_tanh(v));
        else GATES[(size_t)r * 2048 + c - 2560] = f2bf(sigmoidf_(v));
    }
};
struct EpiResid { const float* x; float* out; __device__ void operator()(int r, int c, float v) const { out[(size_t)r * DM + c] = x[(size_t)r * DM + c] + v; } };

__global__ void n_gemm_mix(const bf16* __restrict__ AL, const float* __restrict__ Woa, const float* __restrict__ Wol, const bf16* __restrict__ GATES, bf16* __restrict__ MERGED) {
    __shared__ float As[2][16][65]; __shared__ float Ws[2][16][64];
    const int tx = threadIdx.x, ty = threadIdx.y, tid = ty * 16 + tx;
    const int row0 = blockIdx.y * 64, col0 = blockIdx.x * 64;
    float acc[2][4][4];
#pragma unroll
    for (int s = 0; s < 2; ++s)
#pragma unroll
        for (int i = 0; i < 4; ++i)
#pragma unroll
            for (int j = 0; j < 4; ++j) acc[s][i][j] = 0.f;
    for (int k0 = 0; k0 < 512; k0 += 16) {
#pragma unroll
        for (int i = 0; i < 4; ++i) { const int idx = tid + i * 256; const int r = idx >> 4, kk = idx & 15;
            As[0][kk][r] = bf2f(AL[(size_t)(row0 + r) * 1024 + k0 + kk]); As[1][kk][r] = bf2f(AL[(size_t)(row0 + r) * 1024 + 512 + k0 + kk]); }
#pragma unroll
        for (int i = 0; i < 4; ++i) { const int idx = tid + i * 256; const int kk = idx >> 6, c = idx & 63;
            Ws[0][kk][c] = Woa[(size_t)(k0 + kk) * 1024 + col0 + c]; Ws[1][kk][c] = Wol[(size_t)(k0 + kk) * 1024 + col0 + c]; }
        __syncthreads();
#pragma unroll
        for (int s = 0; s < 2; ++s)
#pragma unroll
            for (int kk = 0; kk < 16; ++kk) {
                float a[4], b[4];
#pragma unroll
                for (int i = 0; i < 4; ++i) a[i] = As[s][kk][ty * 4 + i];
#pragma unroll
                for (int j = 0; j < 4; ++j) b[j] = Ws[s][kk][tx * 4 + j];
#pragma unroll
                for (int i = 0; i < 4; ++i)
#pragma unroll
                    for (int j = 0; j < 4; ++j) acc[s][i][j] += a[i] * b[j];
            }
        __syncthreads();
    }
#pragma unroll
    for (int i = 0; i < 4; ++i)
#pragma unroll
        for (int j = 0; j < 4; ++j) { const int r = row0 + ty * 4 + i, c = col0 + tx * 4 + j;
            const float ga = bf2f(GATES[(size_t)r * 2048 + c]), gl = bf2f(GATES[(size_t)r * 2048 + 1024 + c]);
            MERGED[(size_t)r * 1024 + c] = f2bf(ga * acc[0][i][j] + gl * acc[1][i][j]); }
}

__global__ void n_attn(const bf16* __restrict__ Q, const bf16* __restrict__ K, const bf16* __restrict__ V, const float* __restrict__ lambda_qk, const float* __restrict__ subln_g, bf16* __restrict__ AL) {
    const int row = blockIdx.x, h = blockIdx.y, tid = threadIdx.x;
    const int b = row / SEQ, qpos = row % SEQ;
    __shared__ float sc[SEQ]; __shared__ float qv[64]; __shared__ float red[256]; __shared__ float o0[128]; __shared__ float part[256];
    const float slope2 = exp2f(-2.f * (h + 1)) * LOG2E;
    float lam;
    { float s0 = 0.f, s1 = 0.f; for (int d = 0; d < 64; ++d) { s0 += lambda_qk[d] * lambda_qk[64 + d]; s1 += lambda_qk[128 + d] * lambda_qk[192 + d]; } lam = expf(s0) - expf(s1) + 0.2f; }
    float ofin = 0.f;
    for (int m = 0; m < 2; ++m) {
        __syncthreads();
        if (tid < 64) qv[tid] = bf2f(Q[(size_t)row * 512 + h * 128 + m * 64 + tid]);
        __syncthreads();
        float lmax = -INFINITY;
        for (int key = tid; key <= qpos; key += 256) {
            const bf16* kr = K + (size_t)(b * SEQ + key) * 512 + h * 128 + m * 64;
            float s = 0.f;
            for (int d = 0; d < 64; ++d) s += qv[d] * bf2f(kr[d]);
            s += slope2 * (float)(key - qpos);
            sc[key] = s; lmax = fmaxf(lmax, s);
        }
        red[tid] = lmax; __syncthreads();
        for (int o = 128; o > 0; o >>= 1) { if (tid < o) red[tid] = fmaxf(red[tid], red[tid + o]); __syncthreads(); }
        const float mx = red[0]; __syncthreads();
        float lsum = 0.f;
        for (int key = tid; key <= qpos; key += 256) { const float p = exp2f(sc[key] - mx); sc[key] = p; lsum += p; }
        red[tid] = lsum; __syncthreads();
        for (int o = 128; o > 0; o >>= 1) { if (tid < o) red[tid] += red[tid + o]; __syncthreads(); }
        const float inv = 1.f / red[0]; __syncthreads();
        const int vd = tid & 127, half = tid >> 7;
        float acc = 0.f;
        for (int key = half; key <= qpos; key += 2) acc += sc[key] * bf2f(V[(size_t)(b * SEQ + key) * 512 + h * 128 + vd]);
        part[tid] = acc; __syncthreads();
        if (tid < 128) { const float o = (part[tid] + part[tid + 128]) * inv; if (m == 0) ofin = o; else ofin = ofin - lam * o; }
    }
    __syncthreads();
    red[tid] = (tid < 128) ? ofin * ofin : 0.f; __syncthreads();
    for (int o = 128; o > 0; o >>= 1) { if (tid < o) red[tid] += red[tid + o]; __syncthreads(); }
    const float rstd = rsqrtf(red[0] / 128.f + EPS);
    if (tid < 128) AL[(size_t)row * 1024 + h * 128 + tid] = f2bf(ofin * rstd * subln_g[tid] * 0.8f);
}

__global__ void n_lru(const bf16* __restrict__ XR, const bf16* __restrict__ GY, const float* __restrict__ conv_w, const float* __restrict__ conv_b, const float* __restrict__ w_r, const float* __restrict__ b_r,
                      const float* __restrict__ w_i, const float* __restrict__ b_i, const float* __restrict__ lru_lambda, bf16* __restrict__ AL) {
    const int b = blockIdx.x >> 3, n = blockIdx.x & 7, d = threadIdx.x, ch = n * 64 + d;
    __shared__ float Wr[64][64]; __shared__ float Wi[64][64]; __shared__ float xs[64];
    for (int c = 0; c < 64; ++c) { Wr[c][d] = w_r[(size_t)n * 4096 + c * 64 + d]; Wi[c][d] = w_i[(size_t)n * 4096 + c * 64 + d]; }
    const float cw0 = conv_w[ch], cw1 = conv_w[512 + ch], cw2 = conv_w[1024 + ch], cw3 = conv_w[1536 + ch], cb = conv_b[ch];
    const float br = b_r[ch], bi = b_i[ch];
    const float sp = log1pf(expf(-lru_lambda[ch]));
    float xm3 = 0.f, xm2 = 0.f, xm1 = 0.f, hst = 0.f;
    __syncthreads();
    for (int t = 0; t < SEQ; ++t) {
        const size_t row = (size_t)b * SEQ + t;
        const float xt = bf2f(XR[row * 512 + ch]);
        const float xc = cw0 * xm3 + cw1 * xm2 + cw2 * xm1 + cw3 * xt + cb;
        xm3 = xm2; xm2 = xm1; xm1 = xt;
        xs[d] = xc; __syncthreads();
        float rp = br, ip = bi;
        for (int c = 0; c < 64; ++c) { const float xv = xs[c]; rp += xv * Wr[c][d]; ip += xv * Wi[c][d]; }
        __syncthreads();
        const float r = sigmoidf_(rp), ig = sigmoidf_(ip);
        const float log_a = -8.f * r * sp;
        const float a = expf(log_a);
        const float mult = (t == 0) ? 1.f : sqrtf(-expm1f(2.f * log_a));
        hst = a * hst + xc * ig * mult;
        AL[row * 1024 + 512 + ch] = f2bf(hst * bf2f(GY[row * 512 + ch]));
    }
}

__global__ void n_moe_final(float* __restrict__ xio, const float* __restrict__ g_ffn, const float* __restrict__ w_group, const float* __restrict__ w_er, const float* __restrict__ w_gate, const float* __restrict__ w_up,
                            const float* __restrict__ w_down, const float* __restrict__ g_fin) {
    const int row = blockIdx.x, tid = threadIdx.x;
    __shared__ float x1[1024]; __shared__ float hn[1024]; __shared__ float hb[512]; __shared__ float red[512]; __shared__ float lg[16]; __shared__ int sel[4]; __shared__ float selw[2];
    float* xr = xio + (size_t)row * DM;
    const float a0 = xr[tid], a1 = xr[tid + 512];
    x1[tid] = a0; x1[tid + 512] = a1;
    red[tid] = a0 * a0 + a1 * a1; __syncthreads();
    for (int o = 256; o > 0; o >>= 1) { if (tid < o) red[tid] += red[tid + o]; __syncthreads(); }
    const float rstd = rsqrtf(red[0] / DM + EPS); __syncthreads();
    hn[tid] = a0 * rstd * g_ffn[tid]; hn[tid + 512] = a1 * rstd * g_ffn[tid + 512]; __syncthreads();
    if (tid < 4) { float s = 0.f; for (int k = 0; k < 1024; ++k) s += hn[k] * w_group[k * 4 + tid]; lg[tid] = s; }
    __syncthreads();
    if (tid == 0) { int g = 0; float mx = lg[0]; for (int j = 1; j < 4; ++j) if (lg[j] > mx) { mx = lg[j]; g = j; } float den = 0.f; for (int j = 0; j < 4; ++j) den += expf(lg[j] - mx); sel[0] = g; lg[8] = 1.f / den; }
    __syncthreads();
    const int grp = sel[0];
    if (tid < 8) { float s = 0.f; const float* w = w_er + (size_t)grp * 8192; for (int k = 0; k < 1024; ++k) s += hn[k] * w[k * 8 + tid]; lg[tid] = s; }
    __syncthreads();
    if (tid == 0) {
        const float gw = lg[8];
        int i0 = 0; for (int j = 1; j < 8; ++j) if (lg[j] > lg[i0]) i0 = j;
        int i1 = (i0 == 0) ? 1 : 0; for (int j = 0; j < 8; ++j) if (j != i0 && lg[j] > lg[i1]) i1 = j;
        const float p0 = 1.f / (1.f + expf(lg[i1] - lg[i0]));
        sel[1] = grp * 8 + i0; sel[2] = grp * 8 + i1; selw[0] = gw * p0; selw[1] = gw * (1.f - p0);
    }
    __syncthreads();
    float y0 = 0.f, y1 = 0.f;
    for (int kk = 0; kk < 2; ++kk) {
        const int e = sel[1 + kk]; const float wk = selw[kk];
        const float* wg = w_gate + (size_t)e * 1024 * 512; const float* wu = w_up + (size_t)e * 1024 * 512; const float* wd = w_down + (size_t)e * 512 * 1024;
        float g = 0.f, u = 0.f;
        for (int k = 0; k < 1024; ++k) { const float xv = hn[k]; g += xv * wg[(size_t)k * 512 + tid]; u += xv * wu[(size_t)k * 512 + tid]; }
        __syncthreads();
        hb[tid] = g / (1.f + expf(-g)) * u; __syncthreads();
        float s0 = 0.f, s1 = 0.f;
        for (int j = 0; j < 512; ++j) { const float hv = hb[j]; s0 += hv * wd[(size_t)j * 1024 + tid]; s1 += hv * wd[(size_t)j * 1024 + tid + 512]; }
        y0 += wk * s0; y1 += wk * s1;
    }
    const float z0 = a0 + y0, z1 = a1 + y1;
    __syncthreads();
    red[tid] = z0 * z0 + z1 * z1; __syncthreads();
    for (int o = 256; o > 0; o >>= 1) { if (tid < o) red[tid] += red[tid + o]; __syncthreads(); }
    const float rs2 = rsqrtf(red[0] / DM + EPS);
    xr[tid] = z0 * rs2 * g_fin[tid]; xr[tid + 512] = z1 * rs2 * g_fin[tid + 512];
}


__global__ void n_conv_win(const float* __restrict__ W, bf16* __restrict__ WT) {
    const int c = blockIdx.x * 256 + threadIdx.x, k = blockIdx.y;
    const int w = c & 255; const int row = (c & ~255) + ((w >> 5) & 1) * 128 + (w >> 6) * 32 + (w & 31);
    WT[(size_t)row * 1024 + k] = (bf16)f2bf(W[(size_t)k * INC + c]);
}
#ifndef MEGA_HI
#define MEGA_HI 11
#endif
static void launch_mega(const Args& a0, int lo, int hi, int li, int grid, hipStream_t stream) {
    Args a = a0; a.ph_lo = lo; a.ph_hi = hi; a.li = li;
    hipLaunchKernelGGL(mega, dim3(grid), dim3(NWAVES * 64), LDS_BYTES, stream, a);
    const hipError_t le = hipPeekAtLastError();
    if (le != hipSuccess) fprintf(stderr, "kernel_launch: mega launch [%d,%d) failed: %s\n", lo, hi, hipGetErrorName(le));
}
extern "C" void kernel_launch(void* const* d_in, const int* in_sizes, int n_in, void* d_out, int out_size, void* d_ws, size_t ws_size, hipStream_t stream) {
    static int grid = 0;
    if (grid == 0) {
        if (n_in != 22 || out_size != NTOK * DM || ws_size < WS_END) { fprintf(stderr, "kernel_launch: unexpected shapes (n_in %d out %d ws %zu)\n", n_in, out_size, ws_size); grid = -1; return; }
        int dev = 0, cus = 0, per_cu = 0;
        if (hipGetDevice(&dev) != hipSuccess || hipDeviceGetAttribute(&cus, hipDeviceAttributeMultiprocessorCount, dev) != hipSuccess) { grid = -1; return; }
        if (hipFuncSetAttribute((const void*)mega, hipFuncAttributeMaxDynamicSharedMemorySize, LDS_BYTES) != hipSuccess) { fprintf(stderr, "kernel_launch: hipFuncSetAttribute failed\n"); grid = -1; return; }
        if (hipOccupancyMaxActiveBlocksPerMultiprocessor(&per_cu, (const void*)mega, NWAVES * 64, LDS_BYTES) != hipSuccess || per_cu < 1) fprintf(stderr, "kernel_launch: occupancy query says %d\n", per_cu);
        (void)hipGetLastError();
        grid = cus;
    }
    if (grid < 0) return;
    (void)hipMemsetAsync((char*)d_ws + WS_CTL, 0, CTL_ZERO_BYTES, stream);
    Args a{};
    for (int i = 0; i < 22; ++i) a.in[i] = (const float*)d_in[i];
    a.out = (float*)d_out; a.ws = (unsigned char*)d_ws;
    const float* x = (const float*)d_in[0];
    unsigned char* ws = (unsigned char*)d_ws;
    bf16* XN = (bf16*)(ws + WS_XN); bf16* Qb = (bf16*)(ws + WS_Q); bf16* Kb = (bf16*)(ws + WS_K); bf16* Vb = (bf16*)(ws + WS_V);
    bf16* XR = (bf16*)(ws + WS_XR); bf16* GY = (bf16*)(ws + WS_GY); bf16* AL = (bf16*)(ws + WS_AL); bf16* MERGED = (bf16*)(ws + WS_MERGED);
    bf16* GATES = (bf16*)d_out;
#ifdef DUP_PHASE
    launch_mega(a, 0, DUP_PHASE + 1, 0, grid, stream);
    launch_mega(a, DUP_PHASE, DUP_PHASE + 1, 1, grid, stream);
    if (DUP_PHASE + 1 < 11) launch_mega(a, DUP_PHASE + 1, 11, 2, grid, stream);
#elif defined(PROBE_P1_ONLY)
    n_rmsnorm<<<NTOK, 256, 0, stream>>>(x, (const float*)d_in[1], XN);
    n_conv_win<<<dim3(INC / 256, 1024), 256, 0, stream>>>((const float*)d_in[2], (bf16*)(ws + WS_WIN));
    launch_mega(a, 1, 2, 0, grid, stream);
#elif defined(MEGA_SPLIT)
    for (int ph = 0; ph < MEGA_HI; ++ph) launch_mega(a, ph, ph + 1, ph, grid, stream);
#else
    if (MEGA_HI > 0) launch_mega(a, 0, MEGA_HI, 0, grid, stream);
#endif
    if (MEGA_HI < 1) n_rmsnorm<<<NTOK, 256, 0, stream>>>(x, (const float*)d_in[1], XN);
    if (MEGA_HI < 2) n_gemm<EpiInProjN><<<dim3(INC / 64, NTOK / 64), dim3(16, 16), 0, stream>>>(XN, DM, (const float*)d_in[2], INC, DM, EpiInProjN{Qb, Kb, Vb, XR, GY, GATES});
    if (MEGA_HI < 3) n_attn<<<dim3(NTOK, 4), 256, 0, stream>>>(Qb, Kb, Vb, (const float*)d_in[3], (const float*)d_in[4], AL);
    if (MEGA_HI < 4) n_lru<<<16, 64, 0, stream>>>(XR, GY, (const float*)d_in[5], (const float*)d_in[6], (const float*)d_in[7], (const float*)d_in[8], (const float*)d_in[9], (const float*)d_in[10], (const float*)d_in[11], AL);
    if (MEGA_HI < 5) n_gemm_mix<<<dim3(DM / 64, NTOK / 64), dim3(16, 16), 0, stream>>>(AL, (const float*)d_in[12], (const float*)d_in[13], GATES, MERGED);
    if (MEGA_HI < 6) n_gemm<EpiResid><<<dim3(DM / 64, NTOK / 64), dim3(16, 16), 0, stream>>>(MERGED, DM, (const float*)d_in[14], DM, DM, EpiResid{x, (float*)d_out});
    if (MEGA_HI < 11) n_moe_final<<<NTOK, 512, 0, stream>>>((float*)d_out, (const float*)d_in[15], (const float*)d_in[16], (const float*)d_in[17], (const float*)d_in[18], (const float*)d_in[19], (const float*)d_in[20], (const float*)d_in[21]);
}
```

```cpp
#include <hip/hip_runtime.h>
#include <cstdio>
#include <cstdint>
#include <cmath>

constexpr int NTOK = 16384, SEQ = 8192, DM = 1024, INC = 4608;
constexpr float C2 = 0.125f * 1.4426950408889634f;
constexpr float LOG2E = 1.4426950408889634f;
constexpr float EPS = 1e-6f;
typedef unsigned short bf16;

__device__ __forceinline__ unsigned f2bf(float f) { unsigned u = __builtin_bit_cast(unsigned, f); return (u + 0x7fffu + ((u >> 16) & 1u)) >> 16; }
__device__ __forceinline__ unsigned pk2(float lo, float hi) { return f2bf(lo) | (f2bf(hi) << 16); }
__device__ __forceinline__ float bf2f(bf16 b) { return __builtin_bit_cast(float, (unsigned)b << 16); }
__device__ __forceinline__ float sigmoidf_(float x) { return 1.f / (1.f + __expf(-x)); }
__device__ __forceinline__ float gelu_tanh(float x) { const float z = 0.7978845608028654f * (x + 0.044715f * x * x * x); return 0.5f * x * (1.f + tanhf(z)); }
__device__ __forceinline__ float sigmoid_fast(float x) { return __builtin_amdgcn_rcpf(1.f + __builtin_amdgcn_exp2f(-LOG2E * x)); }
__device__ __forceinline__ float gelu_fast(float x) { const float z2 = 1.5957691216057308f * (x + 0.044715f * x * x * x); return x * sigmoid_fast(z2); }

constexpr size_t MiB = 1u << 20;
constexpr size_t WS_CTL = 0, CTL_ZERO_BYTES = 1 * MiB;
constexpr size_t WS_WIN = 1 * MiB, WS_WMIX = 10 * MiB, WS_WOUT = 12 * MiB, WS_WGU = 14 * MiB, WS_WD = 78 * MiB;
constexpr size_t WS_XN = 110 * MiB, WS_Q = 142 * MiB, WS_K = 158 * MiB, WS_V = 174 * MiB, WS_XR = 190 * MiB, WS_GY = 206 * MiB, WS_AL = 222 * MiB;
constexpr size_t WS_PG = 110 * MiB, WS_QG = 126 * MiB;
constexpr size_t WS_MERGED = 142 * MiB;
constexpr size_t WS_XS = 110 * MiB, WS_HB = 190 * MiB, WS_YB = 110 * MiB;
constexpr size_t WS_HNB = 222 * MiB;
constexpr size_t WS_MISC = 254 * MiB;
constexpr size_t WS_END = 256 * MiB;
constexpr int CW_QKMAX = 64;
constexpr int CW_CNT = 128;
constexpr int CW_BAR = 4096;
namespace pg8 {
#define PG8_LAS __attribute__((address_space(3)))
typedef unsigned short bf16_t;
typedef short bf16x8 __attribute__((ext_vector_type(8)));
typedef float f32x4 __attribute__((ext_vector_type(4)));
typedef unsigned u32x4 __attribute__((ext_vector_type(4)));
constexpr int BM = 256, BK = 64, HALF = 128, HTB = HALF * BK * 2  , STAGE_BYTES = 8 * HTB, NXCD = 8, WGM = 8;

__host__ __device__ __forceinline__ int lds_byte(int r, int c) { const int st = (r >> 4) * 2 + (c >> 5), rr = r & 15, cc = c & 31, ob = rr * 64 + cc * 2; return st * 1024 + (ob ^ (((ob >> 9) & 1) << 5)); }
__host__ __device__ __forceinline__ void stage_rc(int b, int& R, int& C) { const int st = b / 1024, sb = b % 1024, swz = sb ^ (((sb >> 9) & 1) << 5); R = (st >> 1) * 16 + swz / 64; C = (st & 1) * 32 + (swz % 64) / 2; }
__host__ __device__ __forceinline__ int perm32(int rho) { const int n = rho >> 4, i = rho & 15; return 8 * (i >> 2) + 4 * n + (i & 3); }

struct Unit { int pm, pn, bt; };
struct Gemm { const bf16_t* A; const bf16_t* Bt; int M, N, K; };

struct StaticOrder {
    int nM, nN, nwg, G, c;
    __host__ __device__ void init(int M, int N, int G_, int c_) { nM = M / BM; nN = N / BM; nwg = nM * nN; G = G_; c = c_; }
    __host__ __device__ bool next(int i, Unit& u) const {
        const long L = (long)i * G + c; if (L >= nwg) return false;
        int wgid = (int)L; { const int q = nwg / NXCD, r = nwg % NXCD, xcd = wgid % NXCD, off = wgid / NXCD; wgid = (xcd < r ? xcd * (q + 1) : r * (q + 1) + (xcd - r) * q) + off; }
        const int nig = WGM * nN, gid = wgid / nig, fm = gid * WGM, gsz = (nM - fm) < WGM ? (nM - fm) : WGM;
        u.pm = fm + ((wgid % nig) % gsz); u.pn = (wgid % nig) / gsz; u.bt = u.pn; return true;
    }
    __device__ __forceinline__ void a_ready(const Unit&) const {}
    __device__ __forceinline__ void done(const Unit&) const {}
};

typedef float f32x2 __attribute__((ext_vector_type(2))); typedef __bf16 bf16x2_t __attribute__((ext_vector_type(2)));
__device__ __forceinline__ unsigned cvt_pk_bf16(float lo, float hi) { const f32x2 v = {lo, hi}; const bf16x2_t b = __builtin_convertvector(v, bf16x2_t); return __builtin_bit_cast(unsigned, b); }
struct EpiInProj {
    static constexpr bool PERM = true, AFTER_DRAIN = false, HAS_MID = false;
#ifdef NO_NORMS
    static constexpr bool NORMS = false;
#else
    static constexpr bool NORMS = true;
#endif
    bf16_t *Q, *K, *V, *XR, *GY, *GATES; unsigned* qkmax;
    template <int CAT> __device__ __forceinline__ void run(const f32x4 (&acc)[2][2][4][2], bf16_t* base, int ldc, int row0, int col0, unsigned* mx) const {
        float nrm = 0.f;
#pragma unroll
        for (int ai = 0; ai < 2; ++ai)
#pragma unroll
            for (int m = 0; m < 4; ++m) { bf16_t* rowp = base + (size_t)(row0 + ai * HALF + m * 16) * ldc + col0; float ss = 0.f;
#pragma unroll
                for (int bj = 0; bj < 2; ++bj) { f32x4 v0 = acc[ai][bj][m][0], v1 = acc[ai][bj][m][1];
                    if (CAT == 0) { v0 = v0 * C2; v1 = v1 * C2; }
                    if (CAT == 4) {
#pragma unroll
                        for (int j = 0; j < 4; ++j) { v0[j] = gelu_fast(v0[j]); v1[j] = gelu_fast(v1[j]); } }
                    if (CAT == 5) {
#pragma unroll
                        for (int j = 0; j < 4; ++j) { v0[j] = sigmoid_fast(v0[j]); v1[j] = sigmoid_fast(v1[j]); } }
                    if (NORMS && CAT <= 1) ss += (v0[0] * v0[0] + v0[1] * v0[1]) + (v0[2] * v0[2] + v0[3] * v0[3]) + (v1[0] * v1[0] + v1[1] * v1[1]) + (v1[2] * v1[2] + v1[3] * v1[3]);
                    u32x4 w; w.x = cvt_pk_bf16(v0[0], v0[1]); w.y = cvt_pk_bf16(v0[2], v0[3]); w.z = cvt_pk_bf16(v1[0], v1[1]); w.w = cvt_pk_bf16(v1[2], v1[3]);
                    *(u32x4*)(rowp + bj * 32) = w; }
                if (NORMS && CAT <= 1) { ss += __shfl_xor(ss, 16); ss += __shfl_xor(ss, 32); nrm = fmaxf(nrm, ss); } }
        if (NORMS && CAT <= 1) {
#pragma unroll
            for (int o = 1; o < 16; o <<= 1) nrm = fmaxf(nrm, __shfl_xor(nrm, o));
            if ((threadIdx.x & 63) == 0) atomicMax(mx, __builtin_bit_cast(unsigned, nrm * 1.02f)); }
    }
    __device__ __forceinline__ void operator()(const f32x4 (&acc)[2][2][4][2], const Unit& u, int wr, int wc, int fr, int fq) const {
        const int pn = u.pn, row0 = u.pm * BM + wr * 64 + fr, cw = wc * 64 + 8 * fq, b = u.pm >> 5;
        if (pn < 2)       run<0>(acc, Q, 512, row0, pn * 256 + cw, qkmax + b * 16 + 0 + (pn & 1) * 4 + wc);
        else if (pn < 4)  run<1>(acc, K, 512, row0, (pn - 2) * 256 + cw, qkmax + b * 16 + 8 + (pn & 1) * 4 + wc);
        else if (pn < 6)  run<2>(acc, V, 512, row0, (pn - 4) * 256 + cw, nullptr);
        else if (pn < 8)  run<3>(acc, XR, 512, row0, (pn - 6) * 256 + cw, nullptr);
        else if (pn < 10) run<4>(acc, GY, 512, row0, (pn - 8) * 256 + cw, nullptr);
        else              run<5>(acc, GATES, 2048, row0, (pn - 10) * 256 + cw, nullptr);
    }
};
struct EpiMix {
    static constexpr bool PERM = true, AFTER_DRAIN = false, HAS_MID = true;
    const bf16_t* GATES; bf16_t* OUT;
    __device__ __forceinline__ void mid(f32x4 (&acc)[2][2][4][2], const Unit& u, int wr, int wc, int fr, int fq) const {
        int row0 = u.pm * BM + wr * 64 + fr; const int col0 = u.pn * BM + wc * 32 + 8 * fq;
        asm volatile("" : "+v"(row0));
#pragma unroll
        for (int ai = 0; ai < 2; ++ai)
#pragma unroll
            for (int m = 0; m < 4; ++m) { const bf16_t* gp = GATES + (size_t)(row0 + ai * HALF + m * 16) * 2048 + col0;
#pragma unroll
                for (int bj = 0; bj < 2; ++bj) { const u32x4 ga = *(const u32x4*)(gp + bj * HALF), gl = *(const u32x4*)(gp + 1024 + bj * HALF);
#pragma unroll
                    for (int e = 0; e < 4; ++e) { const float a0 = __builtin_bit_cast(float, ga[e] << 16), a1 = __builtin_bit_cast(float, ga[e] & 0xffff0000u);
                        const float l0 = __builtin_bit_cast(float, gl[e] << 16), l1 = __builtin_bit_cast(float, gl[e] & 0xffff0000u);
                        acc[ai][bj][m][e >> 1][(e & 1) * 2] *= a0 * __builtin_amdgcn_rcpf(l0); acc[ai][bj][m][e >> 1][(e & 1) * 2 + 1] *= a1 * __builtin_amdgcn_rcpf(l1); } }
                asm volatile("" ::: "memory"); }
    }
    __device__ __forceinline__ void operator()(const f32x4 (&acc)[2][2][4][2], const Unit& u, int wr, int wc, int fr, int fq) const {
        const int row0 = u.pm * BM + wr * 64 + fr, col0 = u.pn * BM + wc * 32 + 8 * fq;
#pragma unroll
        for (int ai = 0; ai < 2; ++ai)
#pragma unroll
            for (int m = 0; m < 4; ++m) { const size_t r = (size_t)(row0 + ai * HALF + m * 16);
#pragma unroll
                for (int bj = 0; bj < 2; ++bj) { const u32x4 gl = *(const u32x4*)(GATES + r * 2048 + 1024 + col0 + bj * HALF);
                    const f32x4 v0 = acc[ai][bj][m][0], v1 = acc[ai][bj][m][1]; u32x4 w;
                    w.x = cvt_pk_bf16(v0[0] * __builtin_bit_cast(float, gl[0] << 16), v0[1] * __builtin_bit_cast(float, gl[0] & 0xffff0000u));
                    w.y = cvt_pk_bf16(v0[2] * __builtin_bit_cast(float, gl[1] << 16), v0[3] * __builtin_bit_cast(float, gl[1] & 0xffff0000u));
                    w.z = cvt_pk_bf16(v1[0] * __builtin_bit_cast(float, gl[2] << 16), v1[1] * __builtin_bit_cast(float, gl[2] & 0xffff0000u));
                    w.w = cvt_pk_bf16(v1[2] * __builtin_bit_cast(float, gl[3] << 16), v1[3] * __builtin_bit_cast(float, gl[3] & 0xffff0000u));
                    *(u32x4*)(OUT + r * 1024 + col0 + bj * HALF) = w; }
                asm volatile("" ::: "memory"); }
    }
};
struct EpiResidF32 {
    static constexpr bool PERM = false, AFTER_DRAIN = false, HAS_MID = false;
    const float* base; float* out;
    __device__ __forceinline__ void operator()(const f32x4 (&acc)[2][2][4][2], const Unit& u, int wr, int wc, int fr, int fq) const {
        const int row0 = u.pm * BM + wr * 64 + fr, col0 = u.pn * BM + wc * 32 + 4 * fq;
#pragma unroll
        for (int ai = 0; ai < 2; ++ai)
#pragma unroll
            for (int m = 0; m < 4; ++m) { const size_t off = (size_t)(row0 + ai * HALF + m * 16) * 1024 + col0;
#pragma unroll
                for (int bj = 0; bj < 2; ++bj)
#pragma unroll
                    for (int n = 0; n < 2; ++n) *(f32x4*)(out + off + bj * HALF + n * 16) = *(const f32x4*)(base + off + bj * HALF + n * 16) + acc[ai][bj][m][n];
                asm volatile("" ::: "memory"); }
    }
};
struct MoeOrder {
    const PG8_LAS int* pad; int nunits, G, c;
    __device__ __forceinline__ void init(const PG8_LAS int* pad_, int G_, int c_) { pad = pad_; nunits = (pad_[32] >> 8) * 4; G = G_; c = c_; }
    __device__ __forceinline__ bool next(int i, Unit& u) const {
        const int L = i * G + c; if (L >= nunits) return false;
        const int tile = L >> 2, pn = L & 3, slot = tile << 8; int e = 0;
        for (int j = 1; j < 32; ++j) e += (pad[j] <= slot) ? 1 : 0;
        u.pm = tile; u.pn = pn; u.bt = e * 4 + pn; return true;
    }
    __device__ __forceinline__ void a_ready(const Unit&) const {}
    __device__ __forceinline__ void done(const Unit&) const {}
};
struct EpiSwiGLU {
    static constexpr bool PERM = true, AFTER_DRAIN = false, HAS_MID = false;
    bf16_t* H;
    __device__ __forceinline__ void operator()(const f32x4 (&acc)[2][2][4][2], const Unit& u, int wr, int wc, int fr, int fq) const {
        const int row0 = u.pm * BM + wr * 64 + fr, col0 = u.pn * HALF + wc * 32 + 8 * fq;
#pragma unroll
        for (int ai = 0; ai < 2; ++ai)
#pragma unroll
            for (int m = 0; m < 4; ++m) { float h[8];
#pragma unroll
                for (int n = 0; n < 2; ++n)
#pragma unroll
                    for (int e = 0; e < 4; ++e) { const float g = acc[ai][0][m][n][e], up = acc[ai][1][m][n][e]; h[n * 4 + e] = g * sigmoid_fast(g) * up; }
                u32x4 w; w.x = cvt_pk_bf16(h[0], h[1]); w.y = cvt_pk_bf16(h[2], h[3]); w.z = cvt_pk_bf16(h[4], h[5]); w.w = cvt_pk_bf16(h[6], h[7]);
                *(u32x4*)(H + (size_t)(row0 + ai * HALF + m * 16) * 512 + col0) = w; }
    }
};
struct EpiStoreBf16 {
    static constexpr bool PERM = true, AFTER_DRAIN = false, HAS_MID = false;
    bf16_t* O; int ldc;
    __device__ __forceinline__ void operator()(const f32x4 (&acc)[2][2][4][2], const Unit& u, int wr, int wc, int fr, int fq) const {
        const int row0 = u.pm * BM + wr * 64 + fr, col0 = u.pn * BM + wc * 32 + 8 * fq;
#pragma unroll
        for (int ai = 0; ai < 2; ++ai)
#pragma unroll
            for (int m = 0; m < 4; ++m) { bf16_t* rowp = O + (size_t)(row0 + ai * HALF + m * 16) * ldc + col0;
#pragma unroll
                for (int bj = 0; bj < 2; ++bj) { const f32x4 v0 = acc[ai][bj][m][0], v1 = acc[ai][bj][m][1]; u32x4 w;
                    w.x = cvt_pk_bf16(v0[0], v0[1]); w.y = cvt_pk_bf16(v0[2], v0[3]); w.z = cvt_pk_bf16(v1[0], v1[1]); w.w = cvt_pk_bf16(v1[2], v1[3]);
                    *(u32x4*)(rowp + bj * HALF) = w; } }
    }
};
template <class Epi, class Sched, bool ALIGN_EPI = false, bool SP2 = false>
__device__ __forceinline__ void gemm_phase(PG8_LAS unsigned char* lds, const Gemm g, const Sched& S, const Epi& E) {
    int tid_ = threadIdx.x; asm volatile("" : "+v"(tid_));
    const int tid = tid_, wid = __builtin_amdgcn_readfirstlane(tid >> 6), lane = tid & 63, wr = wid >> 2, wc = wid & 3, fr = lane & 15, fq = lane >> 4;
    const int K = g.K, nt = K / BK;
    unsigned voffA[2], voffB[2];
#pragma unroll
    for (int i = 0; i < 2; ++i) { int R, C; stage_rc(tid * 16 + i * 8192, R, C); const int Rb = Epi::PERM ? ((R & ~31) + perm32(R & 31)) : R;
        voffA[i] = (unsigned)(R * K + C) * 2u; voffB[i] = (unsigned)(Rb * K + C) * 2u; }
    const size_t kstep = (size_t)(BK * 2);
    const size_t hstep = (size_t)HALF * K * 2;
    const size_t tstep = 2 * hstep;
    const unsigned ldsw = (unsigned)wid * 1024u;
    const int aoff = lds_byte(wr * 64 + fr, fq * 8), boff = lds_byte(wc * 32 + fr, fq * 8);
#define PG8_SA(b, h) (((b) * 2 + (h)) * HTB)
#define PG8_SB(b, h) ((4 + (b) * 2 + (h)) * HTB)
#define PG8_STAGE(bufoff, gbase, voff) do { _Pragma("unroll") for (int _i = 0; _i < 2; ++_i) \
        __builtin_amdgcn_global_load_lds((const unsigned*)((const char*)(gbase) + (voff)[_i]), (PG8_LAS unsigned*)(lds + (bufoff) + ldsw + _i * 8192), 16, 0, 0); } while (0)
#define PG8_LDA(dst, b, h) do { _Pragma("unroll") for (int m = 0; m < 4; ++m) _Pragma("unroll") for (int k = 0; k < 2; ++k) dst[m][k] = *(const PG8_LAS bf16x8*)(lds + PG8_SA(b, h) + aoff + m * 2048 + k * 1024); } while (0)
#define PG8_LDB(dst, b, h) do { _Pragma("unroll") for (int n = 0; n < 2; ++n) _Pragma("unroll") for (int k = 0; k < 2; ++k) dst[n][k] = *(const PG8_LAS bf16x8*)(lds + PG8_SB(b, h) + boff + n * 2048 + k * 1024); } while (0)
#define PG8_MMA(ai, bj, At, Bt) do { __builtin_amdgcn_s_setprio(1); _Pragma("unroll") for (int m = 0; m < 4; ++m) _Pragma("unroll") for (int n = 0; n < 2; ++n) _Pragma("unroll") for (int k = 0; k < 2; ++k) \
        acc[ai][bj][m][n] = __builtin_amdgcn_mfma_f32_16x16x32_bf16(Bt[n][k], At[m][k], acc[ai][bj][m][n], 0, 0, 0); __builtin_amdgcn_s_setprio(0); } while (0)
#define PG8_WAIT_V(n) asm volatile("s_waitcnt vmcnt(" #n ")" ::: "memory")
#define PG8_WAIT_L(n) asm volatile("s_waitcnt lgkmcnt(" #n ")" ::: "memory")
#define PG8_BAR __builtin_amdgcn_s_barrier()
#define PG8_SCHED __builtin_amdgcn_sched_barrier(0)
    Unit cur, nxt; int ui = 0;
    if (!S.next(0, cur)) return;
    f32x4 acc[2][2][4][2];
#pragma unroll
    for (int a = 0; a < 2; ++a)
#pragma unroll
        for (int b = 0; b < 2; ++b)
#pragma unroll
            for (int m = 0; m < 4; ++m)
#pragma unroll
                for (int n = 0; n < 2; ++n) acc[a][b][m][n] = (f32x4){0.f, 0.f, 0.f, 0.f};
    bf16x8 At[4][2], B0[2][2], B1[2][2];
    const char* cA = (const char*)g.A + (size_t)cur.pm * tstep; const char* cB = (const char*)g.Bt + (size_t)cur.bt * tstep;
    S.a_ready(cur);
    if constexpr (SP2) {
        PG8_STAGE(PG8_SB(0, 0), cB, voffB); PG8_STAGE(PG8_SB(0, 1), cB + hstep, voffB); PG8_STAGE(PG8_SA(0, 0), cA, voffA); PG8_STAGE(PG8_SA(0, 1), cA + hstep, voffA);
        if (wr == 1) PG8_BAR;
        PG8_WAIT_V(2); PG8_BAR;
        PG8_STAGE(PG8_SB(1, 0), cB + kstep, voffB); PG8_STAGE(PG8_SA(1, 0), cA + kstep, voffA); PG8_STAGE(PG8_SB(1, 1), cB + hstep + kstep, voffB);
        PG8_WAIT_V(6); PG8_BAR;
    } else {
        PG8_STAGE(PG8_SB(0, 0), cB, voffB); PG8_STAGE(PG8_SA(0, 0), cA, voffA); PG8_STAGE(PG8_SB(0, 1), cB + hstep, voffB); PG8_STAGE(PG8_SA(0, 1), cA + hstep, voffA);
        if (wr == 1) PG8_BAR;
        PG8_WAIT_V(4); PG8_BAR;
        PG8_STAGE(PG8_SB(1, 0), cB + kstep, voffB); PG8_STAGE(PG8_SA(1, 0), cA + kstep, voffA); PG8_STAGE(PG8_SB(1, 1), cB + hstep + kstep, voffB);
        PG8_WAIT_V(6); PG8_BAR;
    }
    for (;;) {
        const bool has_next = S.next(ui + 1, nxt);
        const char* nA = has_next ? (const char*)g.A + (size_t)nxt.pm * tstep : cA; const char* nB = has_next ? (const char*)g.Bt + (size_t)nxt.bt * tstep : cB;
        for (int t = 0; t < nt; t += 2) {
            const bool last = (t == nt - 2);
            if constexpr (Epi::HAS_MID) { if (t == (nt >> 1)) E.mid(acc, cur, wr, wc, fr, fq); }
            const char* a1 = cA + (size_t)(t + 1) * kstep;
            const char* a2 = last ? nA : cA + (size_t)(t + 2) * kstep; const char* b2 = last ? nB : cB + (size_t)(t + 2) * kstep;
            const char* a3 = a2 + kstep; const char* b3 = b2 + kstep;
            if (last && has_next) S.a_ready(nxt);
            if constexpr (SP2) {
            PG8_LDB(B0, 0, 0); PG8_LDB(B1, 0, 1); PG8_SCHED; PG8_LDA(At, 0, 0); PG8_STAGE(PG8_SA(1, 1), a1 + hstep, voffA);
            PG8_WAIT_V(8); PG8_WAIT_L(0); PG8_BAR; PG8_MMA(0, 0, At, B0); PG8_MMA(0, 1, At, B1); PG8_BAR; PG8_SCHED;
            PG8_LDA(At, 0, 1); PG8_STAGE(PG8_SB(0, 0), b2, voffB); PG8_STAGE(PG8_SB(0, 1), b2 + hstep, voffB); PG8_STAGE(PG8_SA(0, 0), a2, voffA);
            PG8_WAIT_V(8); PG8_WAIT_L(0); PG8_BAR; PG8_MMA(1, 0, At, B0); PG8_MMA(1, 1, At, B1); PG8_BAR; PG8_SCHED;
            PG8_LDB(B0, 1, 0); PG8_LDB(B1, 1, 1); PG8_SCHED; PG8_LDA(At, 1, 0); PG8_STAGE(PG8_SA(0, 1), a2 + hstep, voffA);
            PG8_WAIT_V(8); PG8_WAIT_L(0); PG8_BAR; PG8_MMA(0, 0, At, B0); PG8_MMA(0, 1, At, B1); PG8_BAR; PG8_SCHED;
            PG8_LDA(At, 1, 1); PG8_STAGE(PG8_SB(1, 0), b3, voffB); PG8_STAGE(PG8_SB(1, 1), b3 + hstep, voffB); PG8_STAGE(PG8_SA(1, 0), a3, voffA);
            PG8_WAIT_V(8); PG8_WAIT_L(0); PG8_BAR; PG8_MMA(1, 0, At, B0); PG8_MMA(1, 1, At, B1); PG8_BAR; PG8_SCHED;
            } else {
            PG8_LDB(B0, 0, 0); PG8_SCHED; PG8_LDA(At, 0, 0); PG8_STAGE(PG8_SA(1, 1), a1 + hstep, voffA);
            PG8_WAIT_L(8); PG8_BAR; PG8_WAIT_L(0); PG8_MMA(0, 0, At, B0); PG8_BAR; PG8_SCHED;
            PG8_LDB(B1, 0, 1); PG8_STAGE(PG8_SB(0, 0), b2, voffB);
            PG8_BAR; PG8_WAIT_L(0); PG8_MMA(0, 1, At, B1); PG8_BAR;
            PG8_LDA(At, 0, 1); PG8_STAGE(PG8_SA(0, 0), a2, voffA);
            PG8_BAR; PG8_WAIT_L(0); PG8_MMA(1, 0, At, B0); PG8_BAR; PG8_SCHED;
            PG8_STAGE(PG8_SB(0, 1), b2 + hstep, voffB);
            PG8_WAIT_V(6); PG8_BAR; PG8_MMA(1, 1, At, B1); PG8_BAR;
            PG8_LDB(B0, 1, 0); PG8_SCHED; PG8_LDA(At, 1, 0); PG8_STAGE(PG8_SA(0, 1), a2 + hstep, voffA);
            PG8_WAIT_L(8); PG8_BAR; PG8_WAIT_L(0); PG8_MMA(0, 0, At, B0); PG8_BAR; PG8_SCHED;
            PG8_LDB(B1, 1, 1); PG8_STAGE(PG8_SB(1, 0), b3, voffB);
            PG8_BAR; PG8_WAIT_L(0); PG8_MMA(0, 1, At, B1); PG8_BAR;
            PG8_LDA(At, 1, 1); PG8_STAGE(PG8_SA(1, 0), a3, voffA);
            PG8_BAR; PG8_WAIT_L(0); PG8_MMA(1, 0, At, B0); PG8_BAR; PG8_SCHED;
            PG8_STAGE(PG8_SB(1, 1), b3 + hstep, voffB);
            PG8_WAIT_V(6); PG8_BAR; PG8_MMA(1, 1, At, B1); PG8_BAR;
            }
        }
        if constexpr (ALIGN_EPI) { if (wr == 0) PG8_BAR; }
        if constexpr (!Epi::AFTER_DRAIN) { E(acc, cur, wr, wc, fr, fq); S.done(cur); }
        if (!has_next) break;
#pragma unroll
        for (int a = 0; a < 2; ++a)
#pragma unroll
            for (int b = 0; b < 2; ++b)
#pragma unroll
                for (int m = 0; m < 4; ++m)
#pragma unroll
                    for (int n = 0; n < 2; ++n) acc[a][b][m][n] = (f32x4){0.f, 0.f, 0.f, 0.f};
        cur = nxt; cA = nA; cB = nB; ++ui;
        if constexpr (ALIGN_EPI) { if (wr == 1) PG8_BAR; }
    }
    PG8_WAIT_V(0);
    if constexpr (!ALIGN_EPI) { if (wr == 0) PG8_BAR; }
    PG8_BAR;
    if constexpr (Epi::AFTER_DRAIN) { E.fused(acc, cur, wr, wc, fr, fq, lds, wid, lane); S.done(cur); }
#undef PG8_SA
#undef PG8_SB
#undef PG8_STAGE
#undef PG8_LDA
#undef PG8_LDB
#undef PG8_MMA
#undef PG8_WAIT_V
#undef PG8_WAIT_L
#undef PG8_BAR
#undef PG8_SCHED
}
}
#define GAS __attribute__((address_space(1)))
#define LAS __attribute__((address_space(3)))
typedef unsigned v4u __attribute__((ext_vector_type(4)));
typedef float f32x4 __attribute__((ext_vector_type(4)));
typedef short bf16x8 __attribute__((ext_vector_type(8)));
typedef GAS unsigned gu32;
typedef GAS unsigned long long gu64;
#define RLX_AGENT __ATOMIC_RELAXED, __HIP_MEMORY_SCOPE_AGENT
#define LDS_WAIT() asm volatile("s_waitcnt lgkmcnt(0)" ::: "memory")
#define VM_WAIT() asm volatile("s_waitcnt vmcnt(0)" ::: "memory")
#define XB_TMO      128
#define XB_XCNT(j)  (256  + 64 * (j))
#define XB_XSUB(j)  (1280 + 64 * (j))
#define XB_XGEN(j)  (2304 + 64 * (j))
#define XB_TOP      3328
#define XB_TOPGEN   3392
#define XCD_BAR_WORDS 3456
#define XB_SPIN_CAP (1u << 18)

__device__ __forceinline__ unsigned xb_ld(unsigned* p)              { return __hip_atomic_load(p, __ATOMIC_RELAXED, __HIP_MEMORY_SCOPE_AGENT); }
__device__ __forceinline__ unsigned xb_add(unsigned* p, unsigned v) { return __hip_atomic_fetch_add(p, v, __ATOMIC_RELAXED, __HIP_MEMORY_SCOPE_AGENT); }
__device__ __forceinline__ unsigned xb_xcc_id() { return (unsigned)__builtin_amdgcn_s_getreg((3 << 11) | 20) & 0xFu; }
#define XB_SPIN(cond, bar) do { unsigned _sp = 0; while (cond) { __builtin_amdgcn_s_sleep(1); \
    if ((++_sp & 255u) == 0u) { if (xb_ld(&(bar)[XB_TMO])) break; if (_sp > XB_SPIN_CAP) { atomicAdd(&(bar)[XB_TMO], 1u); break; } } } } while (0)

struct XcdBarrier {
    unsigned* bar; unsigned x;
    volatile LAS unsigned* st;
};

__device__ __forceinline__ XcdBarrier xcd_barrier_post(unsigned* bar, volatile LAS unsigned* st) {
    XcdBarrier b; b.bar = bar; b.x = xb_xcc_id(); b.st = st;
    if (threadIdx.x == 0) (void)xb_add(&bar[XB_XCNT(b.x)], 1u);
    return b;
}
__device__ __forceinline__ void xcd_barrier_complete(unsigned* bar, unsigned x, unsigned& nloc, unsigned& nx) {
    const unsigned G = gridDim.x * gridDim.y * gridDim.z;
    unsigned sum, cnt, mine, sp = 0u;
    for (;;) {
        sum = 0u; cnt = 0u; mine = 0u;
#pragma unroll
        for (unsigned j = 0; j < 16; ++j) { const unsigned c = xb_ld(&bar[XB_XCNT(j)]); sum += c; cnt += (c > 0u) ? 1u : 0u; mine = (j == x) ? c : mine; }
        if (sum == G) break;
        __builtin_amdgcn_s_sleep(1);
        if ((++sp & 255u) == 0u) { if (xb_ld(&bar[XB_TMO])) break; if (sp > XB_SPIN_CAP) { atomicAdd(&bar[XB_TMO], 1u); break; } }
    }
    nloc = mine > 0u ? mine : 1u; nx = cnt > 0u ? cnt : 1u;
}

__device__ __forceinline__ void xcd_barrier(const XcdBarrier& b) {
    asm volatile("s_waitcnt vmcnt(0)" ::: "memory");
    __syncthreads();
    if (threadIdx.x == 0) {
        unsigned* bar = b.bar;
        __builtin_amdgcn_s_waitcnt(0);
        unsigned nloc = b.st[0], nx = b.st[1];
        if (nloc == 0u) { xcd_barrier_complete(bar, b.x, nloc, nx); b.st[0] = nloc; b.st[1] = nx; }
        const unsigned old = xb_add(&bar[XB_XSUB(b.x)], 1u);
        const unsigned gen = old / nloc;
        if (old + 1u == (gen + 1u) * nloc) {
            __builtin_amdgcn_fence(__ATOMIC_RELEASE, "agent");
            asm volatile("s_waitcnt vmcnt(0)" ::: "memory");
            const unsigned og = xb_add(&bar[XB_TOP], 1u);
            const unsigned tg = og / nx;
            if (og + 1u == (tg + 1u) * nx) xb_add(&bar[XB_TOPGEN], 1u);
            else XB_SPIN(xb_ld(&bar[XB_TOPGEN]) == tg, bar);
            __builtin_amdgcn_fence(__ATOMIC_ACQUIRE, "agent");
            xb_add(&bar[XB_XGEN(b.x)], 1u);
            asm volatile("s_waitcnt vmcnt(0)" ::: "memory");
        } else {
            XB_SPIN(xb_ld(&bar[XB_XGEN(b.x)]) == gen, bar);
            __builtin_amdgcn_fence(__ATOMIC_ACQUIRE, "agent");
            asm volatile("s_waitcnt vmcnt(0)" ::: "memory");
        }
    }
    __syncthreads();
}

constexpr int NWAVES = 8;
constexpr int RING_OFF = 0, RING_BYTES = 131072;
constexpr int SCR_BYTES = 147456;
constexpr int LDSCTL_OFF = SCR_BYTES, MISC_OFF = LDSCTL_OFF + 320;
constexpr int LDS_BYTES = SCR_BYTES + 4096;
static_assert(MISC_OFF + 128 <= LDS_BYTES && LDS_BYTES <= 163840, "LDS map");

struct Frame {
    LAS unsigned char* lds;
    volatile LAS unsigned* MISC;
    gu32* ctl;
    int tid, lane, wave, vcu, G;
    const float* in[22]; float* out; unsigned char* ws;
};
__device__ __forceinline__ float wave_sum(float v) {
#pragma unroll
    for (int o = 1; o < 64; o <<= 1) v += __shfl_xor(v, o);
    return v;
}

__device__ __forceinline__ void p0_tr64(const float* W, int ldn, int k0, int n0, bf16* dst, int ldk, LAS float* scr, int lane) {
    const int lr = lane >> 4, lc = (lane & 15) * 4;
#pragma unroll 4
    for (int i = 0; i < 16; ++i) { const int kk = 4 * i + lr; const f32x4 v = *(const GAS f32x4*)(W + (size_t)(k0 + kk) * ldn + n0 + lc);
        LAS float* s = scr + kk * 65 + lc; s[0] = v[0]; s[1] = v[1]; s[2] = v[2]; s[3] = v[3]; }
    LDS_WAIT(); asm volatile("" ::: "memory");
    const int c = lane & 7;
#pragma unroll
    for (int j = 0; j < 8; ++j) { const int n = (lane >> 3) + 8 * j; const LAS float* s = scr + (8 * c) * 65 + n;
        v4u o; o.x = pk2(s[0 * 65], s[1 * 65]); o.y = pk2(s[2 * 65], s[3 * 65]); o.z = pk2(s[4 * 65], s[5 * 65]); o.w = pk2(s[6 * 65], s[7 * 65]);
        *(GAS v4u*)(dst + (size_t)n * ldk + 8 * c) = o; }
    LDS_WAIT(); asm volatile("" ::: "memory");
}
__device__ __forceinline__ int incol_row(int c) { const int w = c & 255; return (c & ~255) + ((w >> 5) & 1) * 128 + (w >> 6) * 32 + (w & 31); }

__device__ __forceinline__ void p0_prologue(Frame& F) {
    LAS float* scr = (LAS float*)(F.lds + F.wave * 16640);
    const int gw = F.vcu * NWAVES + F.wave, NGW = F.G * NWAVES, lane = F.lane;
    bf16* Wt_in = (bf16*)(F.ws + WS_WIN); bf16* Wt_mix = (bf16*)(F.ws + WS_WMIX); bf16* Wt_out = (bf16*)(F.ws + WS_WOUT); bf16* Wt_gu = (bf16*)(F.ws + WS_WGU); bf16* Wt_d = (bf16*)(F.ws + WS_WD);
    constexpr int I_IN = 16 * 72, I_OA = 8 * 16, I_OL = 8 * 16, I_OUT = 16 * 16, I_G = 32 * 16 * 8, I_U = I_G, I_D = 32 * 8 * 16;
    constexpr int NITEMS = I_IN + I_OA + I_OL + I_OUT + I_G + I_U + I_D;
    for (int it = gw; it < NITEMS; it += NGW) {
        int r = it;
        if (r < I_IN) { const int kb = r / 72, nb = r % 72, n0 = nb * 64; const int w = n0 & 255;
            const int lr = lane >> 4, lc = (lane & 15) * 4; const float* W = F.in[2];
#pragma unroll 4
            for (int i = 0; i < 16; ++i) { const int kk = 4 * i + lr; const f32x4 v = *(const GAS f32x4*)(W + (size_t)(kb * 64 + kk) * INC + n0 + lc);
                LAS float* s = scr + kk * 65 + lc; s[0] = v[0]; s[1] = v[1]; s[2] = v[2]; s[3] = v[3]; }
            LDS_WAIT(); asm volatile("" ::: "memory");
            const int c = lane & 7;
#pragma unroll
            for (int j = 0; j < 8; ++j) { const int n = (lane >> 3) + 8 * j; const LAS float* s = scr + (8 * c) * 65 + n;
                v4u o; o.x = pk2(s[0 * 65], s[1 * 65]); o.y = pk2(s[2 * 65], s[3 * 65]); o.z = pk2(s[4 * 65], s[5 * 65]); o.w = pk2(s[6 * 65], s[7 * 65]);
                *(GAS v4u*)(Wt_in + (size_t)incol_row(n0 + n) * 1024 + kb * 64 + 8 * c) = o; }
            LDS_WAIT(); asm volatile("" ::: "memory"); (void)w;
            continue; } r -= I_IN;
        if (r < I_OA) { const int kb = r / 16, nb = r % 16; p0_tr64(F.in[12], 1024, kb * 64, nb * 64, Wt_mix + (size_t)(nb * 64) * 1024 + kb * 64, 1024, scr, lane); continue; } r -= I_OA;
        if (r < I_OL) { const int kb = r / 16, nb = r % 16; p0_tr64(F.in[13], 1024, kb * 64, nb * 64, Wt_mix + (size_t)(nb * 64) * 1024 + 512 + kb * 64, 1024, scr, lane); continue; } r -= I_OL;
        if (r < I_OUT) { const int kb = r / 16, nb = r % 16; p0_tr64(F.in[14], 1024, kb * 64, nb * 64, Wt_out + (size_t)(nb * 64) * 1024 + kb * 64, 1024, scr, lane); continue; } r -= I_OUT;
        if (r < I_G) { const int e = r / 128, q = r % 128, kb = q / 8, nb = q % 8, n0 = nb * 64;
            p0_tr64(F.in[18] + (size_t)e * 1024 * 512, 512, kb * 64, n0, Wt_gu + (size_t)(e * 1024 + (n0 >> 7) * 256 + (n0 & 127)) * 1024 + kb * 64, 1024, scr, lane); continue; } r -= I_G;
        if (r < I_U) { const int e = r / 128, q = r % 128, kb = q / 8, nb = q % 8, n0 = nb * 64;
            p0_tr64(F.in[19] + (size_t)e * 1024 * 512, 512, kb * 64, n0, Wt_gu + (size_t)(e * 1024 + (n0 >> 7) * 256 + 128 + (n0 & 127)) * 1024 + kb * 64, 1024, scr, lane); continue; } r -= I_U;
        { const int e = r / 128, q = r % 128, kb = q / 16, nb = q % 16;
            p0_tr64(F.in[20] + (size_t)e * 512 * 1024, 1024, kb * 64, nb * 64, Wt_d + (size_t)(e * 1024 + nb * 64) * 512 + kb * 64, 512, scr, lane); }
    }
    { bf16* WER = (bf16*)(F.ws + WS_MISC + 1536 * 1024); const float* gf = F.in[15];
      for (int idx = gw * 64 + lane; idx < 36 * 1024; idx += NGW * 64) { const int row = idx >> 10, k = idx & 1023;
          const float w = (row < 32 ? F.in[17][(size_t)(row >> 3) * 8192 + k * 8 + (row & 7)] : F.in[16][k * 4 + (row - 32)]) * gf[k];
          const unsigned h = f2bf(w), l = f2bf(w - __builtin_bit_cast(float, h << 16));
          const int pos = row * 1024 + ((((k >> 3) ^ (row & 15))) << 3) + (k & 7);
          WER[pos] = (bf16)h; WER[36 * 1024 + pos] = (bf16)l; } }
    bf16* XN = (bf16*)(F.ws + WS_XN); const float* x = F.in[0]; const float* g = F.in[1];
    f32x4 gv[4];
#pragma unroll
    for (int j = 0; j < 4; ++j) gv[j] = ((const GAS f32x4*)g)[lane + 64 * j];
    for (int m = gw; m < NTOK; m += NGW) {
        const GAS f32x4* xr = (const GAS f32x4*)(x + (size_t)m * DM) + lane;
        f32x4 v[4]; float s = 0.f;
#pragma unroll
        for (int j = 0; j < 4; ++j) { v[j] = xr[64 * j]; s += (v[j].x * v[j].x + v[j].y * v[j].y) + (v[j].z * v[j].z + v[j].w * v[j].w); }
        const float rstd = rsqrtf(wave_sum(s) * (1.f / DM) + EPS);
        GAS unsigned long long* o8 = (GAS unsigned long long*)(XN + (size_t)m * DM) + lane;
#pragma unroll
        for (int j = 0; j < 4; ++j) o8[64 * j] = (unsigned long long)pk2(v[j].x * rstd * gv[j].x, v[j].y * rstd * gv[j].y) | ((unsigned long long)pk2(v[j].z * rstd * gv[j].z, v[j].w * rstd * gv[j].w) << 32);
    }
}

namespace att {
typedef float f32x16 __attribute__((ext_vector_type(16)));
typedef short s16x4 __attribute__((ext_vector_type(4)));
typedef short v4i16_t __attribute__((ext_vector_type(4)));
constexpr int KROW = 128;
constexpr int KT = 64 * KROW;
constexpr int STAGE = 2 * KT + 16384;
constexpr int VOFF = 2 * KT;
constexpr int CW_AQ = 192;
constexpr float WIN_T = 40.f;
__device__ __forceinline__ s16x4 vtr(const LAS unsigned char* p) { return __builtin_bit_cast(s16x4, __builtin_amdgcn_ds_read_tr16_b64_v4i16((LAS v4i16_t*)p)); }

struct RowState { float mrun, lrun; };
template <int ABL> __device__ __forceinline__ void soft_tile(const LAS unsigned char* lds, int ko, const bf16x8 (&qr)[4], int t, int qpos, int qmin, int hi, float slope2, RowState& st, f32x16 (&o)[4], bf16x8 (&pa)[4]) {
    f32x16 p0, p1;
#pragma unroll
    for (int r = 0; r < 16; ++r) { p0[r] = 0.f; p1[r] = 0.f; }
#pragma unroll
    for (int d0 = 0; d0 < 4; ++d0) {
        const LAS unsigned char* kq = lds + (ko ^ (d0 * 32));
        const bf16x8 k0 = *(const LAS bf16x8*)(kq);
        const bf16x8 k1 = *(const LAS bf16x8*)(kq + 32 * KROW);
        if (ABL & 4) { if (d0 == 0) { p0[0] = (float)k0[0]; p1[0] = (float)k1[0]; } continue; }
        p0 = __builtin_amdgcn_mfma_f32_32x32x16_bf16(k0, qr[d0], p0, 0, 0, 0);
        p1 = __builtin_amdgcn_mfma_f32_32x32x16_bf16(k1, qr[d0], p1, 0, 0, 0);
    }
    if (ABL & 1) {
#pragma unroll
        for (int s = 0; s < 4; ++s) { v4u w;
#pragma unroll
            for (int e = 0; e < 4; ++e) { const int r = 8 * (s & 1) + 2 * e; w[e] = (s < 2) ? pg8::cvt_pk_bf16(p0[r], p0[r + 1]) : pg8::cvt_pk_bf16(p1[r], p1[r + 1]); }
            pa[s] = __builtin_bit_cast(bf16x8, w); }
        st.lrun += 1.f; return; }
    const float bb = slope2 * (float)(64 * t + 4 * hi - qpos);
    float rm = -1e30f;
    if (64 * t + 63 > qmin) {
#pragma unroll
        for (int r = 0; r < 16; ++r) { const int kk = (r & 3) + 8 * (r >> 2), key = 64 * t + 4 * hi + kk;
            float x0 = p0[r] + (bb + slope2 * (float)kk), x1 = p1[r] + (bb + slope2 * (float)(kk + 32));
            if (key > qpos) x0 = -1e30f; if (key + 32 > qpos) x1 = -1e30f;
            p0[r] = x0; p1[r] = x1; rm = fmaxf(rm, fmaxf(x0, x1)); }
    } else {
#pragma unroll
        for (int r = 0; r < 16; ++r) { const int kk = (r & 3) + 8 * (r >> 2);
            const float x0 = p0[r] + (bb + slope2 * (float)kk), x1 = p1[r] + (bb + slope2 * (float)(kk + 32));
            p0[r] = x0; p1[r] = x1; rm = fmaxf(rm, fmaxf(x0, x1)); }
    }
    rm = fmaxf(rm, __shfl_xor(rm, 32));
    const float mnew = fmaxf(st.mrun, rm);
    if (__any(mnew > st.mrun)) {
        const float alpha = __builtin_amdgcn_exp2f(st.mrun - mnew);
        st.lrun *= alpha;
#pragma unroll
        for (int vb = 0; vb < 4; ++vb)
#pragma unroll
            for (int r = 0; r < 16; ++r) o[vb][r] *= alpha;
        st.mrun = mnew;
    }
    const float mref = st.mrun;
    float ls = 0.f;
#pragma unroll
    for (int r = 0; r < 16; ++r) { p0[r] = __builtin_amdgcn_exp2f(p0[r] - mref); p1[r] = __builtin_amdgcn_exp2f(p1[r] - mref); ls += p0[r] + p1[r]; }
    st.lrun += ls;
#pragma unroll
    for (int s = 0; s < 4; ++s) { v4u w;
#pragma unroll
        for (int e = 0; e < 4; ++e) { const int r = 8 * (s & 1) + 2 * e; w[e] = (s < 2) ? pg8::cvt_pk_bf16(p0[r], p0[r + 1]) : pg8::cvt_pk_bf16(p1[r], p1[r + 1]); }
        pa[s] = __builtin_bit_cast(bf16x8, w); }
}
template <int ABL> __device__ __forceinline__ void pv_tile(const LAS unsigned char* vp, const bf16x8 (&pa)[4], f32x16 (&o)[4]) {
    if (ABL & 2) { o[0][0] += (float)pa[0][0]; return; }
#pragma unroll
    for (int vb = 0; vb < 4; ++vb)
#pragma unroll
        for (int s = 0; s < 4; ++s) {
            const s16x4 lo = vtr(vp + vb * 4096 + s * 1024), hh = vtr(vp + vb * 4096 + s * 1024 + 512);
            const bf16x8 vf = (bf16x8){lo[0], lo[1], lo[2], lo[3], hh[0], hh[1], hh[2], hh[3]};
            o[vb] = __builtin_amdgcn_mfma_f32_32x32x16_bf16(vf, pa[s], o[vb], 0, 0, 0);
        }
}

template <int ABL> __device__ __forceinline__ void attn_unit(Frame& F, int b, int h, int qblk, float lam, bf16* AL, int ldo) {
    int lane_ = F.lane; asm volatile("" : "+v"(lane_));
    const int lane = lane_, wid = F.wave, r32 = lane & 31, hi = lane >> 5;
    const int m = wid >> 2, j4 = wid & 3;
    const bf16* Qb = (const bf16*)(F.ws + WS_Q); const bf16* Kb = (const bf16*)(F.ws + WS_K); const bf16* Vb = (const bf16*)(F.ws + WS_V);
    LAS unsigned char* lds = F.lds;
    const size_t rowbase = (size_t)b * SEQ;
    const int qpos = qblk * 128 + j4 * 32 + r32;
    const int qmin = qblk * 128 + j4 * 32;
    const float slope2 = __builtin_amdgcn_exp2f(-2.f * (float)(h + 1)) * LOG2E;
    int tlo_w, t_lo;
    { const float q0 = __uint_as_float(__hip_atomic_load(F.ctl + CW_QKMAX + b * 16 + h * 2, RLX_AGENT)), k0 = __uint_as_float(__hip_atomic_load(F.ctl + CW_QKMAX + b * 16 + 8 + h * 2, RLX_AGENT));
      const float q1 = __uint_as_float(__hip_atomic_load(F.ctl + CW_QKMAX + b * 16 + h * 2 + 1, RLX_AGENT)), k1 = __uint_as_float(__hip_atomic_load(F.ctl + CW_QKMAX + b * 16 + 8 + h * 2 + 1, RLX_AGENT));
      const float d0 = (2.f * sqrtf(q0 * k0) + WIN_T) / slope2, d1 = (2.f * sqrtf(q1 * k1) + WIN_T) / slope2;
      const int w0 = (int)fminf(d0, 16384.f), w1 = (int)fminf(d1, 16384.f);
      const int s0 = qblk * 128 - w0 - 1, s1 = qblk * 128 - w1 - 1;
      const int tl0 = s0 > 0 ? s0 >> 6 : 0, tl1 = s1 > 0 ? s1 >> 6 : 0;
      t_lo = __builtin_amdgcn_readfirstlane(tl0 < tl1 ? tl0 : tl1);
      const int sw = qmin - (m ? w1 : w0) - 1; const int tw = sw > 0 ? sw >> 6 : 0;
      tlo_w = __builtin_amdgcn_readfirstlane(tw); }
    bf16x8 qr[4];
#pragma unroll
    for (int d0 = 0; d0 < 4; ++d0) qr[d0] = *(const GAS bf16x8*)(Qb + (rowbase + qpos) * 512 + h * 128 + m * 64 + d0 * 16 + hi * 8);
    const bf16* ksrc; const bf16* vsrc0; const bf16* vsrc1;
    { const int row = 8 * wid + (lane >> 3), c = (lane & 7) ^ ((row >> 1) & 7);
      ksrc = Kb + (rowbase + row) * 512 + h * 128 + c * 8;
      const int q0 = 2 * wid, q1 = 2 * wid + 1;
      vsrc0 = Vb + (rowbase + 16 * (q0 & 3) + (lane >> 2)) * 512 + h * 128 + (q0 >> 2) * 32 + (lane & 3) * 8;
      vsrc1 = Vb + (rowbase + 16 * (q1 & 3) + (lane >> 2)) * 512 + h * 128 + (q1 >> 2) * 32 + (lane & 3) * 8; }
    const int kdst = wid * 1024, vdst0 = VOFF + ((2 * wid) >> 2) * 4096 + ((2 * wid) & 3) * 1024, vdst1 = VOFF + ((2 * wid + 1) >> 2) * 4096 + ((2 * wid + 1) & 3) * 1024;
#define ATT_DMA(t, sb) do { const size_t to_ = (size_t)(t) * 64 * 512; LAS unsigned char* s_ = lds + (sb); \
        __builtin_amdgcn_global_load_lds((const GAS unsigned*)(ksrc + to_), (LAS unsigned*)(s_ + kdst), 16, 0, 0); \
        __builtin_amdgcn_global_load_lds((const GAS unsigned*)(ksrc + to_ + 64), (LAS unsigned*)(s_ + KT + kdst), 16, 0, 0); \
        __builtin_amdgcn_global_load_lds((const GAS unsigned*)(vsrc0 + to_), (LAS unsigned*)(s_ + vdst0), 16, 0, 0); \
        __builtin_amdgcn_global_load_lds((const GAS unsigned*)(vsrc1 + to_), (LAS unsigned*)(s_ + vdst1), 16, 0, 0); } while (0)
#define BAR_L() asm volatile("s_waitcnt lgkmcnt(0)\n\ts_barrier" ::: "memory")
#define BAR_VL() asm volatile("s_waitcnt vmcnt(0) lgkmcnt(0)\n\ts_barrier" ::: "memory")
    const int kfoff = m * KT + r32 * KROW + ((hi ^ ((r32 >> 1) & 7)) * 16);
    const int vfoff = VOFF + ((lane >> 4) & 1) * 32 + (lane & 3) * 8 + (4 * hi + ((lane & 15) >> 2)) * 64;
    f32x16 o[4];
#pragma unroll
    for (int vb = 0; vb < 4; ++vb)
#pragma unroll
        for (int r = 0; r < 16; ++r) o[vb][r] = 0.f;
    RowState st{-1e30f, 0.f};
    bf16x8 pa[4];
    const int t_hi = 2 * qblk + 1;
#define ATT_ACTIVE(t) (64 * (t) <= qmin + 31 && (t) >= tlo_w)
    ATT_DMA(t_hi, 0);
    if (t_hi - 1 >= t_lo) ATT_DMA(t_hi - 1, STAGE);
    BAR_VL();
    if (m == 1) BAR_L();
    int it = 0;
    for (int t = t_hi; t >= t_lo; --t, ++it) {
        const int cur = (it & 3) * STAGE;
        int ko_ = kfoff + cur, vc_ = vfoff + cur; asm volatile("" : "+v"(ko_), "+v"(vc_));
        if (!(ABL & 8)) if (t - 2 >= t_lo) ATT_DMA(t - 2, ((it + 2) & 3) * STAGE);
        const bool act = ATT_ACTIVE(t);
        if (act) soft_tile<ABL>(lds, ko_, qr, t, qpos, qmin, hi, slope2, st, o, pa);
        BAR_L();
        if (act) pv_tile<ABL>(lds + vc_, pa, o);
        BAR_VL();
    }
    if (m == 0) BAR_L();
    BAR_L();
#undef ATT_DMA
#undef ATT_ACTIVE
    st.lrun += __shfl_xor(st.lrun, 32);
    const float inv = 1.f / st.lrun;
    LAS float* xch = (LAS float*)lds;
    if (m == 1) {
#pragma unroll
        for (int vb = 0; vb < 4; ++vb)
#pragma unroll
            for (int r = 0; r < 16; ++r) xch[(j4 * 64 + vb * 16 + r) * 64 + lane] = o[vb][r] * inv;
    }
    __syncthreads();
    if (m == 0) {
        float ss = 0.f;
#pragma unroll
        for (int vb = 0; vb < 4; ++vb)
#pragma unroll
            for (int r = 0; r < 16; ++r) { const float v = o[vb][r] * inv - lam * xch[(j4 * 64 + vb * 16 + r) * 64 + lane]; o[vb][r] = v; ss += v * v;
                if (r == 15) asm volatile("" ::: "memory"); }
        ss += __shfl_xor(ss, 32);
        const float rstd = rsqrtf(ss * (1.f / 128.f) + EPS) * 0.8f;
        const float* sg = F.in[4];
        bf16* orow = AL + (rowbase + qpos) * ldo + h * 128;
#pragma unroll
        for (int vb = 0; vb < 4; ++vb)
#pragma unroll
            for (int g = 0; g < 4; ++g) { const int vd = vb * 32 + 8 * g + 4 * hi; const f32x4 gg = *(const GAS f32x4*)(sg + vd);
                const unsigned w0 = pk2(o[vb][4 * g] * rstd * gg[0], o[vb][4 * g + 1] * rstd * gg[1]), w1 = pk2(o[vb][4 * g + 2] * rstd * gg[2], o[vb][4 * g + 3] * rstd * gg[3]);
                *(GAS unsigned long long*)(orow + vd) = (unsigned long long)w0 | ((unsigned long long)w1 << 32);
                asm volatile("" ::: "memory"); }
    }
    __syncthreads();
}

}

namespace att2 {
using att::f32x16; using att::s16x4; using att::vtr;
constexpr int KSLOT = 32768, VBASE = 65536, VSLOT = 32768, TILEK = 16384, TILEV = 16384, KMAP = 8192;
constexpr int CW_AQ2 = 200;

template <int ABL> __device__ __forceinline__ void pv16(const LAS unsigned char* vp, const bf16x8 (&pa)[4], f32x16 (&o)[4]) {
    if (ABL & 2) { o[0][0] += (float)pa[0][0]; return; }
#pragma unroll
    for (int vb = 0; vb < 4; ++vb)
#pragma unroll
        for (int s = 0; s < 4; ++s) {
            const s16x4 lo = vtr(vp + vb * 4096 + s * 1024), hh = vtr(vp + vb * 4096 + s * 1024 + 512);
            const bf16x8 vf = (bf16x8){lo[0], lo[1], lo[2], lo[3], hh[0], hh[1], hh[2], hh[3]};
            o[vb] = __builtin_amdgcn_mfma_f32_32x32x16_bf16(vf, pa[s], o[vb], 0, 0, 0);
        }
}
template <int ABL> __device__ __forceinline__ void qk8(const LAS unsigned char* lds, int ko, const bf16x8 (&qr)[4], const f32x16& c0, const f32x16& c1, f32x16& p0, f32x16& p1) {
#pragma unroll
    for (int d0 = 0; d0 < 4; ++d0) {
        const LAS unsigned char* kq = lds + (ko ^ (d0 * 32));
        const bf16x8 k0 = *(const LAS bf16x8*)(kq), k1 = *(const LAS bf16x8*)(kq + 32 * 128);
        if (ABL & 4) { if (d0 == 0) { p0 = c0; p1 = c1; p0[0] += (float)k0[0]; p1[0] += (float)k1[0]; } continue; }
        p0 = __builtin_amdgcn_mfma_f32_32x32x16_bf16(k0, qr[d0], d0 == 0 ? c0 : p0, 0, 0, 0);
        p1 = __builtin_amdgcn_mfma_f32_32x32x16_bf16(k1, qr[d0], d0 == 0 ? c1 : p1, 0, 0, 0);
    }
}
__device__ __forceinline__ void pack4(const f32x16& p0, const f32x16& p1, bf16x8 (&pa)[4]) {
#pragma unroll
    for (int s = 0; s < 4; ++s) { v4u w;
#pragma unroll
        for (int e = 0; e < 4; ++e) { const int r = 8 * (s & 1) + 2 * e; w[e] = (s < 2) ? pg8::cvt_pk_bf16(p0[r], p0[r + 1]) : pg8::cvt_pk_bf16(p1[r], p1[r + 1]); }
        pa[s] = __builtin_bit_cast(bf16x8, w); }
}

template <int ABL> __device__ __forceinline__ void attn_unit(Frame& F, int b, int h, int qb, float lam, int w0, int w1, bf16* AL, int ldo) {
    int lane_ = F.lane; asm volatile("" : "+v"(lane_));
    const int lane = lane_, wid = F.wave, r32 = lane & 31, hi = lane >> 5;
    const int m = wid >> 2, ks = (wid >> 1) & 1, rb = wid & 1;
    const bf16* Qb = (const bf16*)(F.ws + WS_Q); const bf16* Kb = (const bf16*)(F.ws + WS_K); const bf16* Vb = (const bf16*)(F.ws + WS_V);
    LAS unsigned char* lds = F.lds;
    const size_t rowbase = (size_t)b * SEQ;
    const int qmin = qb * 64 + rb * 32, qpos = qmin + r32;
    const float slope2 = __builtin_amdgcn_exp2f(-2.f * (float)(h + 1)) * LOG2E;
    const int t_hi = qb;
    int t_lo, nact;
    { const int wmax = w0 > w1 ? w0 : w1, s_u = qb * 64 - wmax - 1; t_lo = s_u > 0 ? s_u >> 6 : 0;
      const int s_w = qmin - (m ? w1 : w0) - 1; const int tlw = s_w > 0 ? s_w >> 6 : 0;
      const int tf = t_hi - ks;
      nact = tf >= tlw ? ((tf - tlw) >> 1) + 1 : 0; }
    const int ntrips = (t_hi - t_lo + 2) >> 1;
    bf16x8 qr[4];
#pragma unroll
    for (int d0 = 0; d0 < 4; ++d0) qr[d0] = *(const GAS bf16x8*)(Qb + (rowbase + qpos) * 512 + h * 128 + m * 64 + d0 * 16 + hi * 8);
    const bf16* ksrc; const bf16* vsrc0; const bf16* vsrc1;
    { const int row = 8 * wid + (lane >> 3), c = (lane & 7) ^ ((row >> 1) & 7);
      ksrc = Kb + (rowbase + row) * 512 + h * 128 + c * 8;
      const int q0 = 2 * wid, q1 = 2 * wid + 1;
      vsrc0 = Vb + (rowbase + 16 * (q0 & 3) + (lane >> 2)) * 512 + h * 128 + (q0 >> 2) * 32 + (lane & 3) * 8;
      vsrc1 = Vb + (rowbase + 16 * (q1 & 3) + (lane >> 2)) * 512 + h * 128 + (q1 >> 2) * 32 + (lane & 3) * 8; }
    const int kdst = wid * 1024, vdst0 = ((2 * wid) >> 2) * 4096 + ((2 * wid) & 3) * 1024, vdst1 = ((2 * wid + 1) >> 2) * 4096 + ((2 * wid + 1) & 3) * 1024;
#define A2_GL(src, dst) do { if (!(ABL & 8)) __builtin_amdgcn_global_load_lds((const GAS unsigned*)(src), (LAS unsigned*)(dst), 16, 0, 0); } while (0)
#define A2_DMA_K(j) do { const int tA_ = t_hi - 2 * (j), tB_ = tA_ - 1; LAS unsigned char* s_ = lds + ((j) & 1) * KSLOT + kdst; \
        if (tA_ >= t_lo) { const bf16* g_ = ksrc + (size_t)tA_ * 64 * 512; A2_GL(g_, s_); A2_GL(g_ + 64, s_ + KMAP); } \
        if (tB_ >= t_lo) { const bf16* g_ = ksrc + (size_t)tB_ * 64 * 512; A2_GL(g_, s_ + TILEK); A2_GL(g_ + 64, s_ + TILEK + KMAP); } } while (0)
#define A2_DMA_V(j) do { const int tA_ = t_hi - 2 * (j), tB_ = tA_ - 1; LAS unsigned char* s_ = lds + VBASE + ((j) & 1) * VSLOT; \
        if (tA_ >= t_lo) { const size_t o_ = (size_t)tA_ * 64 * 512; A2_GL(vsrc0 + o_, s_ + vdst0); A2_GL(vsrc1 + o_, s_ + vdst1); } \
        if (tB_ >= t_lo) { const size_t o_ = (size_t)tB_ * 64 * 512; A2_GL(vsrc0 + o_, s_ + TILEV + vdst0); A2_GL(vsrc1 + o_, s_ + TILEV + vdst1); } } while (0)
#define A2_BAR() asm volatile("s_waitcnt vmcnt(0) lgkmcnt(0)\n\ts_barrier" ::: "memory")
    const int kfoff = ks * TILEK + m * KMAP + r32 * 128 + ((hi ^ ((r32 >> 1) & 7)) * 16);
    const int vfoff = VBASE + ks * TILEV + ((lane >> 4) & 1) * 32 + (lane & 3) * 8 + (4 * hi + ((lane & 15) >> 2)) * 64;
    f32x16 o[4];
#pragma unroll
    for (int vb = 0; vb < 4; ++vb)
#pragma unroll
        for (int r = 0; r < 16; ++r) o[vb][r] = 0.f;
    float R = -1e30f, lsum = 0.f;
    bf16x8 pa[4];
    f32x16 cin0;
    const float d32 = 32.f * slope2;
    const float dstep = 128.f * slope2;
    A2_DMA_K(0);
    A2_BAR();
    if (ntrips > 1) A2_DMA_K(1);
    A2_DMA_V(0);
    if (nact > 0) {
        const int t = t_hi - ks;
        const float base = slope2 * (float)(64 * t + 4 * hi - qpos);
#pragma unroll
        for (int r = 0; r < 16; ++r) { const float cb = slope2 * (float)((r & 3) + 8 * (r >> 2)); cin0[r] = cb + base; }
        f32x16 p0, p1;
        { f32x16 c1;
#pragma unroll
          for (int r = 0; r < 16; ++r) c1[r] = cin0[r] + d32;
          qk8<ABL>(lds, kfoff, qr, cin0, c1, p0, p1); }
        float rm = -1e30f;
        if (ks == 0) {
#pragma unroll
            for (int r = 0; r < 16; ++r) { const int key = 64 * t + 4 * hi + (r & 3) + 8 * (r >> 2);
                if (key > qpos) p0[r] = -1e30f; if (key + 32 > qpos) p1[r] = -1e30f; }
        }
#pragma unroll
        for (int r = 0; r < 16; ++r) rm = fmaxf(rm, fmaxf(p0[r], p1[r]));
        rm = fmaxf(rm, __shfl_xor(rm, 32));
        R = rm;
#pragma unroll
        for (int r = 0; r < 16; ++r) { p0[r] = __builtin_amdgcn_exp2f(p0[r] - R); p1[r] = __builtin_amdgcn_exp2f(p1[r] - R); lsum += p0[r] + p1[r]; }
        pack4(p0, p1, pa);
        const float adj = -R - dstep;
#pragma unroll
        for (int r = 0; r < 16; ++r) cin0[r] += adj;
    }
    A2_BAR();
    for (int i = 1; i < ntrips; ++i) {
        int ko_ = (i & 1) * KSLOT + kfoff, vq_ = ((i - 1) & 1) * VSLOT + vfoff; asm volatile("" : "+v"(ko_), "+v"(vq_));
        if (i + 1 < ntrips) A2_DMA_K(i + 1);
        A2_DMA_V(i);
        if (i < nact) {
            f32x16 p0, p1;
            { f32x16 c1;
#pragma unroll
              for (int r = 0; r < 16; ++r) c1[r] = cin0[r] + d32;
              qk8<ABL>(lds, ko_, qr, cin0, c1, p0, p1); }
            pv16<ABL>(lds + vq_, pa, o);
            float ls = 0.f;
#pragma unroll
            for (int r = 0; r < 16; ++r) { p0[r] = __builtin_amdgcn_exp2f(p0[r]); p1[r] = __builtin_amdgcn_exp2f(p1[r]); ls += p0[r] + p1[r]; cin0[r] -= dstep; }
            lsum += ls;
            pack4(p0, p1, pa);
        } else if (i == nact) pv16<ABL>(lds + vq_, pa, o);
        A2_BAR();
    }
    if (nact == ntrips) pv16<ABL>(lds + ((ntrips - 1) & 1) * VSLOT + vfoff, pa, o);
    A2_BAR();
#undef A2_GL
#undef A2_DMA_K
#undef A2_DMA_V
    lsum += __shfl_xor(lsum, 32);
    LAS float* x1 = (LAS float*)lds;
    LAS float* x2 = (LAS float*)(lds + 4 * 66 * 64 * 4);
    const int pr = m * 2 + rb;
    if (ks == 1) {
#pragma unroll
        for (int vb = 0; vb < 4; ++vb)
#pragma unroll
            for (int r = 0; r < 16; ++r) x1[(pr * 66 + vb * 16 + r) * 64 + lane] = o[vb][r];
        x1[(pr * 66 + 64) * 64 + lane] = lsum; x1[(pr * 66 + 65) * 64 + lane] = R;
    }
    __syncthreads();
    float inv = 0.f;
    if (ks == 0) {
        const float l1 = x1[(pr * 66 + 64) * 64 + lane], R1 = x1[(pr * 66 + 65) * 64 + lane];
        const float Rm = fmaxf(R, R1), f0 = __builtin_amdgcn_exp2f(R - Rm), f1 = __builtin_amdgcn_exp2f(R1 - Rm);
        inv = 1.f / (lsum * f0 + l1 * f1);
        const float g0 = f0 * inv, g1 = f1 * inv;
#pragma unroll
        for (int vb = 0; vb < 4; ++vb) {
#pragma unroll
            for (int r = 0; r < 16; ++r) { o[vb][r] = o[vb][r] * g0 + x1[(pr * 66 + vb * 16 + r) * 64 + lane] * g1; if (r == 15) asm volatile("" ::: "memory"); } }
        if (m == 1) {
#pragma unroll
            for (int vb = 0; vb < 4; ++vb)
#pragma unroll
                for (int r = 0; r < 16; ++r) x2[(rb * 64 + vb * 16 + r) * 64 + lane] = o[vb][r];
        }
    }
    __syncthreads();
    if (ks == 0 && m == 0) {
        float ss = 0.f;
#pragma unroll
        for (int vb = 0; vb < 4; ++vb) {
#pragma unroll
            for (int r = 0; r < 16; ++r) { const float v = o[vb][r] - lam * x2[(rb * 64 + vb * 16 + r) * 64 + lane]; o[vb][r] = v; ss += v * v; if (r == 15) asm volatile("" ::: "memory"); } }
        ss += __shfl_xor(ss, 32);
        const float rstd = rsqrtf(ss * (1.f / 128.f) + EPS) * 0.8f;
        const float* sg = F.in[4];
        bf16* orow = AL + (rowbase + qpos) * ldo + h * 128;
#pragma unroll
        for (int vb = 0; vb < 4; ++vb)
#pragma unroll
            for (int g = 0; g < 4; ++g) { const int vd = vb * 32 + 8 * g + 4 * hi; const f32x4 gg = *(const GAS f32x4*)(sg + vd);
                const unsigned u0 = pk2(o[vb][4 * g] * rstd * gg[0], o[vb][4 * g + 1] * rstd * gg[1]), u1 = pk2(o[vb][4 * g + 2] * rstd * gg[2], o[vb][4 * g + 3] * rstd * gg[3]);
                *(GAS unsigned long long*)(orow + vd) = (unsigned long long)u0 | ((unsigned long long)u1 << 32);
                asm volatile("" ::: "memory"); }
    }
    __syncthreads();
#undef A2_BAR
}

template <int ABL> __device__ __forceinline__ void attn_phase(Frame& F, bf16* AL, int ldo, int qw) {
    const float* lp = F.in[3];
    float a = lp[F.lane] * lp[64 + F.lane], c = lp[128 + F.lane] * lp[192 + F.lane];
    a = wave_sum(a); c = wave_sum(c);
    const float lam = __expf(a) - __expf(c) + 0.2f;
    volatile LAS unsigned* slot = F.MISC + 12;
    if (F.tid == 0) slot[0] = __hip_atomic_fetch_add(F.ctl + qw, 1u, RLX_AGENT);
    __syncthreads();
    for (;;) {
        const unsigned u = slot[0];
        if (u >= 1024u) break;
        unsigned nxt = 0;
        if (F.tid == 0) nxt = __hip_atomic_fetch_add(F.ctl + qw, 1u, RLX_AGENT);
        const int h = 3 - (int)(u >> 8), r = (int)(u & 255u), b = r & 1, qb = 127 - (r >> 1);
        const float q0 = __uint_as_float(__hip_atomic_load(F.ctl + CW_QKMAX + b * 16 + h * 2, RLX_AGENT)), k0 = __uint_as_float(__hip_atomic_load(F.ctl + CW_QKMAX + b * 16 + 8 + h * 2, RLX_AGENT));
        const float q1 = __uint_as_float(__hip_atomic_load(F.ctl + CW_QKMAX + b * 16 + h * 2 + 1, RLX_AGENT)), k1 = __uint_as_float(__hip_atomic_load(F.ctl + CW_QKMAX + b * 16 + 8 + h * 2 + 1, RLX_AGENT));
        const float B0 = sqrtf(q0 * k0), B1 = sqrtf(q1 * k1), slope2 = __builtin_amdgcn_exp2f(-2.f * (float)(h + 1)) * LOG2E;
        const int w0 = __builtin_amdgcn_readfirstlane((int)fminf((2.f * B0 + att::WIN_T) / slope2, 16384.f)), w1 = __builtin_amdgcn_readfirstlane((int)fminf((2.f * B1 + att::WIN_T) / slope2, 16384.f));
        const bool fixed_ok = __builtin_amdgcn_readfirstlane((int)(2.f * fmaxf(B0, B1) <= 100.f)) != 0;
        if (fixed_ok) attn_unit<ABL>(F, b, h, qb, lam, w0, w1, AL, ldo);
        else if ((qb & 1) == 0) att::attn_unit<ABL>(F, b, h, qb >> 1, lam, AL, ldo);
        if (F.tid == 0) slot[0] = nxt;
        __syncthreads();
    }
}
}

namespace lru {
typedef float f32x16 __attribute__((ext_vector_type(16)));
constexpr int ROWB = 144;
constexpr int L_WT = 0, L_XC = 128 * ROWB, L_GY = 2 * 128 * ROWB, L_PRE = L_GY + 128 * 128, L_AGG = L_PRE + 128 * 128 * 4;
constexpr int L_OUT = L_PRE;
constexpr size_t AGG_OFF = WS_MISC;
static_assert(L_AGG + 4096 <= SCR_BYTES, "LRU LDS map");

__device__ __forceinline__ float sigm(float x) { return __builtin_amdgcn_rcpf(1.f + __builtin_amdgcn_exp2f(-LOG2E * x)); }

__device__ __forceinline__ void l1_phase(Frame& F) {
    const int tid = F.tid, lane = F.lane, wid = F.wave, r32 = lane & 31, hi = lane >> 5;
    LAS unsigned char* lds = F.lds;
    const bf16* XR = (const bf16*)(F.ws + WS_XR); const bf16* GY = (const bf16*)(F.ws + WS_GY);
    bf16* PG = (bf16*)(F.ws + WS_PG); bf16* QG = (bf16*)(F.ws + WS_QG); float* AGG = (float*)(F.ws + AGG_OFF);
    const int n = F.vcu & 7;
    { const float* wr = F.in[7] + (size_t)n * 4096; const float* wi = F.in[9] + (size_t)n * 4096;
#pragma unroll 4
      for (int i = 0; i < 8; ++i) { const int e = tid + 512 * i, c = e >> 6, d = e & 63;
          *(LAS bf16*)(lds + L_WT + d * ROWB + c * 2) = (bf16)f2bf(wr[e]); *(LAS bf16*)(lds + L_WT + (64 + d) * ROWB + c * 2) = (bf16)f2bf(wi[e]); } }
    const int c = tid & 63, ts = wid, ch = n * 64 + c;
    const float br = F.in[8][ch], bi = F.in[10][ch], sp8 = -8.f * LOG2E * log1pf(__expf(-F.in[11][ch]));
    const int nper = (1024 + F.G - 1) / F.G;
    for (int j = 0; j < nper; ++j) {
        const int q = (F.vcu >> 3) * nper + j;
        if (q >= 128 || F.G * 8 < 8) break;
        const int b = q & 1, k = q >> 1;
        const size_t rowbase = (size_t)b * SEQ; const int p0 = k * 128;
        { const int t = tid >> 2, cg = tid & 3, ch0 = n * 64 + cg * 16;
          float acc[16];
          const float* cb = F.in[6] + ch0;
#pragma unroll
          for (int i = 0; i < 16; ++i) acc[i] = cb[i];
#pragma unroll
          for (int jj = 0; jj < 4; ++jj) { const int p = p0 + t - 3 + jj;
              const float* cw = F.in[5] + jj * 512 + ch0;
              if (p >= 0) { const v4u x0 = *(const GAS v4u*)(XR + (rowbase + p) * 512 + ch0), x1 = *(const GAS v4u*)(XR + (rowbase + p) * 512 + ch0 + 8);
#pragma unroll
                  for (int i = 0; i < 4; ++i) { acc[2 * i] += cw[2 * i] * __builtin_bit_cast(float, x0[i] << 16); acc[2 * i + 1] += cw[2 * i + 1] * __builtin_bit_cast(float, x0[i] & 0xffff0000u);
                                                acc[8 + 2 * i] += cw[8 + 2 * i] * __builtin_bit_cast(float, x1[i] << 16); acc[8 + 2 * i + 1] += cw[8 + 2 * i + 1] * __builtin_bit_cast(float, x1[i] & 0xffff0000u); } } }
          v4u o0, o1;
#pragma unroll
          for (int i = 0; i < 4; ++i) { o0[i] = pk2(acc[2 * i], acc[2 * i + 1]); o1[i] = pk2(acc[8 + 2 * i], acc[8 + 2 * i + 1]); }
          *(LAS v4u*)(lds + L_XC + t * ROWB + cg * 32) = o0; *(LAS v4u*)(lds + L_XC + t * ROWB + cg * 32 + 16) = o1;
#pragma unroll
          for (int i = 0; i < 2; ++i) { const int e = tid + 512 * i, row = e >> 3, cc = e & 7;
              *(LAS v4u*)(lds + L_GY + row * 128 + cc * 16) = *(const GAS v4u*)(GY + (rowbase + p0 + row) * 512 + n * 64 + cc * 8); } }
        __syncthreads();
        { const int tb = wid & 3, dh = wid >> 2;
          f32x16 d0, d1;
#pragma unroll
          for (int r = 0; r < 16; ++r) { d0[r] = 0.f; d1[r] = 0.f; }
#pragma unroll
          for (int s = 0; s < 4; ++s) {
              const bf16x8 a = *(const LAS bf16x8*)(lds + L_XC + (tb * 32 + r32) * ROWB + s * 32 + hi * 16);
              const bf16x8 w0 = *(const LAS bf16x8*)(lds + L_WT + (dh * 64 + r32) * ROWB + s * 32 + hi * 16);
              const bf16x8 w1 = *(const LAS bf16x8*)(lds + L_WT + (dh * 64 + 32 + r32) * ROWB + s * 32 + hi * 16);
              d0 = __builtin_amdgcn_mfma_f32_32x32x16_bf16(a, w0, d0, 0, 0, 0);
              d1 = __builtin_amdgcn_mfma_f32_32x32x16_bf16(a, w1, d1, 0, 0, 0); }
          LAS float* pre = (LAS float*)(lds + L_PRE);
#pragma unroll
          for (int r = 0; r < 16; ++r) { const int tok = tb * 32 + (r & 3) + 8 * (r >> 2) + 4 * hi;
              pre[tok * 128 + dh * 64 + r32] = d0[r]; pre[tok * 128 + dh * 64 + 32 + r32] = d1[r]; } }
        __syncthreads();
        float hv[16], cv[16];
        { const LAS float* pre = (const LAS float*)(lds + L_PRE);
          float h = 0.f, cum = 1.f;
#pragma unroll
          for (int i = 0; i < 16; ++i) { const int tt = ts * 16 + i;
              const float r = sigm(pre[tt * 128 + c] + br), ig = sigm(pre[tt * 128 + 64 + c] + bi);
              const float l2a = sp8 * r, a = __builtin_amdgcn_exp2f(l2a);
              const float x2 = 1.3862943611f * l2a;
              const float om = x2 > -0.05f ? -x2 * (1.f + x2 * (0.5f + x2 * (0.16666667f + x2 * 0.041666667f))) : 1.f - a * a;
              const float mult = (p0 + tt == 0) ? 1.f : __builtin_amdgcn_sqrtf(om);
              const float xc = bf2f(*(const LAS bf16*)(lds + L_XC + tt * ROWB + c * 2));
              h = a * h + xc * ig * mult; cum *= a; hv[i] = h; cv[i] = cum; }
          LAS float* ag = (LAS float*)(lds + L_AGG);
          ag[(ts * 64 + c) * 2] = cum; ag[(ts * 64 + c) * 2 + 1] = h; }
        __syncthreads();
        { const LAS float* ag = (const LAS float*)(lds + L_AGG);
          float carry = 0.f, pprev = 1.f;
          for (int s = 0; s < ts; ++s) { const float as = ag[(s * 64 + c) * 2], hs = ag[(s * 64 + c) * 2 + 1]; carry = as * carry + hs; pprev *= as; }
          if (ts == 7) { float* g = AGG + ((size_t)((b * 8 + n) * 64 + k) * 64 + c) * 2; g[0] = pprev * cv[15]; g[1] = cv[15] * carry + hv[15]; }
#pragma unroll
          for (int i = 0; i < 16; ++i) { const int tt = ts * 16 + i;
              const float gy = bf2f(*(const LAS bf16*)(lds + L_GY + tt * 128 + c * 2));
              *(LAS bf16*)(lds + L_OUT + tt * 128 + c * 2) = (bf16)f2bf(cv[i] * pprev * gy); *(LAS bf16*)(lds + L_OUT + 16384 + tt * 128 + c * 2) = (bf16)f2bf((hv[i] + cv[i] * carry) * gy); } }
        __syncthreads();
#pragma unroll
        for (int i = 0; i < 2; ++i) { const int e = tid + 512 * i, row = e >> 3, cc = e & 7;
            *(GAS v4u*)(PG + (rowbase + p0 + row) * 512 + n * 64 + cc * 8) = *(const LAS v4u*)(lds + L_OUT + row * 128 + cc * 16);
            *(GAS v4u*)(QG + (rowbase + p0 + row) * 512 + n * 64 + cc * 8) = *(const LAS v4u*)(lds + L_OUT + 16384 + row * 128 + cc * 16); }
        __syncthreads();
    }
}

__device__ __forceinline__ void l2_phase(Frame& F) {
    const bf16* PG = (const bf16*)(F.ws + WS_PG); const bf16* QG = (const bf16*)(F.ws + WS_QG); const float* AGG = (const float*)(F.ws + AGG_OFF);
    bf16* AL = (bf16*)(F.ws + WS_AL);
    LAS float* car = (LAS float*)F.lds;
    const int tid = F.tid;
    for (int u0 = F.vcu * 4; u0 < 1024; u0 += F.G * 4) {
        const int bn = u0 >> 6, k0 = u0 & 63, b = bn >> 3, n = bn & 7;
        if (tid < 64) { const float* g = AGG + ((size_t)bn * 64 * 64 + tid) * 2; float carry = 0.f;
            for (int j0 = 0; j0 < k0; j0 += 4) { float a_[4], h_[4];
#pragma unroll
                for (int q = 0; q < 4; ++q) { a_[q] = g[(size_t)(j0 + q) * 128]; h_[q] = g[(size_t)(j0 + q) * 128 + 1]; }
#pragma unroll
                for (int q = 0; q < 4; ++q) carry = a_[q] * carry + h_[q]; }
            float a_[4], h_[4];
#pragma unroll
            for (int q = 0; q < 4; ++q) { a_[q] = g[(size_t)(k0 + q) * 128]; h_[q] = g[(size_t)(k0 + q) * 128 + 1]; }
#pragma unroll
            for (int q = 0; q < 4; ++q) { car[q * 64 + tid] = carry; carry = a_[q] * carry + h_[q]; } }
        __syncthreads();
        v4u qv[8], pv[8];
#pragma unroll
        for (int i = 0; i < 8; ++i) { const int e = tid + 512 * i, tok = e >> 3, g8 = e & 7; const size_t row = (size_t)b * SEQ + k0 * 128 + tok;
            qv[i] = *(const GAS v4u*)(QG + row * 512 + n * 64 + g8 * 8); pv[i] = *(const GAS v4u*)(PG + row * 512 + n * 64 + g8 * 8); }
#pragma unroll
        for (int i = 0; i < 8; ++i) { const int e = tid + 512 * i, tok = e >> 3, g8 = e & 7; const size_t row = (size_t)b * SEQ + k0 * 128 + tok;
            const LAS float* cp = car + (tok >> 7) * 64 + g8 * 8; v4u o;
#pragma unroll
            for (int w = 0; w < 4; ++w) { const float c0 = cp[2 * w], c1 = cp[2 * w + 1];
                o[w] = pk2(__builtin_bit_cast(float, qv[i][w] << 16) + __builtin_bit_cast(float, pv[i][w] << 16) * c0, __builtin_bit_cast(float, qv[i][w] & 0xffff0000u) + __builtin_bit_cast(float, pv[i][w] & 0xffff0000u) * c1); }
            *(GAS v4u*)(AL + row * 1024 + 512 + n * 64 + g8 * 8) = o; }
        __syncthreads();
    }
}
}

namespace moe {
constexpr int L_TOK = LDSCTL_OFF + 512;
constexpr int L_HIST = LDSCTL_OFF + 2560, L_BASE = LDSCTL_OFF + 2688, L_PAD = LDSCTL_OFF + 2816;
constexpr size_t TOKSLOT_OFF = WS_MISC + 1 * MiB;
constexpr size_t WER_OFF = WS_MISC + 1536 * 1024;
static_assert(L_PAD + 33 * 4 <= LDS_BYTES, "LDS control map");

__device__ __forceinline__ void route_phase(Frame& F, bool dry) {
    const int lane = F.lane, wave = F.wave, tid = F.tid, r32 = lane & 31, hi = lane >> 5;
    LAS unsigned char* lds = F.lds;
    const float* x1 = F.out;
    { const GAS v4u* src = (const GAS v4u*)(F.ws + WER_OFF);
#pragma unroll 6
      for (int i = 0; i < 18; ++i) *(LAS v4u*)(lds + (tid + 512 * i) * 16) = src[tid + 512 * i]; }
    f32x4 gv[4];
#pragma unroll
    for (int j = 0; j < 4; ++j) gv[j] = ((const GAS f32x4*)F.in[15])[lane + 64 * j];
    for (int i = 0; i < 8; ++i) { const int lt = wave * 8 + i, tok = F.vcu * 64 + lt;
        const GAS f32x4* xr = (const GAS f32x4*)(x1 + (size_t)tok * DM) + lane; float s = 0.f; f32x4 vv[4];
#pragma unroll
        for (int j = 0; j < 4; ++j) { const f32x4 v = xr[64 * j]; vv[j] = v; s += (v.x * v.x + v.y * v.y) + (v.z * v.z + v.w * v.w); }
        s = wave_sum(s);
        const float rstd = rsqrtf(s * (1.f / DM) + EPS);
        if (lane == 0) ((LAS float*)(lds + L_TOK + lt * 32))[6] = rstd;
        if (!dry) { GAS unsigned long long* hb = (GAS unsigned long long*)((bf16*)(F.ws + WS_HNB) + (size_t)tok * DM) + lane;
#pragma unroll
            for (int j = 0; j < 4; ++j) { const f32x4 h = vv[j] * rstd * gv[j]; hb[64 * j] = (unsigned long long)pk2(h.x, h.y) | ((unsigned long long)pk2(h.z, h.w) << 32); } } }
    __syncthreads();
    typedef float f32x16 __attribute__((ext_vector_type(16)));
    f32x16 acc0, acc1;
#pragma unroll
    for (int r = 0; r < 16; ++r) { acc0[r] = 0.f; acc1[r] = 0.f; }
    { const int mb = wave & 1, kq = wave >> 1, lt = mb * 32 + r32, tok = F.vcu * 64 + lt;
      const float rs = ((const LAS float*)(lds + L_TOK + lt * 32))[6];
      const float* xp = x1 + (size_t)tok * DM + kq * 256 + 8 * hi;
      const LAS unsigned char* wp0 = lds + r32 * 2048;
      const LAS unsigned char* wp1 = lds + (32 + (r32 & 3)) * 2048;
      const int c0 = kq * 32 + hi, z0 = r32 & 15, z1 = r32 & 3;
      const bool gz = r32 >= 4;
#pragma unroll 4
      for (int ks = 0; ks < 16; ++ks) {
          const f32x4 xa = *(const GAS f32x4*)(xp + ks * 16), xb = *(const GAS f32x4*)(xp + ks * 16 + 4);
          v4u ah, al;
#pragma unroll
          for (int e = 0; e < 4; ++e) { const float h0 = (e < 2 ? xa[2 * e] : xb[2 * e - 4]) * rs, h1 = (e < 2 ? xa[2 * e + 1] : xb[2 * e - 3]) * rs;
              const unsigned b0 = f2bf(h0), b1 = f2bf(h1); ah[e] = b0 | (b1 << 16);
              al[e] = pk2(h0 - __builtin_bit_cast(float, b0 << 16), h1 - __builtin_bit_cast(float, b1 << 16)); }
          const bf16x8 a_h = __builtin_bit_cast(bf16x8, ah), a_l = __builtin_bit_cast(bf16x8, al);
          const int o0 = ((c0 + 2 * ks) ^ z0) * 16, o1 = ((c0 + 2 * ks) ^ z1) * 16;
          const bf16x8 bh0 = *(const LAS bf16x8*)(wp0 + o0), bl0 = *(const LAS bf16x8*)(wp0 + 73728 + o0);
          bf16x8 bh1 = *(const LAS bf16x8*)(wp1 + o1), bl1 = *(const LAS bf16x8*)(wp1 + 73728 + o1);
          if (gz) { bh1 = (bf16x8){0, 0, 0, 0, 0, 0, 0, 0}; bl1 = bh1; }
          acc0 = __builtin_amdgcn_mfma_f32_32x32x16_bf16(a_h, bh0, acc0, 0, 0, 0); acc0 = __builtin_amdgcn_mfma_f32_32x32x16_bf16(a_h, bl0, acc0, 0, 0, 0); acc0 = __builtin_amdgcn_mfma_f32_32x32x16_bf16(a_l, bh0, acc0, 0, 0, 0);
          acc1 = __builtin_amdgcn_mfma_f32_32x32x16_bf16(a_h, bh1, acc1, 0, 0, 0); acc1 = __builtin_amdgcn_mfma_f32_32x32x16_bf16(a_h, bl1, acc1, 0, 0, 0); acc1 = __builtin_amdgcn_mfma_f32_32x32x16_bf16(a_l, bh1, acc1, 0, 0, 0);
      } }
    __syncthreads();
    { LAS float* part = (LAS float*)lds;
#pragma unroll
      for (int r = 0; r < 16; ++r) { part[((wave * 2 + 0) * 16 + r) * 64 + lane] = acc0[r]; part[((wave * 2 + 1) * 16 + r) * 64 + lane] = acc1[r]; } }
    __syncthreads();
    if (tid < 64) {
        const int lt = tid, mb = lt >> 5, i5 = lt & 31, h2 = (i5 >> 2) & 1, r = (i5 & 3) + 4 * (i5 >> 3);
        const LAS float* part = (const LAS float*)lds;
        float lg[4];
#pragma unroll
        for (int c = 0; c < 4; ++c) { float s = 0.f;
#pragma unroll
            for (int kq = 0; kq < 4; ++kq) s += part[(((mb + 2 * kq) * 2 + 1) * 16 + r) * 64 + h2 * 32 + c];
            lg[c] = s; }
        int grp = 0; float mx = lg[0];
#pragma unroll
        for (int e = 1; e < 4; ++e) if (lg[e] > mx) { mx = lg[e]; grp = e; }
        float den = 0.f;
#pragma unroll
        for (int e = 0; e < 4; ++e) den += __expf(lg[e] - mx);
        const float gw = 1.f / den;
        float le[8];
#pragma unroll
        for (int e = 0; e < 8; ++e) { float s = 0.f;
#pragma unroll
            for (int kq = 0; kq < 4; ++kq) s += part[(((mb + 2 * kq) * 2 + 0) * 16 + r) * 64 + h2 * 32 + grp * 8 + e];
            le[e] = s; }
        int i0 = 0; float m0 = le[0];
#pragma unroll
        for (int e = 1; e < 8; ++e) if (le[e] > m0) { m0 = le[e]; i0 = e; }
        int i1 = -1; float m1 = -INFINITY;
#pragma unroll
        for (int e = 0; e < 8; ++e) if (e != i0 && le[e] > m1) { m1 = le[e]; i1 = e; }
        const float pa = 1.f / (1.f + __expf(m1 - m0));
        if (!dry) { const int e0 = grp * 8 + i0, e1 = grp * 8 + i1;
            const int l0 = atomicAdd((int*)(lds + L_HIST) + e0, 1), l1 = atomicAdd((int*)(lds + L_HIST) + e1, 1);
            LAS int* tk = (LAS int*)(lds + L_TOK + lt * 32); tk[0] = e0; tk[1] = e1; ((LAS float*)tk)[2] = gw * pa; ((LAS float*)tk)[3] = gw * (1.f - pa); tk[4] = l0; tk[5] = l1; }
        else asm volatile("" :: "v"(gw), "v"(pa), "v"(i0), "v"(i1));
    }
    __syncthreads();
    if (dry) return;
    if (tid < 32) { const int h = ((LAS int*)(lds + L_HIST))[tid];
        ((LAS int*)(lds + L_BASE))[tid] = (int)atomicAdd((unsigned*)(F.ctl + CW_CNT) + tid, (unsigned)h); }
}
__device__ __forceinline__ void scatter_phase(Frame& F) {
    const int lane = F.lane, wave = F.wave;
    LAS unsigned char* lds = F.lds;
    if (F.tid == 0) { int cs[32];
#pragma unroll
        for (int e = 0; e < 32; ++e) cs[e] = (int)__hip_atomic_load(F.ctl + CW_CNT + e, RLX_AGENT);
        int acc = 0; LAS int* pad = (LAS int*)(lds + L_PAD);
#pragma unroll
        for (int e = 0; e < 32; ++e) { pad[e] = acc; acc += (cs[e] + 255) & ~255; }
        pad[32] = acc; }
    __syncthreads();
    bf16* XS = (bf16*)(F.ws + WS_XS); int* TS = (int*)(F.ws + TOKSLOT_OFF); const bf16* HNB = (const bf16*)(F.ws + WS_HNB);
    const LAS int* pad = (const LAS int*)(lds + L_PAD); const LAS int* base = (const LAS int*)(lds + L_BASE);
    for (int i = 0; i < 8; i += 4) {
        v4u a[4], b[4];
#pragma unroll
        for (int q = 0; q < 4; ++q) { const int tok = F.vcu * 64 + wave * 8 + i + q; const GAS v4u* src = (const GAS v4u*)(HNB + (size_t)tok * DM) + lane; a[q] = src[0]; b[q] = src[64]; }
#pragma unroll
        for (int q = 0; q < 4; ++q) { const int lt = wave * 8 + i + q, tok = F.vcu * 64 + lt;
            const LAS int* tk = (const LAS int*)(lds + L_TOK + lt * 32);
            const int e0 = tk[0], e1 = tk[1];
            const int s0 = pad[e0] + base[e0] + tk[4], s1 = pad[e1] + base[e1] + tk[5];
            GAS v4u* o0 = (GAS v4u*)(XS + (size_t)s0 * 1024) + lane; GAS v4u* o1 = (GAS v4u*)(XS + (size_t)s1 * 1024) + lane;
            o0[0] = a[q]; o0[64] = b[q]; o1[0] = a[q]; o1[64] = b[q];
            if (lane == 0) { int* t = TS + (size_t)tok * 4; t[0] = s0; t[1] = s1; t[2] = tk[2]; t[3] = tk[3]; } }
    }
}
__device__ __forceinline__ void final_phase(Frame& F, float* dst) {
    const int lane = F.lane; const int gw = F.vcu * NWAVES + F.wave, NGW = F.G * NWAVES;
    const bf16* YB = (const bf16*)(F.ws + WS_YB); const int* TS = (const int*)(F.ws + TOKSLOT_OFF); const float* gfin = F.in[21];
    f32x4 gv[4];
#pragma unroll
    for (int j = 0; j < 4; ++j) gv[j] = ((const GAS f32x4*)gfin)[lane + 64 * j];
    for (int tok = gw; tok < NTOK; tok += NGW) {
        const int* t = TS + (size_t)tok * 4; const int s0 = t[0], s1 = t[1]; const float w0 = __builtin_bit_cast(float, t[2]), w1 = __builtin_bit_cast(float, t[3]);
        GAS f32x4* xr = (GAS f32x4*)(F.out + (size_t)tok * DM) + lane;
        const GAS unsigned long long* y0 = (const GAS unsigned long long*)(YB + (size_t)s0 * 1024) + lane; const GAS unsigned long long* y1 = (const GAS unsigned long long*)(YB + (size_t)s1 * 1024) + lane;
        f32x4 v[4]; float s = 0.f;
#pragma unroll
        for (int j = 0; j < 4; ++j) { v[j] = xr[64 * j]; const unsigned long long a = y0[64 * j], b = y1[64 * j];
            v[j].x += w0 * __builtin_bit_cast(float, (unsigned)a << 16) + w1 * __builtin_bit_cast(float, (unsigned)b << 16);
            v[j].y += w0 * __builtin_bit_cast(float, (unsigned)a & 0xffff0000u) + w1 * __builtin_bit_cast(float, (unsigned)b & 0xffff0000u);
            v[j].z += w0 * __builtin_bit_cast(float, (unsigned)(a >> 32) << 16) + w1 * __builtin_bit_cast(float, (unsigned)(b >> 32) << 16);
            v[j].w += w0 * __builtin_bit_cast(float, (unsigned)(a >> 32) & 0xffff0000u) + w1 * __builtin_bit_cast(float, (unsigned)(b >> 32) & 0xffff0000u);
            s += (v[j].x * v[j].x + v[j].y * v[j].y) + (v[j].z * v[j].z + v[j].w * v[j].w); }
        const float rstd = rsqrtf(wave_sum(s) * (1.f / DM) + EPS);
        GAS f32x4* orow = (GAS f32x4*)(dst + (size_t)tok * DM) + lane;
#pragma unroll
        for (int j = 0; j < 4; ++j) orow[64 * j] = v[j] * rstd * gv[j];
    }
}
}

struct Args { const float* in[22]; float* out; unsigned char* ws; int ph_lo, ph_hi, li, pad; };
constexpr int N_PHASES = 2;
__global__ void __launch_bounds__(NWAVES * 64, 2) mega(Args args) {
    extern __shared__ __attribute__((aligned(16))) unsigned char lds[];
    Frame F;
    F.lds = (LAS unsigned char*)lds;
    F.MISC = (volatile LAS unsigned*)(F.lds + MISC_OFF);
    F.tid = threadIdx.x; F.lane = F.tid & 63; F.wave = __builtin_amdgcn_readfirstlane(F.tid >> 6);
    F.G = gridDim.x; { const int bx = blockIdx.x; F.vcu = (F.G % 8 == 0) ? (bx % 8) * (F.G / 8) + bx / 8 : bx; }
    F.ws = args.ws; F.out = args.out; F.ctl = (gu32*)(args.ws + WS_CTL);
#pragma unroll
    for (int i = 0; i < 22; ++i) F.in[i] = args.in[i];
    for (int u = F.tid; u < (LDS_BYTES - LDSCTL_OFF) / 4; u += NWAVES * 64) ((LAS unsigned*)(F.lds + LDSCTL_OFF))[u] = 0u;
    __syncthreads();
    XcdBarrier bar = xcd_barrier_post((unsigned*)(F.ctl + CW_BAR) + args.li * XCD_BAR_WORDS, F.MISC + 8);
    const int lo = args.ph_lo, hi = args.ph_hi;
#define IN(k) (lo <= (k) && (k) < hi)
#define BOTH(k) (IN(k) && IN((k) + 1))
#define GRID_BAR() xcd_barrier(bar)
#define REFRESH() do { int t_ = threadIdx.x; asm volatile("" : "+v"(t_)); F.tid = t_; F.lane = t_ & 63; } while (0)

    if (IN(0)) { REFRESH(); p0_prologue(F); if (BOTH(0)) GRID_BAR(); }

    if (IN(1)) {
        pg8::Gemm g{(const bf16*)(F.ws + WS_XN), (const bf16*)(F.ws + WS_WIN), NTOK, INC, DM}; pg8::StaticOrder S; S.init(NTOK, INC, F.G, (int)blockIdx.x);
        pg8::EpiInProj E{(bf16*)(F.ws + WS_Q), (bf16*)(F.ws + WS_K), (bf16*)(F.ws + WS_V), (bf16*)(F.ws + WS_XR), (bf16*)(F.ws + WS_GY), (bf16*)F.out, (unsigned*)(F.ctl + CW_QKMAX)};
        pg8::gemm_phase<pg8::EpiInProj, pg8::StaticOrder, true, true>(F.lds + RING_OFF, g, S, E);
        if (BOTH(1)) GRID_BAR();
    }
    if (IN(2)) { REFRESH(); lru::l1_phase(F);
#ifdef PROBE_L1X2
        REFRESH(); lru::l1_phase(F);
#endif
        REFRESH(); att2::attn_phase<0>(F, (bf16*)(F.ws + WS_AL), 1024, att2::CW_AQ2);
#ifdef PROBE_ATT
        __syncthreads(); REFRESH(); att2::attn_phase<PROBE_ATT>(F, (bf16*)(F.ws + 256 * MiB), 512, att2::CW_AQ2 + 64);
#ifdef PROBE_ATT3
        __syncthreads(); REFRESH(); att2::attn_phase<PROBE_ATT>(F, (bf16*)(F.ws + 256 * MiB), 512, att2::CW_AQ2 + 128);
        __syncthreads(); REFRESH(); att2::attn_phase<PROBE_ATT>(F, (bf16*)(F.ws + 256 * MiB), 512, att2::CW_AQ2 + 192);
#endif
#endif
        if (BOTH(2)) GRID_BAR(); }

    if (IN(3)) { REFRESH(); lru::l2_phase(F); if (BOTH(3)) GRID_BAR(); }
#ifndef NO_P4
    if (IN(4)) {
        pg8::Gemm g{(const bf16*)(F.ws + WS_AL), (const bf16*)(F.ws + WS_WMIX), NTOK, DM, DM}; pg8::StaticOrder S; S.init(NTOK, DM, F.G, (int)blockIdx.x);
        pg8::EpiMix E{(const bf16*)F.out, (bf16*)(F.ws + WS_MERGED)};
        pg8::gemm_phase<pg8::EpiMix, pg8::StaticOrder, true, true>(F.lds + RING_OFF, g, S, E);
        if (BOTH(4)) GRID_BAR();
    }
#endif
#ifndef NO_P5
    if (IN(5)) {
        pg8::Gemm g{(const bf16*)(F.ws + WS_MERGED), (const bf16*)(F.ws + WS_WOUT), NTOK, DM, DM}; pg8::StaticOrder S; S.init(NTOK, DM, F.G, (int)blockIdx.x);
        pg8::EpiResidF32 E{F.in[0], F.out};
        pg8::gemm_phase<pg8::EpiResidF32, pg8::StaticOrder, true, true>(F.lds + RING_OFF, g, S, E);
        if (BOTH(5)) GRID_BAR();
    }
#endif
    if (IN(6)) { REFRESH();
#ifdef PROBE_ROUTEX2
        moe::route_phase(F, true); __syncthreads(); REFRESH();
#endif
        moe::route_phase(F, false); if (BOTH(6)) GRID_BAR(); }
    if (IN(7)) { REFRESH(); moe::scatter_phase(F);
#ifdef PROBE_SCATX2
        __syncthreads(); REFRESH(); moe::scatter_phase(F);
#endif
#ifdef PROBE_BARX10
        for (int i_ = 0; i_ < 10; ++i_) GRID_BAR();
#endif
        if (BOTH(7)) GRID_BAR(); }
#ifdef DUP_PHASE
    if ((IN(8) || IN(9)) && !IN(7)) { if (F.tid == 0) { int acc = 0; LAS int* pad = (LAS int*)(F.lds + moe::L_PAD);
        for (int e = 0; e < 32; ++e) { pad[e] = acc; const int c = (int)__hip_atomic_load(F.ctl + CW_CNT + e, RLX_AGENT); acc += (c + 255) & ~255; } pad[32] = acc; } __syncthreads(); }
#endif
    if (IN(8)) {
        pg8::Gemm g{(const bf16*)(F.ws + WS_XS), (const bf16*)(F.ws + WS_WGU), 0, 0, 1024}; pg8::MoeOrder S; S.init((const LAS int*)(F.lds + moe::L_PAD), F.G, (int)blockIdx.x);
        pg8::EpiSwiGLU E{(bf16*)(F.ws + WS_HB)};
        pg8::gemm_phase<pg8::EpiSwiGLU, pg8::MoeOrder, true, true>(F.lds + RING_OFF, g, S, E);
        if (BOTH(8)) GRID_BAR();
    }
    if (IN(9)) {
        pg8::Gemm g{(const bf16*)(F.ws + WS_HB), (const bf16*)(F.ws + WS_WD), 0, 0, 512}; pg8::MoeOrder S; S.init((const LAS int*)(F.lds + moe::L_PAD), F.G, (int)blockIdx.x);
        pg8::EpiStoreBf16 E{(bf16*)(F.ws + WS_YB), 1024};
        pg8::gemm_phase<pg8::EpiStoreBf16, pg8::MoeOrder, true, true>(F.lds + RING_OFF, g, S, E);
        if (BOTH(9)) GRID_BAR();
    }
    if (IN(10)) { REFRESH();
#ifdef PROBE_FINALX2
        moe::final_phase(F, (float*)(F.ws + 190 * MiB)); REFRESH();
#endif
        moe::final_phase(F, F.out); }
#undef IN
#undef BOTH
#undef GRID_BAR
#undef REFRESH
}
__global__ void n_rmsnorm(const float* __restrict__ x, const float* __restrict__ g, bf16* __restrict__ xn) {
    const int row = blockIdx.x, tid = threadIdx.x;
    const float4 v = ((const float4*)(x + (size_t)row * DM))[tid];
    float s = v.x * v.x + v.y * v.y + v.z * v.z + v.w * v.w;
    __shared__ float red[256];
    red[tid] = s; __syncthreads();
    for (int o = 128; o > 0; o >>= 1) { if (tid < o) red[tid] += red[tid + o]; __syncthreads(); }
    const float rstd = rsqrtf(red[0] / DM + EPS);
    const float4 gg = ((const float4*)g)[tid];
    bf16* o = xn + (size_t)row * DM + tid * 4;
    o[0] = f2bf(v.x * rstd * gg.x); o[1] = f2bf(v.y * rstd * gg.y); o[2] = f2bf(v.z * rstd * gg.z); o[3] = f2bf(v.w * rstd * gg.w);
}

template <class Epi>
__global__ void n_gemm(const bf16* __restrict__ A, int lda, const float* __restrict__ W, int ldw, int K, Epi epi) {
    __shared__ float As[16][65]; __shared__ float Ws[16][64];
    const int tx = threadIdx.x, ty = threadIdx.y, tid = ty * 16 + tx;
    const int row0 = blockIdx.y * 64, col0 = blockIdx.x * 64;
    float acc[4][4];
#pragma unroll
    for (int i = 0; i < 4; ++i)
#pragma unroll
        for (int j = 0; j < 4; ++j) acc[i][j] = 0.f;
    for (int k0 = 0; k0 < K; k0 += 16) {
#pragma unroll
        for (int i = 0; i < 4; ++i) { const int idx = tid + i * 256; const int r = idx >> 4, kk = idx & 15; As[kk][r] = bf2f(A[(size_t)(row0 + r) * lda + k0 + kk]); }
#pragma unroll
        for (int i = 0; i < 4; ++i) { const int idx = tid + i * 256; const int kk = idx >> 6, c = idx & 63; Ws[kk][c] = W[(size_t)(k0 + kk) * ldw + col0 + c]; }
        __syncthreads();
#pragma unroll
        for (int kk = 0; kk < 16; ++kk) {
            float a[4], b[4];
#pragma unroll
            for (int i = 0; i < 4; ++i) a[i] = As[kk][ty * 4 + i];
#pragma unroll
            for (int j = 0; j < 4; ++j) b[j] = Ws[kk][tx * 4 + j];
#pragma unroll
            for (int i = 0; i < 4; ++i)
#pragma unroll
                for (int j = 0; j < 4; ++j) acc[i][j] += a[i] * b[j];
        }
        __syncthreads();
    }
#pragma unroll
    for (int i = 0; i < 4; ++i)
#pragma unroll
        for (int j = 0; j < 4; ++j) epi(row0 + ty * 4 + i, col0 + tx * 4 + j, acc[i][j]);
}

struct EpiInProjN {
    bf16 *Q, *K, *V, *XR, *GY, *GATES;
    __device__ void operator()(int r, int c, float v) const {
        if (c < 512) Q[(size_t)r * 512 + c] = f2bf(v * C2);
        else if (c < 1024) K[(size_t)r * 512 + c - 512] = f2bf(v);
        else if (c < 1536) V[(size_t)r * 512 + c - 1024] = f2bf(v);
        else if (c < 2048) XR[(size_t)r * 512 + c - 1536] = f2bf(v);
        else if (c < 2560) GY[(size_t)r * 512 + c - 2048] = f2bf(gelu_tanh(v));
        else GATES[(size_t)r * 2048 + c - 2560] = f2bf(sigmoidf_(v));
    }
};
struct EpiResid { const float* x; float* out; __device__ void operator()(int r, int c, float v) const { out[(size_t)r * DM + c] = x[(size_t)r * DM + c] + v; } };

__global__ void n_gemm_mix(const bf16* __restrict__ AL, const float* __restrict__ Woa, const float* __restrict__ Wol, const bf16* __restrict__ GATES, bf16* __restrict__ MERGED) {
    __shared__ float As[2][16][65]; __shared__ float Ws[2][16][64];
    const int tx = threadIdx.x, ty = threadIdx.y, tid = ty * 16 + tx;
    const int row0 = blockIdx.y * 64, col0 = blockIdx.x * 64;
    float acc[2][4][4];
#pragma unroll
    for (int s = 0; s < 2; ++s)
#pragma unroll
        for (int i = 0; i < 4; ++i)
#pragma unroll
            for (int j = 0; j < 4; ++j) acc[s][i][j] = 0.f;
    for (int k0 = 0; k0 < 512; k0 += 16) {
#pragma unroll
        for (int i = 0; i < 4; ++i) { const int idx = tid + i * 256; const int r = idx >> 4, kk = idx & 15;
            As[0][kk][r] = bf2f(AL[(size_t)(row0 + r) * 1024 + k0 + kk]); As[1][kk][r] = bf2f(AL[(size_t)(row0 + r) * 1024 + 512 + k0 + kk]); }
#pragma unroll
        for (int i = 0; i < 4; ++i) { const int idx = tid + i * 256; const int kk = idx >> 6, c = idx & 63;
            Ws[0][kk][c] = Woa[(size_t)(k0 + kk) * 1024 + col0 + c]; Ws[1][kk][c] = Wol[(size_t)(k0 + kk) * 1024 + col0 + c]; }
        __syncthreads();
#pragma unroll
        for (int s = 0; s < 2; ++s)
#pragma unroll
            for (int kk = 0; kk < 16; ++kk) {
                float a[4], b[4];
#pragma unroll
                for (int i = 0; i < 4; ++i) a[i] = As[s][kk][ty * 4 + i];
#pragma unroll
                for (int j = 0; j < 4; ++j) b[j] = Ws[s][kk][tx * 4 + j];
#pragma unroll
                for (int i = 0; i < 4; ++i)
#pragma unroll
                    for (int j = 0; j < 4; ++j) acc[s][i][j] += a[i] * b[j];
            }
        __syncthreads();
    }
#pragma unroll
    for (int i = 0; i < 4; ++i)
#pragma unroll
        for (int j = 0; j < 4; ++j) { const int r = row0 + ty * 4 + i, c = col0 + tx * 4 + j;
            const float ga = bf2f(GATES[(size_t)r * 2048 + c]), gl = bf2f(GATES[(size_t)r * 2048 + 1024 + c]);
            MERGED[(size_t)r * 1024 + c] = f2bf(ga * acc[0][i][j] + gl * acc[1][i][j]); }
}

__global__ void n_attn(const bf16* __restrict__ Q, const bf16* __restrict__ K, const bf16* __restrict__ V, const float* __restrict__ lambda_qk, const float* __restrict__ subln_g, bf16* __restrict__ AL) {
    const int row = blockIdx.x, h = blockIdx.y, tid = threadIdx.x;
    const int b = row / SEQ, qpos = row % SEQ;
    __shared__ float sc[SEQ]; __shared__ float qv[64]; __shared__ float red[256]; __shared__ float o0[128]; __shared__ float part[256];
    const float slope2 = exp2f(-2.f * (h + 1)) * LOG2E;
    float lam;
    { float s0 = 0.f, s1 = 0.f; for (int d = 0; d < 64; ++d) { s0 += lambda_qk[d] * lambda_qk[64 + d]; s1 += lambda_qk[128 + d] * lambda_qk[192 + d]; } lam = expf(s0) - expf(s1) + 0.2f; }
    float ofin = 0.f;
    for (int m = 0; m < 2; ++m) {
        __syncthreads();
        if (tid < 64) qv[tid] = bf2f(Q[(size_t)row * 512 + h * 128 + m * 64 + tid]);
        __syncthreads();
        float lmax = -INFINITY;
        for (int key = tid; key <= qpos; key += 256) {
            const bf16* kr = K + (size_t)(b * SEQ + key) * 512 + h * 128 + m * 64;
            float s = 0.f;
            for (int d = 0; d < 64; ++d) s += qv[d] * bf2f(kr[d]);
            s += slope2 * (float)(key - qpos);
            sc[key] = s; lmax = fmaxf(lmax, s);
        }
        red[tid] = lmax; __syncthreads();
        for (int o = 128; o > 0; o >>= 1) { if (tid < o) red[tid] = fmaxf(red[tid], red[tid + o]); __syncthreads(); }
        const float mx = red[0]; __syncthreads();
        float lsum = 0.f;
        for (int key = tid; key <= qpos; key += 256) { const float p = exp2f(sc[key] - mx); sc[key] = p; lsum += p; }
        red[tid] = lsum; __syncthreads();
        for (int o = 128; o > 0; o >>= 1) { if (tid < o) red[tid] += red[tid + o]; __syncthreads(); }
        const float inv = 1.f / red[0]; __syncthreads();
        const int vd = tid & 127, half = tid >> 7;
        float acc = 0.f;
        for (int key = half; key <= qpos; key += 2) acc += sc[key] * bf2f(V[(size_t)(b * SEQ + key) * 512 + h * 128 + vd]);
        part[tid] = acc; __syncthreads();
        if (tid < 128) { const float o = (part[tid] + part[tid + 128]) * inv; if (m == 0) ofin = o; else ofin = ofin - lam * o; }
    }
    __syncthreads();
    red[tid] = (tid < 128) ? ofin * ofin : 0.f; __syncthreads();
    for (int o = 128; o > 0; o >>= 1) { if (tid < o) red[tid] += red[tid + o]; __syncthreads(); }
    const float rstd = rsqrtf(red[0] / 128.f + EPS);
    if (tid < 128) AL[(size_t)row * 1024 + h * 128 + tid] = f2bf(ofin * rstd * subln_g[tid] * 0.8f);
}

__global__ void n_lru(const bf16* __restrict__ XR, const bf16* __restrict__ GY, const float* __restrict__ conv_w, const float* __restrict__ conv_b, const float* __restrict__ w_r, const float* __restrict__ b_r,
                      const float* __restrict__ w_i, const float* __restrict__ b_i, const float* __restrict__ lru_lambda, bf16* __restrict__ AL) {
    const int b = blockIdx.x >> 3, n = blockIdx.x & 7, d = threadIdx.x, ch = n * 64 + d;
    __shared__ float Wr[64][64]; __shared__ float Wi[64][64]; __shared__ float xs[64];
    for (int c = 0; c < 64; ++c) { Wr[c][d] = w_r[(size_t)n * 4096 + c * 64 + d]; Wi[c][d] = w_i[(size_t)n * 4096 + c * 64 + d]; }
    const float cw0 = conv_w[ch], cw1 = conv_w[512 + ch], cw2 = conv_w[1024 + ch], cw3 = conv_w[1536 + ch], cb = conv_b[ch];
    const float br = b_r[ch], bi = b_i[ch];
    const float sp = log1pf(expf(-lru_lambda[ch]));
    float xm3 = 0.f, xm2 = 0.f, xm1 = 0.f, hst = 0.f;
    __syncthreads();
    for (int t = 0; t < SEQ; ++t) {
        const size_t row = (size_t)b * SEQ + t;
        const float xt = bf2f(XR[row * 512 + ch]);
        const float xc = cw0 * xm3 + cw1 * xm2 + cw2 * xm1 + cw3 * xt + cb;
        xm3 = xm2; xm2 = xm1; xm1 = xt;
        xs[d] = xc; __syncthreads();
        float rp = br, ip = bi;
        for (int c = 0; c < 64; ++c) { const float xv = xs[c]; rp += xv * Wr[c][d]; ip += xv * Wi[c][d]; }
        __syncthreads();
        const float r = sigmoidf_(rp), ig = sigmoidf_(ip);
        const float log_a = -8.f * r * sp;
        const float a = expf(log_a);
        const float mult = (t == 0) ? 1.f : sqrtf(-expm1f(2.f * log_a));
        hst = a * hst + xc * ig * mult;
        AL[row * 1024 + 512 + ch] = f2bf(hst * bf2f(GY[row * 512 + ch]));
    }
}

__global__ void n_moe_final(float* __restrict__ xio, const float* __restrict__ g_ffn, const float* __restrict__ w_group, const float* __restrict__ w_er, const float* __restrict__ w_gate, const float* __restrict__ w_up,
                            const float* __restrict__ w_down, const float* __restrict__ g_fin) {
    const int row = blockIdx.x, tid = threadIdx.x;
    __shared__ float x1[1024]; __shared__ float hn[1024]; __shared__ float hb[512]; __shared__ float red[512]; __shared__ float lg[16]; __shared__ int sel[4]; __shared__ float selw[2];
    float* xr = xio + (size_t)row * DM;
    const float a0 = xr[tid], a1 = xr[tid + 512];
    x1[tid] = a0; x1[tid + 512] = a1;
    red[tid] = a0 * a0 + a1 * a1; __syncthreads();
    for (int o = 256; o > 0; o >>= 1) { if (tid < o) red[tid] += red[tid + o]; __syncthreads(); }
    const float rstd = rsqrtf(red[0] / DM + EPS); __syncthreads();
    hn[tid] = a0 * rstd * g_ffn[tid]; hn[tid + 512] = a1 * rstd * g_ffn[tid + 512]; __syncthreads();
    if (tid < 4) { float s = 0.f; for (int k = 0; k < 1024; ++k) s += hn[k] * w_group[k * 4 + tid]; lg[tid] = s; }
    __syncthreads();
    if (tid == 0) { int g = 0; float mx = lg[0]; for (int j = 1; j < 4; ++j) if (lg[j] > mx) { mx = lg[j]; g = j; } float den = 0.f; for (int j = 0; j < 4; ++j) den += expf(lg[j] - mx); sel[0] = g; lg[8] = 1.f / den; }
    __syncthreads();
    const int grp = sel[0];
    if (tid < 8) { float s = 0.f; const float* w = w_er + (size_t)grp * 8192; for (int k = 0; k < 1024; ++k) s += hn[k] * w[k * 8 + tid]; lg[tid] = s; }
    __syncthreads();
    if (tid == 0) {
        const float gw = lg[8];
        int i0 = 0; for (int j = 1; j < 8; ++j) if (lg[j] > lg[i0]) i0 = j;
        int i1 = (i0 == 0) ? 1 : 0; for (int j = 0; j < 8; ++j) if (j != i0 && lg[j] > lg[i1]) i1 = j;
        const float p0 = 1.f / (1.f + expf(lg[i1] - lg[i0]));
        sel[1] = grp * 8 + i0; sel[2] = grp * 8 + i1; selw[0] = gw * p0; selw[1] = gw * (1.f - p0);
    }
    __syncthreads();
    float y0 = 0.f, y1 = 0.f;
    for (int kk = 0; kk < 2; ++kk) {
        const int e = sel[1 + kk]; const float wk = selw[kk];
        const float* wg = w_gate + (size_t)e * 1024 * 512; const float* wu = w_up + (size_t)e * 1024 * 512; const float* wd = w_down + (size_t)e * 512 * 1024;
        float g = 0.f, u = 0.f;
        for (int k = 0; k < 1024; ++k) { const float xv = hn[k]; g += xv * wg[(size_t)k * 512 + tid]; u += xv * wu[(size_t)k * 512 + tid]; }
        __syncthreads();
        hb[tid] = g / (1.f + expf(-g)) * u; __syncthreads();
        float s0 = 0.f, s1 = 0.f;
        for (int j = 0; j < 512; ++j) { const float hv = hb[j]; s0 += hv * wd[(size_t)j * 1024 + tid]; s1 += hv * wd[(size_t)j * 1024 + tid + 512]; }
        y0 += wk * s0; y1 += wk * s1;
    }
    const float z0 = a0 + y0, z1 = a1 + y1;
    __syncthreads();
    red[tid] = z0 * z0 + z1 * z1; __syncthreads();
    for (int o = 256; o > 0; o >>= 1) { if (tid < o) red[tid] += red[tid + o]; __syncthreads(); }
    const float rs2 = rsqrtf(red[0] / DM + EPS);
    xr[tid] = z0 * rs2 * g_fin[tid]; xr[tid + 512] = z1 * rs2 * g_fin[tid + 512];
}


__global__ void n_conv_win(const float* __restrict__ W, bf16* __restrict__ WT) {
    const int c = blockIdx.x * 256 + threadIdx.x, k = blockIdx.y;
    const int w = c & 255; const int row = (c & ~255) + ((w >> 5) & 1) * 128 + (w >> 6) * 32 + (w & 31);
    WT[(size_t)row * 1024 + k] = (bf16)f2bf(W[(size_t)k * INC + c]);
}
#ifndef MEGA_HI
#define MEGA_HI 11
#endif
static void launch_mega(const Args& a0, int lo, int hi, int li, int grid, hipStream_t stream) {
    Args a = a0; a.ph_lo = lo; a.ph_hi = hi; a.li = li;
    hipLaunchKernelGGL(mega, dim3(grid), dim3(NWAVES * 64), LDS_BYTES, stream, a);
    const hipError_t le = hipPeekAtLastError();
    if (le != hipSuccess) fprintf(stderr, "kernel_launch: mega launch [%d,%d) failed: %s\n", lo, hi, hipGetErrorName(le));
}
extern "C" void kernel_launch(void* const* d_in, const int* in_sizes, int n_in, void* d_out, int out_size, void* d_ws, size_t ws_size, hipStream_t stream) {
    static int grid = 0;
    if (grid == 0) {
        if (n_in != 22 || out_size != NTOK * DM || ws_size < WS_END) { fprintf(stderr, "kernel_launch: unexpected shapes (n_in %d out %d ws %zu)\n", n_in, out_size, ws_size); grid = -1; return; }
        int dev = 0, cus = 0, per_cu = 0;
        if (hipGetDevice(&dev) != hipSuccess || hipDeviceGetAttribute(&cus, hipDeviceAttributeMultiprocessorCount, dev) != hipSuccess) { grid = -1; return; }
        if (hipFuncSetAttribute((const void*)mega, hipFuncAttributeMaxDynamicSharedMemorySize, LDS_BYTES) != hipSuccess) { fprintf(stderr, "kernel_launch: hipFuncSetAttribute failed\n"); grid = -1; return; }
        if (hipOccupancyMaxActiveBlocksPerMultiprocessor(&per_cu, (const void*)mega, NWAVES * 64, LDS_BYTES) != hipSuccess || per_cu < 1) fprintf(stderr, "kernel_launch: occupancy query says %d\n", per_cu);
        (void)hipGetLastError();
        grid = cus;
    }
    if (grid < 0) return;
    (void)hipMemsetAsync((char*)d_ws + WS_CTL, 0, CTL_ZERO_BYTES, stream);
    Args a{};
    for (int i = 0; i < 22; ++i) a.in[i] = (const float*)d_in[i];
    a.out = (float*)d_out; a.ws = (unsigned char*)d_ws;
    const float* x = (const float*)d_in[0];
    unsigned char* ws = (unsigned char*)d_ws;
    bf16* XN = (bf16*)(ws + WS_XN); bf16* Qb = (bf16*)(ws + WS_Q); bf16* Kb = (bf16*)(ws + WS_K); bf16* Vb = (bf16*)(ws + WS_V);
    bf16* XR = (bf16*)(ws + WS_XR); bf16* GY = (bf16*)(ws + WS_GY); bf16* AL = (bf16*)(ws + WS_AL); bf16* MERGED = (bf16*)(ws + WS_MERGED);
    bf16* GATES = (bf16*)d_out;
#ifdef DUP_PHASE
    launch_mega(a, 0, DUP_PHASE + 1, 0, grid, stream);
    launch_mega(a, DUP_PHASE, DUP_PHASE + 1, 1, grid, stream);
    if (DUP_PHASE + 1 < 11) launch_mega(a, DUP_PHASE + 1, 11, 2, grid, stream);
#elif defined(PROBE_P1_ONLY)
    n_rmsnorm<<<NTOK, 256, 0, stream>>>(x, (const float*)d_in[1], XN);
    n_conv_win<<<dim3(INC / 256, 1024), 256, 0, stream>>>((const float*)d_in[2], (bf16*)(ws + WS_WIN));
    launch_mega(a, 1, 2, 0, grid, stream);
#elif defined(MEGA_SPLIT)
    for (int ph = 0; ph < MEGA_HI; ++ph) launch_mega(a, ph, ph + 1, ph, grid, stream);
#else
    if (MEGA_HI > 0) launch_mega(a, 0, MEGA_HI, 0, grid, stream);
#endif
    if (MEGA_HI < 1) n_rmsnorm<<<NTOK, 256, 0, stream>>>(x, (const float*)d_in[1], XN);
    if (MEGA_HI < 2) n_gemm<EpiInProjN><<<dim3(INC / 64, NTOK / 64), dim3(16, 16), 0, stream>>>(XN, DM, (const float*)d_in[2], INC, DM, EpiInProjN{Qb, Kb, Vb, XR, GY, GATES});
    if (MEGA_HI < 3) n_attn<<<dim3(NTOK, 4), 256, 0, stream>>>(Qb, Kb, Vb, (const float*)d_in[3], (const float*)d_in[4], AL);
    if (MEGA_HI < 4) n_lru<<<16, 64, 0, stream>>>(XR, GY, (const float*)d_in[5], (const float*)d_in[6], (const float*)d_in[7], (const float*)d_in[8], (const float*)d_in[9], (const float*)d_in[10], (const float*)d_in[11], AL);
    if (MEGA_HI < 5) n_gemm_mix<<<dim3(DM / 64, NTOK / 64), dim3(16, 16), 0, stream>>>(AL, (const float*)d_in[12], (const float*)d_in[13], GATES, MERGED);
    if (MEGA_HI < 6) n_gemm<EpiResid><<<dim3(DM / 64, NTOK / 64), dim3(16, 16), 0, stream>>>(MERGED, DM, (const float*)d_in[14], DM, DM, EpiResid{x, (float*)d_out});
    if (MEGA_HI < 11) n_moe_final<<<NTOK, 512, 0, stream>>>((float*)d_out, (const float*)d_in[15], (const float*)d_in[16], (const float*)d_in[17], (const float*)d_in[18], (const float*)d_in[19], (const float*)d_in[20], (const float*)d_in[21]);
}
```

```cpp
#define P1_CONV_PER 3
#include <hip/hip_runtime.h>
#include <cstdio>
#include <cstdint>
#include <cmath>

constexpr int NTOK = 16384, SEQ = 8192, DM = 1024, INC = 4608;
constexpr float C2 = 0.125f * 1.4426950408889634f;
constexpr float LOG2E = 1.4426950408889634f;
constexpr float EPS = 1e-6f;
typedef unsigned short bf16;

__device__ __forceinline__ unsigned f2bf(float f) { unsigned u = __builtin_bit_cast(unsigned, f); return (u + 0x7fffu + ((u >> 16) & 1u)) >> 16; }
__device__ __forceinline__ unsigned pk2(float lo, float hi) { return f2bf(lo) | (f2bf(hi) << 16); }
__device__ __forceinline__ float bf2f(bf16 b) { return __builtin_bit_cast(float, (unsigned)b << 16); }
__device__ __forceinline__ float sigmoidf_(float x) { return 1.f / (1.f + __expf(-x)); }
__device__ __forceinline__ float gelu_tanh(float x) { const float z = 0.7978845608028654f * (x + 0.044715f * x * x * x); return 0.5f * x * (1.f + tanhf(z)); }
__device__ __forceinline__ float sigmoid_fast(float x) { return __builtin_amdgcn_rcpf(1.f + __builtin_amdgcn_exp2f(-LOG2E * x)); }
__device__ __forceinline__ float gelu_fast(float x) { const float z2 = 1.5957691216057308f * (x + 0.044715f * x * x * x); return x * sigmoid_fast(z2); }

constexpr size_t MiB = 1u << 20;
constexpr size_t WS_CTL = 0, CTL_ZERO_BYTES = 1 * MiB;
constexpr size_t WS_WIN = 1 * MiB, WS_WMIX = 10 * MiB, WS_WOUT = 12 * MiB, WS_WGU = 14 * MiB, WS_WD = 78 * MiB;
constexpr size_t WS_XN = 110 * MiB, WS_Q = 142 * MiB, WS_K = 158 * MiB, WS_V = 174 * MiB, WS_XR = 190 * MiB, WS_GY = 206 * MiB, WS_AL = 222 * MiB;
constexpr size_t WS_PG = 110 * MiB, WS_QG = 126 * MiB;
constexpr size_t WS_MERGED = 142 * MiB;
constexpr size_t WS_XS = 110 * MiB, WS_HB = 190 * MiB, WS_YB = 110 * MiB;
constexpr size_t WS_HNB = 222 * MiB;
constexpr size_t WS_MISC = 254 * MiB;
constexpr size_t WS_END = 256 * MiB;
constexpr int CW_QKMAX = 64;
constexpr int CW_CNT = 128;
constexpr int CW_BAR = 4096;
namespace pg8 {
#define PG8_LAS __attribute__((address_space(3)))
typedef unsigned short bf16_t;
typedef short bf16x8 __attribute__((ext_vector_type(8)));
typedef float f32x4 __attribute__((ext_vector_type(4)));
typedef unsigned u32x4 __attribute__((ext_vector_type(4)));
constexpr int BM = 256, BK = 64, HALF = 128, HTB = HALF * BK * 2  , STAGE_BYTES = 8 * HTB, NXCD = 8, WGM = 8;

__host__ __device__ __forceinline__ int lds_byte(int r, int c) { const int st = (r >> 4) * 2 + (c >> 5), rr = r & 15, cc = c & 31, ob = rr * 64 + cc * 2; return st * 1024 + (ob ^ (((ob >> 9) & 1) << 5)); }
__host__ __device__ __forceinline__ void stage_rc(int b, int& R, int& C) { const int st = b / 1024, sb = b % 1024, swz = sb ^ (((sb >> 9) & 1) << 5); R = (st >> 1) * 16 + swz / 64; C = (st & 1) * 32 + (swz % 64) / 2; }
__host__ __device__ __forceinline__ int perm32(int rho) { const int n = rho >> 4, i = rho & 15; return 8 * (i >> 2) + 4 * n + (i & 3); }

struct Unit { int pm, pn, bt; };
struct Gemm { const bf16_t* A; const bf16_t* Bt; int M, N, K; };

struct StaticOrder {
    int nM, nN, nwg, G, c;
    __host__ __device__ void init(int M, int N, int G_, int c_) { nM = M / BM; nN = N / BM; nwg = nM * nN; G = G_; c = c_; }
    __host__ __device__ bool next(int i, Unit& u) const {
        const long L = (long)i * G + c; if (L >= nwg) return false;
        int wgid = (int)L; { const int q = nwg / NXCD, r = nwg % NXCD, xcd = wgid % NXCD, off = wgid / NXCD; wgid = (xcd < r ? xcd * (q + 1) : r * (q + 1) + (xcd - r) * q) + off; }
        const int nig = WGM * nN, gid = wgid / nig, fm = gid * WGM, gsz = (nM - fm) < WGM ? (nM - fm) : WGM;
        u.pm = fm + ((wgid % nig) % gsz); u.pn = (wgid % nig) / gsz; u.bt = u.pn; return true;
    }
    __device__ __forceinline__ void a_ready(const Unit&) const {}
    __device__ __forceinline__ void done(const Unit&) const {}
};

typedef float f32x2 __attribute__((ext_vector_type(2))); typedef __bf16 bf16x2_t __attribute__((ext_vector_type(2)));
__device__ __forceinline__ unsigned cvt_pk_bf16(float lo, float hi) { const f32x2 v = {lo, hi}; const bf16x2_t b = __builtin_convertvector(v, bf16x2_t); return __builtin_bit_cast(unsigned, b); }
struct EpiInProj {
    static constexpr bool PERM = true, AFTER_DRAIN = false, HAS_MID = false;
#ifdef NO_NORMS
    static constexpr bool NORMS = false;
#else
    static constexpr bool NORMS = true;
#endif
    bf16_t *Q, *K, *V, *XR, *GY, *GATES; unsigned* qkmax;
    template <int CAT> __device__ __forceinline__ void run(const f32x4 (&acc)[2][2][4][2], bf16_t* base, int ldc, int row0, int col0, unsigned* mx) const {
        float nrm = 0.f;
#pragma unroll
        for (int ai = 0; ai < 2; ++ai)
#pragma unroll
            for (int m = 0; m < 4; ++m) { bf16_t* rowp = base + (size_t)(row0 + ai * HALF + m * 16) * ldc + col0; float ss = 0.f;
#pragma unroll
                for (int bj = 0; bj < 2; ++bj) { f32x4 v0 = acc[ai][bj][m][0], v1 = acc[ai][bj][m][1];
                    if (CAT == 0) { v0 = v0 * C2; v1 = v1 * C2; }
                    if (CAT == 4) {
#pragma unroll
                        for (int j = 0; j < 4; ++j) { v0[j] = gelu_fast(v0[j]); v1[j] = gelu_fast(v1[j]); } }
                    if (CAT == 5) {
#pragma unroll
                        for (int j = 0; j < 4; ++j) { v0[j] = sigmoid_fast(v0[j]); v1[j] = sigmoid_fast(v1[j]); } }
                    if (NORMS && CAT <= 1) ss += (v0[0] * v0[0] + v0[1] * v0[1]) + (v0[2] * v0[2] + v0[3] * v0[3]) + (v1[0] * v1[0] + v1[1] * v1[1]) + (v1[2] * v1[2] + v1[3] * v1[3]);
                    u32x4 w; w.x = cvt_pk_bf16(v0[0], v0[1]); w.y = cvt_pk_bf16(v0[2], v0[3]); w.z = cvt_pk_bf16(v1[0], v1[1]); w.w = cvt_pk_bf16(v1[2], v1[3]);
                    *(u32x4*)(rowp + bj * 32) = w; }
                if (NORMS && CAT <= 1) { ss += __shfl_xor(ss, 16); ss += __shfl_xor(ss, 32); nrm = fmaxf(nrm, ss); } }
        if (NORMS && CAT <= 1) {
#pragma unroll
            for (int o = 1; o < 16; o <<= 1) nrm = fmaxf(nrm, __shfl_xor(nrm, o));
            if ((threadIdx.x & 63) == 0) atomicMax(mx, __builtin_bit_cast(unsigned, nrm * 1.02f)); }
    }
    __device__ __forceinline__ void operator()(const f32x4 (&acc)[2][2][4][2], const Unit& u, int wr, int wc, int fr, int fq) const {
        const int pn = u.pn, row0 = u.pm * BM + wr * 64 + fr, cw = wc * 64 + 8 * fq, b = u.pm >> 5;
        if (pn < 2)       run<0>(acc, Q, 512, row0, pn * 256 + cw, qkmax + b * 16 + 0 + (pn & 1) * 4 + wc);
        else if (pn < 4)  run<1>(acc, K, 512, row0, (pn - 2) * 256 + cw, qkmax + b * 16 + 8 + (pn & 1) * 4 + wc);
        else if (pn < 6)  run<2>(acc, V, 512, row0, (pn - 4) * 256 + cw, nullptr);
        else if (pn < 8)  run<3>(acc, XR, 512, row0, (pn - 6) * 256 + cw, nullptr);
        else if (pn < 10) run<4>(acc, GY, 512, row0, (pn - 8) * 256 + cw, nullptr);
        else              run<5>(acc, GATES, 2048, row0, (pn - 10) * 256 + cw, nullptr);
    }
};
struct EpiMix {
    static constexpr bool PERM = true, AFTER_DRAIN = false, HAS_MID = true;
    const bf16_t* GATES; bf16_t* OUT;
    __device__ __forceinline__ void mid(f32x4 (&acc)[2][2][4][2], const Unit& u, int wr, int wc, int fr, int fq) const {
        int row0 = u.pm * BM + wr * 64 + fr; const int col0 = u.pn * BM + wc * 32 + 8 * fq;
        asm volatile("" : "+v"(row0));
#pragma unroll
        for (int ai = 0; ai < 2; ++ai)
#pragma unroll
            for (int m = 0; m < 4; ++m) { const bf16_t* gp = GATES + (size_t)(row0 + ai * HALF + m * 16) * 2048 + col0;
#pragma unroll
                for (int bj = 0; bj < 2; ++bj) { const u32x4 ga = *(const u32x4*)(gp + bj * HALF), gl = *(const u32x4*)(gp + 1024 + bj * HALF);
#pragma unroll
                    for (int e = 0; e < 4; ++e) { const float a0 = __builtin_bit_cast(float, ga[e] << 16), a1 = __builtin_bit_cast(float, ga[e] & 0xffff0000u);
                        const float l0 = __builtin_bit_cast(float, gl[e] << 16), l1 = __builtin_bit_cast(float, gl[e] & 0xffff0000u);
                        acc[ai][bj][m][e >> 1][(e & 1) * 2] *= a0 * __builtin_amdgcn_rcpf(l0); acc[ai][bj][m][e >> 1][(e & 1) * 2 + 1] *= a1 * __builtin_amdgcn_rcpf(l1); } }
                asm volatile("" ::: "memory"); }
    }
    __device__ __forceinline__ void operator()(const f32x4 (&acc)[2][2][4][2], const Unit& u, int wr, int wc, int fr, int fq) const {
        const int row0 = u.pm * BM + wr * 64 + fr, col0 = u.pn * BM + wc * 32 + 8 * fq;
#pragma unroll
        for (int ai = 0; ai < 2; ++ai)
#pragma unroll
            for (int m = 0; m < 4; ++m) { const size_t r = (size_t)(row0 + ai * HALF + m * 16);
#pragma unroll
                for (int bj = 0; bj < 2; ++bj) { const u32x4 gl = *(const u32x4*)(GATES + r * 2048 + 1024 + col0 + bj * HALF);
                    const f32x4 v0 = acc[ai][bj][m][0], v1 = acc[ai][bj][m][1]; u32x4 w;
                    w.x = cvt_pk_bf16(v0[0] * __builtin_bit_cast(float, gl[0] << 16), v0[1] * __builtin_bit_cast(float, gl[0] & 0xffff0000u));
                    w.y = cvt_pk_bf16(v0[2] * __builtin_bit_cast(float, gl[1] << 16), v0[3] * __builtin_bit_cast(float, gl[1] & 0xffff0000u));
                    w.z = cvt_pk_bf16(v1[0] * __builtin_bit_cast(float, gl[2] << 16), v1[1] * __builtin_bit_cast(float, gl[2] & 0xffff0000u));
                    w.w = cvt_pk_bf16(v1[2] * __builtin_bit_cast(float, gl[3] << 16), v1[3] * __builtin_bit_cast(float, gl[3] & 0xffff0000u));
                    *(u32x4*)(OUT + r * 1024 + col0 + bj * HALF) = w; }
                asm volatile("" ::: "memory"); }
    }
};
struct EpiResidF32 {
    static constexpr bool PERM = false, AFTER_DRAIN = false, HAS_MID = false;
    const float* base; float* out;
    __device__ __forceinline__ void operator()(const f32x4 (&acc)[2][2][4][2], const Unit& u, int wr, int wc, int fr, int fq) const {
        const int row0 = u.pm * BM + wr * 64 + fr, col0 = u.pn * BM + wc * 32 + 4 * fq;
#pragma unroll
        for (int ai = 0; ai < 2; ++ai)
#pragma unroll
            for (int m = 0; m < 4; ++m) { const size_t off = (size_t)(row0 + ai * HALF + m * 16) * 1024 + col0;
#pragma unroll
                for (int bj = 0; bj < 2; ++bj)
#pragma unroll
                    for (int n = 0; n < 2; ++n) *(f32x4*)(out + off + bj * HALF + n * 16) = *(const f32x4*)(base + off + bj * HALF + n * 16) + acc[ai][bj][m][n];
                asm volatile("" ::: "memory"); }
    }
};
struct MoeOrder {
    const PG8_LAS int* pad; int nunits, G, c;
    __device__ __forceinline__ void init(const PG8_LAS int* pad_, int G_, int c_) { pad = pad_; nunits = (pad_[32] >> 8) * 4; G = G_; c = c_; }
    __device__ __forceinline__ bool next(int i, Unit& u) const {
        const int L = i * G + c; if (L >= nunits) return false;
        const int tile = L >> 2, pn = L & 3, slot = tile << 8; int e = 0;
        for (int j = 1; j < 32; ++j) e += (pad[j] <= slot) ? 1 : 0;
        u.pm = tile; u.pn = pn; u.bt = e * 4 + pn; return true;
    }
    __device__ __forceinline__ void a_ready(const Unit&) const {}
    __device__ __forceinline__ void done(const Unit&) const {}
};
struct EpiSwiGLU {
    static constexpr bool PERM = true, AFTER_DRAIN = false, HAS_MID = false;
    bf16_t* H;
    __device__ __forceinline__ void operator()(const f32x4 (&acc)[2][2][4][2], const Unit& u, int wr, int wc, int fr, int fq) const {
        const int row0 = u.pm * BM + wr * 64 + fr, col0 = u.pn * HALF + wc * 32 + 8 * fq;
#pragma unroll
        for (int ai = 0; ai < 2; ++ai)
#pragma unroll
            for (int m = 0; m < 4; ++m) { float h[8];
#pragma unroll
                for (int n = 0; n < 2; ++n)
#pragma unroll
                    for (int e = 0; e < 4; ++e) { const float g = acc[ai][0][m][n][e], up = acc[ai][1][m][n][e]; h[n * 4 + e] = g * sigmoid_fast(g) * up; }
                u32x4 w; w.x = cvt_pk_bf16(h[0], h[1]); w.y = cvt_pk_bf16(h[2], h[3]); w.z = cvt_pk_bf16(h[4], h[5]); w.w = cvt_pk_bf16(h[6], h[7]);
                *(u32x4*)(H + (size_t)(row0 + ai * HALF + m * 16) * 512 + col0) = w; }
    }
};
struct EpiStoreBf16 {
    static constexpr bool PERM = true, AFTER_DRAIN = false, HAS_MID = false;
    bf16_t* O; int ldc;
    __device__ __forceinline__ void operator()(const f32x4 (&acc)[2][2][4][2], const Unit& u, int wr, int wc, int fr, int fq) const {
        const int row0 = u.pm * BM + wr * 64 + fr, col0 = u.pn * BM + wc * 32 + 8 * fq;
#pragma unroll
        for (int ai = 0; ai < 2; ++ai)
#pragma unroll
            for (int m = 0; m < 4; ++m) { bf16_t* rowp = O + (size_t)(row0 + ai * HALF + m * 16) * ldc + col0;
#pragma unroll
                for (int bj = 0; bj < 2; ++bj) { const f32x4 v0 = acc[ai][bj][m][0], v1 = acc[ai][bj][m][1]; u32x4 w;
                    w.x = cvt_pk_bf16(v0[0], v0[1]); w.y = cvt_pk_bf16(v0[2], v0[3]); w.z = cvt_pk_bf16(v1[0], v1[1]); w.w = cvt_pk_bf16(v1[2], v1[3]);
                    *(u32x4*)(rowp + bj * HALF) = w; } }
    }
};
template <class Epi, class Sched, bool ALIGN_EPI = false, bool SP2 = false>
__device__ __forceinline__ void gemm_phase(PG8_LAS unsigned char* lds, const Gemm g, const Sched& S, const Epi& E) {
    int tid_ = threadIdx.x; asm volatile("" : "+v"(tid_));
    const int tid = tid_, wid = __builtin_amdgcn_readfirstlane(tid >> 6), lane = tid & 63, wr = wid >> 2, wc = wid & 3, fr = lane & 15, fq = lane >> 4;
    const int K = g.K, nt = K / BK;
    unsigned voffA[2], voffB[2];
#pragma unroll
    for (int i = 0; i < 2; ++i) { int R, C; stage_rc(tid * 16 + i * 8192, R, C); const int Rb = Epi::PERM ? ((R & ~31) + perm32(R & 31)) : R;
        voffA[i] = (unsigned)(R * K + C) * 2u; voffB[i] = (unsigned)(Rb * K + C) * 2u; }
    const size_t kstep = (size_t)(BK * 2);
    const size_t hstep = (size_t)HALF * K * 2;
    const size_t tstep = 2 * hstep;
    const unsigned ldsw = (unsigned)wid * 1024u;
    const int aoff = lds_byte(wr * 64 + fr, fq * 8), boff = lds_byte(wc * 32 + fr, fq * 8);
#define PG8_SA(b, h) (((b) * 2 + (h)) * HTB)
#define PG8_SB(b, h) ((4 + (b) * 2 + (h)) * HTB)
#define PG8_STAGE(bufoff, gbase, voff) do { _Pragma("unroll") for (int _i = 0; _i < 2; ++_i) \
        __builtin_amdgcn_global_load_lds((const unsigned*)((const char*)(gbase) + (voff)[_i]), (PG8_LAS unsigned*)(lds + (bufoff) + ldsw + _i * 8192), 16, 0, 0); } while (0)
#define PG8_LDA(dst, b, h) do { _Pragma("unroll") for (int m = 0; m < 4; ++m) _Pragma("unroll") for (int k = 0; k < 2; ++k) dst[m][k] = *(const PG8_LAS bf16x8*)(lds + PG8_SA(b, h) + aoff + m * 2048 + k * 1024); } while (0)
#define PG8_LDB(dst, b, h) do { _Pragma("unroll") for (int n = 0; n < 2; ++n) _Pragma("unroll") for (int k = 0; k < 2; ++k) dst[n][k] = *(const PG8_LAS bf16x8*)(lds + PG8_SB(b, h) + boff + n * 2048 + k * 1024); } while (0)
#define PG8_MMA(ai, bj, At, Bt) do { __builtin_amdgcn_s_setprio(1); _Pragma("unroll") for (int m = 0; m < 4; ++m) _Pragma("unroll") for (int n = 0; n < 2; ++n) _Pragma("unroll") for (int k = 0; k < 2; ++k) \
        acc[ai][bj][m][n] = __builtin_amdgcn_mfma_f32_16x16x32_bf16(Bt[n][k], At[m][k], acc[ai][bj][m][n], 0, 0, 0); __builtin_amdgcn_s_setprio(0); } while (0)
#define PG8_WAIT_V(n) asm volatile("s_waitcnt vmcnt(" #n ")" ::: "memory")
#define PG8_WAIT_L(n) asm volatile("s_waitcnt lgkmcnt(" #n ")" ::: "memory")
#define PG8_BAR __builtin_amdgcn_s_barrier()
#define PG8_SCHED __builtin_amdgcn_sched_barrier(0)
    Unit cur, nxt; int ui = 0;
    if (!S.next(0, cur)) return;
    f32x4 acc[2][2][4][2];
#pragma unroll
    for (int a = 0; a < 2; ++a)
#pragma unroll
        for (int b = 0; b < 2; ++b)
#pragma unroll
            for (int m = 0; m < 4; ++m)
#pragma unroll
                for (int n = 0; n < 2; ++n) acc[a][b][m][n] = (f32x4){0.f, 0.f, 0.f, 0.f};
    bf16x8 At[4][2], B0[2][2], B1[2][2];
    const char* cA = (const char*)g.A + (size_t)cur.pm * tstep; const char* cB = (const char*)g.Bt + (size_t)cur.bt * tstep;
    S.a_ready(cur);
    if constexpr (SP2) {
        PG8_STAGE(PG8_SB(0, 0), cB, voffB); PG8_STAGE(PG8_SB(0, 1), cB + hstep, voffB); PG8_STAGE(PG8_SA(0, 0), cA, voffA); PG8_STAGE(PG8_SA(0, 1), cA + hstep, voffA);
        if (wr == 1) PG8_BAR;
        PG8_WAIT_V(2); PG8_BAR;
        PG8_STAGE(PG8_SB(1, 0), cB + kstep, voffB); PG8_STAGE(PG8_SA(1, 0), cA + kstep, voffA); PG8_STAGE(PG8_SB(1, 1), cB + hstep + kstep, voffB);
        PG8_WAIT_V(6); PG8_BAR;
    } else {
        PG8_STAGE(PG8_SB(0, 0), cB, voffB); PG8_STAGE(PG8_SA(0, 0), cA, voffA); PG8_STAGE(PG8_SB(0, 1), cB + hstep, voffB); PG8_STAGE(PG8_SA(0, 1), cA + hstep, voffA);
        if (wr == 1) PG8_BAR;
        PG8_WAIT_V(4); PG8_BAR;
        PG8_STAGE(PG8_SB(1, 0), cB + kstep, voffB); PG8_STAGE(PG8_SA(1, 0), cA + kstep, voffA); PG8_STAGE(PG8_SB(1, 1), cB + hstep + kstep, voffB);
        PG8_WAIT_V(6); PG8_BAR;
    }
    for (;;) {
        const bool has_next = S.next(ui + 1, nxt);
        const char* nA = has_next ? (const char*)g.A + (size_t)nxt.pm * tstep : cA; const char* nB = has_next ? (const char*)g.Bt + (size_t)nxt.bt * tstep : cB;
        for (int t = 0; t < nt; t += 2) {
            const bool last = (t == nt - 2);
            if constexpr (Epi::HAS_MID) { if (t == (nt >> 1)) E.mid(acc, cur, wr, wc, fr, fq); }
            const char* a1 = cA + (size_t)(t + 1) * kstep;
            const char* a2 = last ? nA : cA + (size_t)(t + 2) * kstep; const char* b2 = last ? nB : cB + (size_t)(t + 2) * kstep;
            const char* a3 = a2 + kstep; const char* b3 = b2 + kstep;
            if (last && has_next) S.a_ready(nxt);
            if constexpr (SP2) {
            PG8_LDB(B0, 0, 0); PG8_LDB(B1, 0, 1); PG8_SCHED; PG8_LDA(At, 0, 0); PG8_STAGE(PG8_SA(1, 1), a1 + hstep, voffA);
            PG8_WAIT_V(8); PG8_WAIT_L(0); PG8_BAR; PG8_MMA(0, 0, At, B0); PG8_MMA(0, 1, At, B1); PG8_BAR; PG8_SCHED;
            PG8_LDA(At, 0, 1); PG8_STAGE(PG8_SB(0, 0), b2, voffB); PG8_STAGE(PG8_SB(0, 1), b2 + hstep, voffB); PG8_STAGE(PG8_SA(0, 0), a2, voffA);
            PG8_WAIT_V(8); PG8_WAIT_L(0); PG8_BAR; PG8_MMA(1, 0, At, B0); PG8_MMA(1, 1, At, B1); PG8_BAR; PG8_SCHED;
            PG8_LDB(B0, 1, 0); PG8_LDB(B1, 1, 1); PG8_SCHED; PG8_LDA(At, 1, 0); PG8_STAGE(PG8_SA(0, 1), a2 + hstep, voffA);
            PG8_WAIT_V(8); PG8_WAIT_L(0); PG8_BAR; PG8_MMA(0, 0, At, B0); PG8_MMA(0, 1, At, B1); PG8_BAR; PG8_SCHED;
            PG8_LDA(At, 1, 1); PG8_STAGE(PG8_SB(1, 0), b3, voffB); PG8_STAGE(PG8_SB(1, 1), b3 + hstep, voffB); PG8_STAGE(PG8_SA(1, 0), a3, voffA);
            PG8_WAIT_V(8); PG8_WAIT_L(0); PG8_BAR; PG8_MMA(1, 0, At, B0); PG8_MMA(1, 1, At, B1); PG8_BAR; PG8_SCHED;
            } else {
            PG8_LDB(B0, 0, 0); PG8_SCHED; PG8_LDA(At, 0, 0); PG8_STAGE(PG8_SA(1, 1), a1 + hstep, voffA);
            PG8_WAIT_L(8); PG8_BAR; PG8_WAIT_L(0); PG8_MMA(0, 0, At, B0); PG8_BAR; PG8_SCHED;
            PG8_LDB(B1, 0, 1); PG8_STAGE(PG8_SB(0, 0), b2, voffB);
            PG8_BAR; PG8_WAIT_L(0); PG8_MMA(0, 1, At, B1); PG8_BAR;
            PG8_LDA(At, 0, 1); PG8_STAGE(PG8_SA(0, 0), a2, voffA);
            PG8_BAR; PG8_WAIT_L(0); PG8_MMA(1, 0, At, B0); PG8_BAR; PG8_SCHED;
            PG8_STAGE(PG8_SB(0, 1), b2 + hstep, voffB);
            PG8_WAIT_V(6); PG8_BAR; PG8_MMA(1, 1, At, B1); PG8_BAR;
            PG8_LDB(B0, 1, 0); PG8_SCHED; PG8_LDA(At, 1, 0); PG8_STAGE(PG8_SA(0, 1), a2 + hstep, voffA);
            PG8_WAIT_L(8); PG8_BAR; PG8_WAIT_L(0); PG8_MMA(0, 0, At, B0); PG8_BAR; PG8_SCHED;
            PG8_LDB(B1, 1, 1); PG8_STAGE(PG8_SB(1, 0), b3, voffB);
            PG8_BAR; PG8_WAIT_L(0); PG8_MMA(0, 1, At, B1); PG8_BAR;
            PG8_LDA(At, 1, 1); PG8_STAGE(PG8_SA(1, 0), a3, voffA);
            PG8_BAR; PG8_WAIT_L(0); PG8_MMA(1, 0, At, B0); PG8_BAR; PG8_SCHED;
            PG8_STAGE(PG8_SB(1, 1), b3 + hstep, voffB);
            PG8_WAIT_V(6); PG8_BAR; PG8_MMA(1, 1, At, B1); PG8_BAR;
            }
        }
        if constexpr (ALIGN_EPI) { if (wr == 0) PG8_BAR; }
        if constexpr (!Epi::AFTER_DRAIN) { E(acc, cur, wr, wc, fr, fq); S.done(cur); }
        if (!has_next) break;
#pragma unroll
        for (int a = 0; a < 2; ++a)
#pragma unroll
            for (int b = 0; b < 2; ++b)
#pragma unroll
                for (int m = 0; m < 4; ++m)
#pragma unroll
                    for (int n = 0; n < 2; ++n) acc[a][b][m][n] = (f32x4){0.f, 0.f, 0.f, 0.f};
        cur = nxt; cA = nA; cB = nB; ++ui;
        if constexpr (ALIGN_EPI) { if (wr == 1) PG8_BAR; }
    }
    PG8_WAIT_V(0);
    if constexpr (!ALIGN_EPI) { if (wr == 0) PG8_BAR; }
    PG8_BAR;
    if constexpr (Epi::AFTER_DRAIN) { E.fused(acc, cur, wr, wc, fr, fq, lds, wid, lane); S.done(cur); }
#undef PG8_SA
#undef PG8_SB
#undef PG8_STAGE
#undef PG8_LDA
#undef PG8_LDB
#undef PG8_MMA
#undef PG8_WAIT_V
#undef PG8_WAIT_L
#undef PG8_BAR
#undef PG8_SCHED
}
}
#define GAS __attribute__((address_space(1)))
#define LAS __attribute__((address_space(3)))
typedef unsigned v4u __attribute__((ext_vector_type(4)));
typedef float f32x4 __attribute__((ext_vector_type(4)));
typedef short bf16x8 __attribute__((ext_vector_type(8)));
typedef GAS unsigned gu32;
typedef GAS unsigned long long gu64;
#define RLX_AGENT __ATOMIC_RELAXED, __HIP_MEMORY_SCOPE_AGENT
#define LDS_WAIT() asm volatile("s_waitcnt lgkmcnt(0)" ::: "memory")
#define VM_WAIT() asm volatile("s_waitcnt vmcnt(0)" ::: "memory")
#define XB_TMO      128
#define XB_XCNT(j)  (256  + 64 * (j))
#define XB_XSUB(j)  (1280 + 64 * (j))
#define XB_XGEN(j)  (2304 + 64 * (j))
#define XB_TOP      3328
#define XB_TOPGEN   3392
#define XCD_BAR_WORDS 3456
#define XB_SPIN_CAP (1u << 18)

__device__ __forceinline__ unsigned xb_ld(unsigned* p)              { return __hip_atomic_load(p, __ATOMIC_RELAXED, __HIP_MEMORY_SCOPE_AGENT); }
__device__ __forceinline__ unsigned xb_add(unsigned* p, unsigned v) { return __hip_atomic_fetch_add(p, v, __ATOMIC_RELAXED, __HIP_MEMORY_SCOPE_AGENT); }
__device__ __forceinline__ unsigned xb_xcc_id() { return (unsigned)__builtin_amdgcn_s_getreg((3 << 11) | 20) & 0xFu; }
#define XB_SPIN(cond, bar) do { unsigned _sp = 0; while (cond) { __builtin_amdgcn_s_sleep(1); \
    if ((++_sp & 255u) == 0u) { if (xb_ld(&(bar)[XB_TMO])) break; if (_sp > XB_SPIN_CAP) { atomicAdd(&(bar)[XB_TMO], 1u); break; } } } } while (0)

struct XcdBarrier {
    unsigned* bar; unsigned x;
    volatile LAS unsigned* st;
};

__device__ __forceinline__ XcdBarrier xcd_barrier_post(unsigned* bar, volatile LAS unsigned* st) {
    XcdBarrier b; b.bar = bar; b.x = xb_xcc_id(); b.st = st;
    if (threadIdx.x == 0) (void)xb_add(&bar[XB_XCNT(b.x)], 1u);
    return b;
}
__device__ __forceinline__ void xcd_barrier_complete(unsigned* bar, unsigned x, unsigned& nloc, unsigned& nx) {
    const unsigned G = gridDim.x * gridDim.y * gridDim.z;
    unsigned sum, cnt, mine, sp = 0u;
    for (;;) {
        sum = 0u; cnt = 0u; mine = 0u;
#pragma unroll
        for (unsigned j = 0; j < 16; ++j) { const unsigned c = xb_ld(&bar[XB_XCNT(j)]); sum += c; cnt += (c > 0u) ? 1u : 0u; mine = (j == x) ? c : mine; }
        if (sum == G) break;
        __builtin_amdgcn_s_sleep(1);
        if ((++sp & 255u) == 0u) { if (xb_ld(&bar[XB_TMO])) break; if (sp > XB_SPIN_CAP) { atomicAdd(&bar[XB_TMO], 1u); break; } }
    }
    nloc = mine > 0u ? mine : 1u; nx = cnt > 0u ? cnt : 1u;
}

__device__ __forceinline__ void xcd_barrier(const XcdBarrier& b) {
    asm volatile("s_waitcnt vmcnt(0)" ::: "memory");
    __syncthreads();
    if (threadIdx.x == 0) {
        unsigned* bar = b.bar;
        __builtin_amdgcn_s_waitcnt(0);
        unsigned nloc = b.st[0], nx = b.st[1];
        if (nloc == 0u) { xcd_barrier_complete(bar, b.x, nloc, nx); b.st[0] = nloc; b.st[1] = nx; }
        const unsigned old = xb_add(&bar[XB_XSUB(b.x)], 1u);
        const unsigned gen = old / nloc;
        if (old + 1u == (gen + 1u) * nloc) {
            __builtin_amdgcn_fence(__ATOMIC_RELEASE, "agent");
            asm volatile("s_waitcnt vmcnt(0)" ::: "memory");
            const unsigned og = xb_add(&bar[XB_TOP], 1u);
            const unsigned tg = og / nx;
            if (og + 1u == (tg + 1u) * nx) xb_add(&bar[XB_TOPGEN], 1u);
            else XB_SPIN(xb_ld(&bar[XB_TOPGEN]) == tg, bar);
            __builtin_amdgcn_fence(__ATOMIC_ACQUIRE, "agent");
            xb_add(&bar[XB_XGEN(b.x)], 1u);
            asm volatile("s_waitcnt vmcnt(0)" ::: "memory");
        } else {
            XB_SPIN(xb_ld(&bar[XB_XGEN(b.x)]) == gen, bar);
            __builtin_amdgcn_fence(__ATOMIC_ACQUIRE, "agent");
            asm volatile("s_waitcnt vmcnt(0)" ::: "memory");
        }
    }
    __syncthreads();
}

constexpr int NWAVES = 8;
constexpr int RING_OFF = 0, RING_BYTES = 131072;
constexpr int SCR_BYTES = 147456;
constexpr int LDSCTL_OFF = SCR_BYTES, MISC_OFF = LDSCTL_OFF + 320;
constexpr int LDS_BYTES = SCR_BYTES + 4096;
static_assert(MISC_OFF + 128 <= LDS_BYTES && LDS_BYTES <= 163840, "LDS map");

struct Frame {
    LAS unsigned char* lds;
    volatile LAS unsigned* MISC;
    gu32* ctl;
    int tid, lane, wave, vcu, G;
    const float* in[22]; float* out; unsigned char* ws;
};
__device__ __forceinline__ float wave_sum(float v) {
#pragma unroll
    for (int o = 1; o < 64; o <<= 1) v += __shfl_xor(v, o);
    return v;
}

__device__ __forceinline__ void p0_tr64(const float* W, int ldn, int k0, int n0, bf16* dst, int ldk, LAS float* scr, int lane) {
    const int lr = lane >> 4, lc = (lane & 15) * 4;
    f32x4 v[16];
#pragma unroll
    for (int i = 0; i < 16; ++i) v[i] = *(const GAS f32x4*)(W + (size_t)(k0 + 4 * i + lr) * ldn + n0 + lc);
#pragma unroll
    for (int i = 0; i < 16; ++i) { LAS float* s = scr + (4 * i + lr) * 65 + lc; s[0] = v[i][0]; s[1] = v[i][1]; s[2] = v[i][2]; s[3] = v[i][3]; }
    LDS_WAIT(); asm volatile("" ::: "memory");
    const int c = lane & 7;
#pragma unroll
    for (int j = 0; j < 8; ++j) { const int n = (lane >> 3) + 8 * j; const LAS float* s = scr + (8 * c) * 65 + n;
        v4u o; o.x = pk2(s[0 * 65], s[1 * 65]); o.y = pk2(s[2 * 65], s[3 * 65]); o.z = pk2(s[4 * 65], s[5 * 65]); o.w = pk2(s[6 * 65], s[7 * 65]);
        *(GAS v4u*)(dst + (size_t)n * ldk + 8 * c) = o; }
    LDS_WAIT(); asm volatile("" ::: "memory");
}
__device__ __forceinline__ int incol_row(int c) { const int w = c & 255; return (c & ~255) + ((w >> 5) & 1) * 128 + (w >> 6) * 32 + (w & 31); }

constexpr int I_IN = 16 * 72, I_OA = 8 * 16, I_OL = 8 * 16, I_OUT = 16 * 16, I_G = 32 * 16 * 8, I_U = I_G, I_D = 32 * 8 * 16;
constexpr int NITEMS = I_IN + I_OA + I_OL + I_OUT + I_G + I_U + I_D;
constexpr int NCONV_BATCH = (NITEMS - I_IN + NWAVES - 1) / NWAVES;
__device__ __forceinline__ void conv_item(Frame& F, int it, LAS float* scr, int lane) {
    bf16* Wt_in = (bf16*)(F.ws + WS_WIN); bf16* Wt_mix = (bf16*)(F.ws + WS_WMIX); bf16* Wt_out = (bf16*)(F.ws + WS_WOUT); bf16* Wt_gu = (bf16*)(F.ws + WS_WGU); bf16* Wt_d = (bf16*)(F.ws + WS_WD);
    int r = it;
    if (r < I_IN) { const int kb = r / 72, nb = r % 72, n0 = nb * 64;
        const int lr = lane >> 4, lc = (lane & 15) * 4; const float* W = F.in[2];
        f32x4 v[16];
#pragma unroll
        for (int i = 0; i < 16; ++i) v[i] = *(const GAS f32x4*)(W + (size_t)(kb * 64 + 4 * i + lr) * INC + n0 + lc);
#pragma unroll
        for (int i = 0; i < 16; ++i) { LAS float* s = scr + (4 * i + lr) * 65 + lc; s[0] = v[i][0]; s[1] = v[i][1]; s[2] = v[i][2]; s[3] = v[i][3]; }
        LDS_WAIT(); asm volatile("" ::: "memory");
        const int c = lane & 7;
#pragma unroll
        for (int j = 0; j < 8; ++j) { const int n = (lane >> 3) + 8 * j; const LAS float* s = scr + (8 * c) * 65 + n;
            v4u o; o.x = pk2(s[0 * 65], s[1 * 65]); o.y = pk2(s[2 * 65], s[3 * 65]); o.z = pk2(s[4 * 65], s[5 * 65]); o.w = pk2(s[6 * 65], s[7 * 65]);
            *(GAS v4u*)(Wt_in + (size_t)incol_row(n0 + n) * 1024 + kb * 64 + 8 * c) = o; }
        LDS_WAIT(); asm volatile("" ::: "memory");
        return; } r -= I_IN;
    if (r < I_OA) { const int kb = r / 16, nb = r % 16; p0_tr64(F.in[12], 1024, kb * 64, nb * 64, Wt_mix + (size_t)(nb * 64) * 1024 + kb * 64, 1024, scr, lane); return; } r -= I_OA;
    if (r < I_OL) { const int kb = r / 16, nb = r % 16; p0_tr64(F.in[13], 1024, kb * 64, nb * 64, Wt_mix + (size_t)(nb * 64) * 1024 + 512 + kb * 64, 1024, scr, lane); return; } r -= I_OL;
    if (r < I_OUT) { const int kb = r / 16, nb = r % 16; p0_tr64(F.in[14], 1024, kb * 64, nb * 64, Wt_out + (size_t)(nb * 64) * 1024 + kb * 64, 1024, scr, lane); return; } r -= I_OUT;
    if (r < I_G) { const int e = r / 128, q = r % 128, kb = q / 8, nb = q % 8, n0 = nb * 64;
        p0_tr64(F.in[18] + (size_t)e * 1024 * 512, 512, kb * 64, n0, Wt_gu + (size_t)(e * 1024 + (n0 >> 7) * 256 + (n0 & 127)) * 1024 + kb * 64, 1024, scr, lane); return; } r -= I_G;
    if (r < I_U) { const int e = r / 128, q = r % 128, kb = q / 8, nb = q % 8, n0 = nb * 64;
        p0_tr64(F.in[19] + (size_t)e * 1024 * 512, 512, kb * 64, n0, Wt_gu + (size_t)(e * 1024 + (n0 >> 7) * 256 + 128 + (n0 & 127)) * 1024 + kb * 64, 1024, scr, lane); return; } r -= I_U;
    { const int e = r / 128, q = r % 128, kb = q / 16, nb = q % 16;
        p0_tr64(F.in[20] + (size_t)e * 512 * 1024, 1024, kb * 64, nb * 64, Wt_d + (size_t)(e * 1024 + nb * 64) * 512 + kb * 64, 512, scr, lane); }
}
__device__ __forceinline__ void conv_batch(Frame& F, int c) {
    const int it = I_IN + c * NWAVES + F.wave;
    int lane = F.lane; asm volatile("" : "+v"(lane));
    if (it < NITEMS) conv_item(F, it, (LAS float*)(F.lds + F.wave * 16640), lane);
}
__device__ __forceinline__ void p0_prologue(Frame& F) {
    LAS float* scr = (LAS float*)(F.lds + F.wave * 16640);
    const int gw = F.vcu * NWAVES + F.wave, NGW = F.G * NWAVES, lane = F.lane;
#ifdef CONV_ALL_IN_P0
    for (int it = gw; it < NITEMS; it += NGW) conv_item(F, it, scr, lane);
#else
    for (int it = gw; it < I_IN; it += NGW) conv_item(F, it, scr, lane);
#endif
    { bf16* WER = (bf16*)(F.ws + WS_MISC + 1536 * 1024); const float* gf = F.in[15];
      for (int idx = gw * 64 + lane; idx < 36 * 1024; idx += NGW * 64) { const int row = idx >> 10, k = idx & 1023;
          const float w = (row < 32 ? F.in[17][(size_t)(row >> 3) * 8192 + k * 8 + (row & 7)] : F.in[16][k * 4 + (row - 32)]) * gf[k];
          const unsigned h = f2bf(w), l = f2bf(w - __builtin_bit_cast(float, h << 16));
          const int pos = row * 1024 + ((((k >> 3) ^ (row & 15))) << 3) + (k & 7);
          WER[pos] = (bf16)h; WER[36 * 1024 + pos] = (bf16)l; } }
    bf16* XN = (bf16*)(F.ws + WS_XN); const float* x = F.in[0]; const float* g = F.in[1];
    f32x4 gv[4];
#pragma unroll
    for (int j = 0; j < 4; ++j) gv[j] = ((const GAS f32x4*)g)[lane + 64 * j];
    for (int m = gw; m < NTOK; m += NGW) {
        const GAS f32x4* xr = (const GAS f32x4*)(x + (size_t)m * DM) + lane;
        f32x4 v[4]; float s = 0.f;
#pragma unroll
        for (int j = 0; j < 4; ++j) { v[j] = xr[64 * j]; s += (v[j].x * v[j].x + v[j].y * v[j].y) + (v[j].z * v[j].z + v[j].w * v[j].w); }
        const float rstd = rsqrtf(wave_sum(s) * (1.f / DM) + EPS);
        GAS unsigned long long* o8 = (GAS unsigned long long*)(XN + (size_t)m * DM) + lane;
#pragma unroll
        for (int j = 0; j < 4; ++j) o8[64 * j] = (unsigned long long)pk2(v[j].x * rstd * gv[j].x, v[j].y * rstd * gv[j].y) | ((unsigned long long)pk2(v[j].z * rstd * gv[j].z, v[j].w * rstd * gv[j].w) << 32);
    }
}

namespace att {
typedef float f32x16 __attribute__((ext_vector_type(16)));
typedef short s16x4 __attribute__((ext_vector_type(4)));
typedef short v4i16_t __attribute__((ext_vector_type(4)));
constexpr int KROW = 128;
constexpr int KT = 64 * KROW;
constexpr int STAGE = 2 * KT + 16384;
constexpr int VOFF = 2 * KT;
constexpr int CW_AQ = 192;
constexpr float WIN_T = 40.f;
__device__ __forceinline__ s16x4 vtr(const LAS unsigned char* p) { return __builtin_bit_cast(s16x4, __builtin_amdgcn_ds_read_tr16_b64_v4i16((LAS v4i16_t*)p)); }

struct RowState { float mrun, lrun; };
template <int ABL> __device__ __forceinline__ void soft_tile(const LAS unsigned char* lds, int ko, const bf16x8 (&qr)[4], int t, int qpos, int qmin, int hi, float slope2, RowState& st, f32x16 (&o)[4], bf16x8 (&pa)[4]) {
    f32x16 p0, p1;
#pragma unroll
    for (int r = 0; r < 16; ++r) { p0[r] = 0.f; p1[r] = 0.f; }
#pragma unroll
    for (int d0 = 0; d0 < 4; ++d0) {
        const LAS unsigned char* kq = lds + (ko ^ (d0 * 32));
        const bf16x8 k0 = *(const LAS bf16x8*)(kq);
        const bf16x8 k1 = *(const LAS bf16x8*)(kq + 32 * KROW);
        if (ABL & 4) { if (d0 == 0) { p0[0] = (float)k0[0]; p1[0] = (float)k1[0]; } continue; }
        p0 = __builtin_amdgcn_mfma_f32_32x32x16_bf16(k0, qr[d0], p0, 0, 0, 0);
        p1 = __builtin_amdgcn_mfma_f32_32x32x16_bf16(k1, qr[d0], p1, 0, 0, 0);
    }
    if (ABL & 1) {
#pragma unroll
        for (int s = 0; s < 4; ++s) { v4u w;
#pragma unroll
            for (int e = 0; e < 4; ++e) { const int r = 8 * (s & 1) + 2 * e; w[e] = (s < 2) ? pg8::cvt_pk_bf16(p0[r], p0[r + 1]) : pg8::cvt_pk_bf16(p1[r], p1[r + 1]); }
            pa[s] = __builtin_bit_cast(bf16x8, w); }
        st.lrun += 1.f; return; }
    const float bb = slope2 * (float)(64 * t + 4 * hi - qpos);
    float rm = -1e30f;
    if (64 * t + 63 > qmin) {
#pragma unroll
        for (int r = 0; r < 16; ++r) { const int kk = (r & 3) + 8 * (r >> 2), key = 64 * t + 4 * hi + kk;
            float x0 = p0[r] + (bb + slope2 * (float)kk), x1 = p1[r] + (bb + slope2 * (float)(kk + 32));
            if (key > qpos) x0 = -1e30f; if (key + 32 > qpos) x1 = -1e30f;
            p0[r] = x0; p1[r] = x1; rm = fmaxf(rm, fmaxf(x0, x1)); }
    } else {
#pragma unroll
        for (int r = 0; r < 16; ++r) { const int kk = (r & 3) + 8 * (r >> 2);
            const float x0 = p0[r] + (bb + slope2 * (float)kk), x1 = p1[r] + (bb + slope2 * (float)(kk + 32));
            p0[r] = x0; p1[r] = x1; rm = fmaxf(rm, fmaxf(x0, x1)); }
    }
    rm = fmaxf(rm, __shfl_xor(rm, 32));
    const float mnew = fmaxf(st.mrun, rm);
    if (__any(mnew > st.mrun)) {
        const float alpha = __builtin_amdgcn_exp2f(st.mrun - mnew);
        st.lrun *= alpha;
#pragma unroll
        for (int vb = 0; vb < 4; ++vb)
#pragma unroll
            for (int r = 0; r < 16; ++r) o[vb][r] *= alpha;
        st.mrun = mnew;
    }
    const float mref = st.mrun;
    float ls = 0.f;
#pragma unroll
    for (int r = 0; r < 16; ++r) { p0[r] = __builtin_amdgcn_exp2f(p0[r] - mref); p1[r] = __builtin_amdgcn_exp2f(p1[r] - mref); ls += p0[r] + p1[r]; }
    st.lrun += ls;
#pragma unroll
    for (int s = 0; s < 4; ++s) { v4u w;
#pragma unroll
        for (int e = 0; e < 4; ++e) { const int r = 8 * (s & 1) + 2 * e; w[e] = (s < 2) ? pg8::cvt_pk_bf16(p0[r], p0[r + 1]) : pg8::cvt_pk_bf16(p1[r], p1[r + 1]); }
        pa[s] = __builtin_bit_cast(bf16x8, w); }
}
template <int ABL> __device__ __forceinline__ void pv_tile(const LAS unsigned char* vp, const bf16x8 (&pa)[4], f32x16 (&o)[4]) {
    if (ABL & 2) { o[0][0] += (float)pa[0][0]; return; }
#pragma unroll
    for (int vb = 0; vb < 4; ++vb)
#pragma unroll
        for (int s = 0; s < 4; ++s) {
            const s16x4 lo = vtr(vp + vb * 4096 + s * 1024), hh = vtr(vp + vb * 4096 + s * 1024 + 512);
            const bf16x8 vf = (bf16x8){lo[0], lo[1], lo[2], lo[3], hh[0], hh[1], hh[2], hh[3]};
            o[vb] = __builtin_amdgcn_mfma_f32_32x32x16_bf16(vf, pa[s], o[vb], 0, 0, 0);
        }
}

template <int ABL> __device__ __forceinline__ void attn_unit(Frame& F, int b, int h, int qblk, float lam, bf16* AL, int ldo) {
    int lane_ = F.lane; asm volatile("" : "+v"(lane_));
    const int lane = lane_, wid = F.wave, r32 = lane & 31, hi = lane >> 5;
    const int m = wid >> 2, j4 = wid & 3;
    const bf16* Qb = (const bf16*)(F.ws + WS_Q); const bf16* Kb = (const bf16*)(F.ws + WS_K); const bf16* Vb = (const bf16*)(F.ws + WS_V);
    LAS unsigned char* lds = F.lds;
    const size_t rowbase = (size_t)b * SEQ;
    const int qpos = qblk * 128 + j4 * 32 + r32;
    const int qmin = qblk * 128 + j4 * 32;
    const float slope2 = __builtin_amdgcn_exp2f(-2.f * (float)(h + 1)) * LOG2E;
    int tlo_w, t_lo;
    { const float q0 = __uint_as_float(__hip_atomic_load(F.ctl + CW_QKMAX + b * 16 + h * 2, RLX_AGENT)), k0 = __uint_as_float(__hip_atomic_load(F.ctl + CW_QKMAX + b * 16 + 8 + h * 2, RLX_AGENT));
      const float q1 = __uint_as_float(__hip_atomic_load(F.ctl + CW_QKMAX + b * 16 + h * 2 + 1, RLX_AGENT)), k1 = __uint_as_float(__hip_atomic_load(F.ctl + CW_QKMAX + b * 16 + 8 + h * 2 + 1, RLX_AGENT));
      const float d0 = (2.f * sqrtf(q0 * k0) + WIN_T) / slope2, d1 = (2.f * sqrtf(q1 * k1) + WIN_T) / slope2;
      const int w0 = (int)fminf(d0, 16384.f), w1 = (int)fminf(d1, 16384.f);
      const int s0 = qblk * 128 - w0 - 1, s1 = qblk * 128 - w1 - 1;
      const int tl0 = s0 > 0 ? s0 >> 6 : 0, tl1 = s1 > 0 ? s1 >> 6 : 0;
      t_lo = __builtin_amdgcn_readfirstlane(tl0 < tl1 ? tl0 : tl1);
      const int sw = qmin - (m ? w1 : w0) - 1; const int tw = sw > 0 ? sw >> 6 : 0;
      tlo_w = __builtin_amdgcn_readfirstlane(tw); }
    bf16x8 qr[4];
#pragma unroll
    for (int d0 = 0; d0 < 4; ++d0) qr[d0] = *(const GAS bf16x8*)(Qb + (rowbase + qpos) * 512 + h * 128 + m * 64 + d0 * 16 + hi * 8);
    const bf16* ksrc; const bf16* vsrc0; const bf16* vsrc1;
    { const int row = 8 * wid + (lane >> 3), c = (lane & 7) ^ ((row >> 1) & 7);
      ksrc = Kb + (rowbase + row) * 512 + h * 128 + c * 8;
      const int q0 = 2 * wid, q1 = 2 * wid + 1;
      vsrc0 = Vb + (rowbase + 16 * (q0 & 3) + (lane >> 2)) * 512 + h * 128 + (q0 >> 2) * 32 + (lane & 3) * 8;
      vsrc1 = Vb + (rowbase + 16 * (q1 & 3) + (lane >> 2)) * 512 + h * 128 + (q1 >> 2) * 32 + (lane & 3) * 8; }
    const int kdst = wid * 1024, vdst0 = VOFF + ((2 * wid) >> 2) * 4096 + ((2 * wid) & 3) * 1024, vdst1 = VOFF + ((2 * wid + 1) >> 2) * 4096 + ((2 * wid + 1) & 3) * 1024;
#define ATT_DMA(t, sb) do { const size_t to_ = (size_t)(t) * 64 * 512; LAS unsigned char* s_ = lds + (sb); \
        __builtin_amdgcn_global_load_lds((const GAS unsigned*)(ksrc + to_), (LAS unsigned*)(s_ + kdst), 16, 0, 0); \
        __builtin_amdgcn_global_load_lds((const GAS unsigned*)(ksrc + to_ + 64), (LAS unsigned*)(s_ + KT + kdst), 16, 0, 0); \
        __builtin_amdgcn_global_load_lds((const GAS unsigned*)(vsrc0 + to_), (LAS unsigned*)(s_ + vdst0), 16, 0, 0); \
        __builtin_amdgcn_global_load_lds((const GAS unsigned*)(vsrc1 + to_), (LAS unsigned*)(s_ + vdst1), 16, 0, 0); } while (0)
#define BAR_L() asm volatile("s_waitcnt lgkmcnt(0)\n\ts_barrier" ::: "memory")
#define BAR_VL() asm volatile("s_waitcnt vmcnt(0) lgkmcnt(0)\n\ts_barrier" ::: "memory")
    const int kfoff = m * KT + r32 * KROW + ((hi ^ ((r32 >> 1) & 7)) * 16);
    const int vfoff = VOFF + ((lane >> 4) & 1) * 32 + (lane & 3) * 8 + (4 * hi + ((lane & 15) >> 2)) * 64;
    f32x16 o[4];
#pragma unroll
    for (int vb = 0; vb < 4; ++vb)
#pragma unroll
        for (int r = 0; r < 16; ++r) o[vb][r] = 0.f;
    RowState st{-1e30f, 0.f};
    bf16x8 pa[4];
    const int t_hi = 2 * qblk + 1;
#define ATT_ACTIVE(t) (64 * (t) <= qmin + 31 && (t) >= tlo_w)
    ATT_DMA(t_hi, 0);
    if (t_hi - 1 >= t_lo) ATT_DMA(t_hi - 1, STAGE);
    BAR_VL();
    if (m == 1) BAR_L();
    int it = 0;
    for (int t = t_hi; t >= t_lo; --t, ++it) {
        const int cur = (it & 3) * STAGE;
        int ko_ = kfoff + cur, vc_ = vfoff + cur; asm volatile("" : "+v"(ko_), "+v"(vc_));
        if (!(ABL & 8)) if (t - 2 >= t_lo) ATT_DMA(t - 2, ((it + 2) & 3) * STAGE);
        const bool act = ATT_ACTIVE(t);
        if (act) soft_tile<ABL>(lds, ko_, qr, t, qpos, qmin, hi, slope2, st, o, pa);
        BAR_L();
        if (act) pv_tile<ABL>(lds + vc_, pa, o);
        BAR_VL();
    }
    if (m == 0) BAR_L();
    BAR_L();
#undef ATT_DMA
#undef ATT_ACTIVE
    st.lrun += __shfl_xor(st.lrun, 32);
    const float inv = 1.f / st.lrun;
    LAS float* xch = (LAS float*)lds;
    if (m == 1) {
#pragma unroll
        for (int vb = 0; vb < 4; ++vb)
#pragma unroll
            for (int r = 0; r < 16; ++r) xch[(j4 * 64 + vb * 16 + r) * 64 + lane] = o[vb][r] * inv;
    }
    __syncthreads();
    if (m == 0) {
        float ss = 0.f;
#pragma unroll
        for (int vb = 0; vb < 4; ++vb)
#pragma unroll
            for (int r = 0; r < 16; ++r) { const float v = o[vb][r] * inv - lam * xch[(j4 * 64 + vb * 16 + r) * 64 + lane]; o[vb][r] = v; ss += v * v;
                if (r == 15) asm volatile("" ::: "memory"); }
        ss += __shfl_xor(ss, 32);
        const float rstd = rsqrtf(ss * (1.f / 128.f) + EPS) * 0.8f;
        const float* sg = F.in[4];
        bf16* orow = AL + (rowbase + qpos) * ldo + h * 128;
#pragma unroll
        for (int vb = 0; vb < 4; ++vb)
#pragma unroll
            for (int g = 0; g < 4; ++g) { const int vd = vb * 32 + 8 * g + 4 * hi; const f32x4 gg = *(const GAS f32x4*)(sg + vd);
                const unsigned w0 = pk2(o[vb][4 * g] * rstd * gg[0], o[vb][4 * g + 1] * rstd * gg[1]), w1 = pk2(o[vb][4 * g + 2] * rstd * gg[2], o[vb][4 * g + 3] * rstd * gg[3]);
                *(GAS unsigned long long*)(orow + vd) = (unsigned long long)w0 | ((unsigned long long)w1 << 32);
                asm volatile("" ::: "memory"); }
    }
    __syncthreads();
}

}

namespace att2 {
using att::f32x16; using att::s16x4; using att::vtr;
constexpr int KSLOT = 32768, VBASE = 65536, VSLOT = 32768, TILEK = 16384, TILEV = 16384, KMAP = 8192;
constexpr int CW_AQ2 = 200, CW_CQ = 208;

template <int ABL> __device__ __forceinline__ void pv16(const LAS unsigned char* vp, const bf16x8 (&pa)[4], f32x16 (&o)[4]) {
    if (ABL & 2) { o[0][0] += (float)pa[0][0]; return; }
#pragma unroll
    for (int vb = 0; vb < 4; ++vb)
#pragma unroll
        for (int s = 0; s < 4; ++s) {
            const s16x4 lo = vtr(vp + vb * 4096 + s * 1024), hh = vtr(vp + vb * 4096 + s * 1024 + 512);
            const bf16x8 vf = (bf16x8){lo[0], lo[1], lo[2], lo[3], hh[0], hh[1], hh[2], hh[3]};
            o[vb] = __builtin_amdgcn_mfma_f32_32x32x16_bf16(vf, pa[s], o[vb], 0, 0, 0);
        }
}
template <int ABL> __device__ __forceinline__ void qk8(const LAS unsigned char* lds, int ko, const bf16x8 (&qr)[4], const f32x16& c0, const f32x16& c1, f32x16& p0, f32x16& p1) {
#pragma unroll
    for (int d0 = 0; d0 < 4; ++d0) {
        const LAS unsigned char* kq = lds + (ko ^ (d0 * 32));
        const bf16x8 k0 = *(const LAS bf16x8*)(kq), k1 = *(const LAS bf16x8*)(kq + 32 * 128);
        if (ABL & 4) { if (d0 == 0) { p0 = c0; p1 = c1; p0[0] += (float)k0[0]; p1[0] += (float)k1[0]; } continue; }
        p0 = __builtin_amdgcn_mfma_f32_32x32x16_bf16(k0, qr[d0], d0 == 0 ? c0 : p0, 0, 0, 0);
        p1 = __builtin_amdgcn_mfma_f32_32x32x16_bf16(k1, qr[d0], d0 == 0 ? c1 : p1, 0, 0, 0);
    }
}
__device__ __forceinline__ void pack4(const f32x16& p0, const f32x16& p1, bf16x8 (&pa)[4]) {
#pragma unroll
    for (int s = 0; s < 4; ++s) { v4u w;
#pragma unroll
        for (int e = 0; e < 4; ++e) { const int r = 8 * (s & 1) + 2 * e; w[e] = (s < 2) ? pg8::cvt_pk_bf16(p0[r], p0[r + 1]) : pg8::cvt_pk_bf16(p1[r], p1[r + 1]); }
        pa[s] = __builtin_bit_cast(bf16x8, w); }
}

template <int ABL> __device__ __forceinline__ void attn_unit(Frame& F, int b, int h, int qb, float lam, int w0, int w1, bf16* AL, int ldo) {
    int lane_ = F.lane; asm volatile("" : "+v"(lane_));
    const int lane = lane_, wid = F.wave, r32 = lane & 31, hi = lane >> 5;
    const int m = wid >> 2, ks = (wid >> 1) & 1, rb = wid & 1;
    const bf16* Qb = (const bf16*)(F.ws + WS_Q); const bf16* Kb = (const bf16*)(F.ws + WS_K); const bf16* Vb = (const bf16*)(F.ws + WS_V);
    LAS unsigned char* lds = F.lds;
    const size_t rowbase = (size_t)b * SEQ;
    const int qmin = qb * 64 + rb * 32, qpos = qmin + r32;
    const float slope2 = __builtin_amdgcn_exp2f(-2.f * (float)(h + 1)) * LOG2E;
    const int t_hi = qb;
    int t_lo, nact;
    { const int wmax = w0 > w1 ? w0 : w1, s_u = qb * 64 - wmax - 1; t_lo = s_u > 0 ? s_u >> 6 : 0;
      const int s_w = qmin - (m ? w1 : w0) - 1; const int tlw = s_w > 0 ? s_w >> 6 : 0;
      const int tf = t_hi - ks;
      nact = tf >= tlw ? ((tf - tlw) >> 1) + 1 : 0; }
    const int ntrips = (t_hi - t_lo + 2) >> 1;
    bf16x8 qr[4];
#pragma unroll
    for (int d0 = 0; d0 < 4; ++d0) qr[d0] = *(const GAS bf16x8*)(Qb + (rowbase + qpos) * 512 + h * 128 + m * 64 + d0 * 16 + hi * 8);
    const bf16* ksrc; const bf16* vsrc0; const bf16* vsrc1;
    { const int row = 8 * wid + (lane >> 3), c = (lane & 7) ^ ((row >> 1) & 7);
      ksrc = Kb + (rowbase + row) * 512 + h * 128 + c * 8;
      const int q0 = 2 * wid, q1 = 2 * wid + 1;
      vsrc0 = Vb + (rowbase + 16 * (q0 & 3) + (lane >> 2)) * 512 + h * 128 + (q0 >> 2) * 32 + (lane & 3) * 8;
      vsrc1 = Vb + (rowbase + 16 * (q1 & 3) + (lane >> 2)) * 512 + h * 128 + (q1 >> 2) * 32 + (lane & 3) * 8; }
    const int kdst = wid * 1024, vdst0 = ((2 * wid) >> 2) * 4096 + ((2 * wid) & 3) * 1024, vdst1 = ((2 * wid + 1) >> 2) * 4096 + ((2 * wid + 1) & 3) * 1024;
#define A2_GL(src, dst) do { if (!(ABL & 8)) __builtin_amdgcn_global_load_lds((const GAS unsigned*)(src), (LAS unsigned*)(dst), 16, 0, 0); } while (0)
#define A2_DMA_K(j) do { const int tA_ = t_hi - 2 * (j), tB_ = tA_ - 1; LAS unsigned char* s_ = lds + ((j) & 1) * KSLOT + kdst; \
        if (tA_ >= t_lo) { const bf16* g_ = ksrc + (size_t)tA_ * 64 * 512; A2_GL(g_, s_); A2_GL(g_ + 64, s_ + KMAP); } \
        if (tB_ >= t_lo) { const bf16* g_ = ksrc + (size_t)tB_ * 64 * 512; A2_GL(g_, s_ + TILEK); A2_GL(g_ + 64, s_ + TILEK + KMAP); } } while (0)
#define A2_DMA_V(j) do { const int tA_ = t_hi - 2 * (j), tB_ = tA_ - 1; LAS unsigned char* s_ = lds + VBASE + ((j) & 1) * VSLOT; \
        if (tA_ >= t_lo) { const size_t o_ = (size_t)tA_ * 64 * 512; A2_GL(vsrc0 + o_, s_ + vdst0); A2_GL(vsrc1 + o_, s_ + vdst1); } \
        if (tB_ >= t_lo) { const size_t o_ = (size_t)tB_ * 64 * 512; A2_GL(vsrc0 + o_, s_ + TILEV + vdst0); A2_GL(vsrc1 + o_, s_ + TILEV + vdst1); } } while (0)
#define A2_BAR() asm volatile("s_waitcnt vmcnt(0) lgkmcnt(0)\n\ts_barrier" ::: "memory")
    const int kfoff = ks * TILEK + m * KMAP + r32 * 128 + ((hi ^ ((r32 >> 1) & 7)) * 16);
    const int vfoff = VBASE + ks * TILEV + ((lane >> 4) & 1) * 32 + (lane & 3) * 8 + (4 * hi + ((lane & 15) >> 2)) * 64;
    f32x16 o[4];
#pragma unroll
    for (int vb = 0; vb < 4; ++vb)
#pragma unroll
        for (int r = 0; r < 16; ++r) o[vb][r] = 0.f;
    float R = -1e30f, lsum = 0.f;
    bf16x8 pa[4];
    f32x16 cin0;
    const float d32 = 32.f * slope2;
    const float dstep = 128.f * slope2;
    A2_DMA_K(0);
    A2_BAR();
    if (ntrips > 1) A2_DMA_K(1);
    A2_DMA_V(0);
    if (nact > 0) {
        const int t = t_hi - ks;
        const float base = slope2 * (float)(64 * t + 4 * hi - qpos);
#pragma unroll
        for (int r = 0; r < 16; ++r) { const float cb = slope2 * (float)((r & 3) + 8 * (r >> 2)); cin0[r] = cb + base; }
        f32x16 p0, p1;
        { f32x16 c1;
#pragma unroll
          for (int r = 0; r < 16; ++r) c1[r] = cin0[r] + d32;
          qk8<ABL>(lds, kfoff, qr, cin0, c1, p0, p1); }
        float rm = -1e30f;
        if (ks == 0) {
#pragma unroll
            for (int r = 0; r < 16; ++r) { const int key = 64 * t + 4 * hi + (r & 3) + 8 * (r >> 2);
                if (key > qpos) p0[r] = -1e30f; if (key + 32 > qpos) p1[r] = -1e30f; }
        }
#pragma unroll
        for (int r = 0; r < 16; ++r) rm = fmaxf(rm, fmaxf(p0[r], p1[r]));
        rm = fmaxf(rm, __shfl_xor(rm, 32));
        R = rm;
#pragma unroll
        for (int r = 0; r < 16; ++r) { p0[r] = __builtin_amdgcn_exp2f(p0[r] - R); p1[r] = __builtin_amdgcn_exp2f(p1[r] - R); lsum += p0[r] + p1[r]; }
        pack4(p0, p1, pa);
        const float adj = -R - dstep;
#pragma unroll
        for (int r = 0; r < 16; ++r) cin0[r] += adj;
    }
    A2_BAR();
    for (int i = 1; i < ntrips; ++i) {
        int ko_ = (i & 1) * KSLOT + kfoff, vq_ = ((i - 1) & 1) * VSLOT + vfoff; asm volatile("" : "+v"(ko_), "+v"(vq_));
        if (i + 1 < ntrips) A2_DMA_K(i + 1);
        A2_DMA_V(i);
        if (i < nact) {
            f32x16 p0, p1;
            { f32x16 c1;
#pragma unroll
              for (int r = 0; r < 16; ++r) c1[r] = cin0[r] + d32;
              qk8<ABL>(lds, ko_, qr, cin0, c1, p0, p1); }
            pv16<ABL>(lds + vq_, pa, o);
            float ls = 0.f;
#pragma unroll
            for (int r = 0; r < 16; ++r) { p0[r] = __builtin_amdgcn_exp2f(p0[r]); p1[r] = __builtin_amdgcn_exp2f(p1[r]); ls += p0[r] + p1[r]; cin0[r] -= dstep; }
            lsum += ls;
            pack4(p0, p1, pa);
        } else if (i == nact) pv16<ABL>(lds + vq_, pa, o);
        A2_BAR();
    }
    if (nact == ntrips) pv16<ABL>(lds + ((ntrips - 1) & 1) * VSLOT + vfoff, pa, o);
    A2_BAR();
#undef A2_GL
#undef A2_DMA_K
#undef A2_DMA_V
    lsum += __shfl_xor(lsum, 32);
    LAS float* x1 = (LAS float*)lds;
    LAS float* x2 = (LAS float*)(lds + 4 * 66 * 64 * 4);
    const int pr = m * 2 + rb;
    if (ks == 1) {
#pragma unroll
        for (int vb = 0; vb < 4; ++vb)
#pragma unroll
            for (int r = 0; r < 16; ++r) x1[(pr * 66 + vb * 16 + r) * 64 + lane] = o[vb][r];
        x1[(pr * 66 + 64) * 64 + lane] = lsum; x1[(pr * 66 + 65) * 64 + lane] = R;
    }
    __syncthreads();
    float inv = 0.f;
    if (ks == 0) {
        const float l1 = x1[(pr * 66 + 64) * 64 + lane], R1 = x1[(pr * 66 + 65) * 64 + lane];
        const float Rm = fmaxf(R, R1), f0 = __builtin_amdgcn_exp2f(R - Rm), f1 = __builtin_amdgcn_exp2f(R1 - Rm);
        inv = 1.f / (lsum * f0 + l1 * f1);
        const float g0 = f0 * inv, g1 = f1 * inv;
#pragma unroll
        for (int vb = 0; vb < 4; ++vb) {
#pragma unroll
            for (int r = 0; r < 16; ++r) { o[vb][r] = o[vb][r] * g0 + x1[(pr * 66 + vb * 16 + r) * 64 + lane] * g1; if (r == 15) asm volatile("" ::: "memory"); } }
        if (m == 1) {
#pragma unroll
            for (int vb = 0; vb < 4; ++vb)
#pragma unroll
                for (int r = 0; r < 16; ++r) x2[(rb * 64 + vb * 16 + r) * 64 + lane] = o[vb][r];
        }
    }
    __syncthreads();
    if (ks == 0 && m == 0) {
        float ss = 0.f;
#pragma unroll
        for (int vb = 0; vb < 4; ++vb) {
#pragma unroll
            for (int r = 0; r < 16; ++r) { const float v = o[vb][r] - lam * x2[(rb * 64 + vb * 16 + r) * 64 + lane]; o[vb][r] = v; ss += v * v; if (r == 15) asm volatile("" ::: "memory"); } }
        ss += __shfl_xor(ss, 32);
        const float rstd = rsqrtf(ss * (1.f / 128.f) + EPS) * 0.8f;
        const float* sg = F.in[4];
        bf16* orow = AL + (rowbase + qpos) * ldo + h * 128;
#pragma unroll
        for (int vb = 0; vb < 4; ++vb)
#pragma unroll
            for (int g = 0; g < 4; ++g) { const int vd = vb * 32 + 8 * g + 4 * hi; const f32x4 gg = *(const GAS f32x4*)(sg + vd);
                const unsigned u0 = pk2(o[vb][4 * g] * rstd * gg[0], o[vb][4 * g + 1] * rstd * gg[1]), u1 = pk2(o[vb][4 * g + 2] * rstd * gg[2], o[vb][4 * g + 3] * rstd * gg[3]);
                *(GAS unsigned long long*)(orow + vd) = (unsigned long long)u0 | ((unsigned long long)u1 << 32);
                asm volatile("" ::: "memory"); }
    }
    __syncthreads();
#undef A2_BAR
}

template <int ABL> __device__ __forceinline__ void attn_unit_dispatch(Frame& F, unsigned u, float lam, bf16* AL, int ldo) {
    const int h = 3 - (int)(u >> 8), r = (int)(u & 255u), b = r & 1, qb = 127 - (r >> 1);
    const float q0 = __uint_as_float(__hip_atomic_load(F.ctl + CW_QKMAX + b * 16 + h * 2, RLX_AGENT)), k0 = __uint_as_float(__hip_atomic_load(F.ctl + CW_QKMAX + b * 16 + 8 + h * 2, RLX_AGENT));
    const float q1 = __uint_as_float(__hip_atomic_load(F.ctl + CW_QKMAX + b * 16 + h * 2 + 1, RLX_AGENT)), k1 = __uint_as_float(__hip_atomic_load(F.ctl + CW_QKMAX + b * 16 + 8 + h * 2 + 1, RLX_AGENT));
    const float B0 = sqrtf(q0 * k0), B1 = sqrtf(q1 * k1), slope2 = __builtin_amdgcn_exp2f(-2.f * (float)(h + 1)) * LOG2E;
    const int w0 = __builtin_amdgcn_readfirstlane((int)fminf((2.f * B0 + att::WIN_T) / slope2, 16384.f)), w1 = __builtin_amdgcn_readfirstlane((int)fminf((2.f * B1 + att::WIN_T) / slope2, 16384.f));
    const bool fixed_ok = __builtin_amdgcn_readfirstlane((int)(2.f * fmaxf(B0, B1) <= 100.f)) != 0;
    if (fixed_ok) attn_unit<ABL>(F, b, h, qb, lam, w0, w1, AL, ldo);
    else if ((qb & 1) == 0) att::attn_unit<ABL>(F, b, h, qb >> 1, lam, AL, ldo);
}
template <int ABL, bool CONV> __device__ __forceinline__ void attn_phase(Frame& F, bf16* AL, int ldo, int qw, int qc, int c_first) {
    const float* lp = F.in[3];
    float a = lp[F.lane] * lp[64 + F.lane], c = lp[128 + F.lane] * lp[192 + F.lane];
    a = wave_sum(a); c = wave_sum(c);
    const float lam = __expf(a) - __expf(c) + 0.2f;
    volatile LAS unsigned* slot = F.MISC + 12;
    if (F.tid == 0) { slot[0] = __hip_atomic_fetch_add(F.ctl + qw, 1u, RLX_AGENT); slot[1] = CONV ? (unsigned)c_first + __hip_atomic_fetch_add(F.ctl + qc, 1u, RLX_AGENT) : 0xffffffffu; }
    __syncthreads();
    for (;;) {
        const unsigned ua = slot[0];
        if (ua >= 1024u && (!CONV || slot[1] >= (unsigned)NCONV_BATCH)) break;
        if (ua < 1024u) {
            unsigned nxt = 0;
            if (F.tid == 0) nxt = __hip_atomic_fetch_add(F.ctl + qw, 1u, RLX_AGENT);
            attn_unit_dispatch<ABL>(F, ua, lam, AL, ldo);
            if (F.tid == 0) slot[0] = nxt;
            __syncthreads();
        }
        if (CONV) {
#pragma unroll 1
            for (int rr = 0; rr < 2; ++rr) {
                const unsigned uc = slot[1];
                if (uc < (unsigned)NCONV_BATCH) {
                    unsigned nxt = 0;
                    if (F.tid == 0) nxt = (unsigned)c_first + __hip_atomic_fetch_add(F.ctl + qc, 1u, RLX_AGENT);
                    conv_batch(F, (int)uc);
                    if (F.tid == 0) slot[1] = nxt;
                    __syncthreads();
                }
            }
        }
    }
}
}

namespace lru {
typedef float f32x16 __attribute__((ext_vector_type(16)));
constexpr int ROWB = 144;
constexpr int L_WT = 0, L_XC = 128 * ROWB, L_GY = 2 * 128 * ROWB, L_PRE = L_GY + 128 * 128, L_AGG = L_PRE + 128 * 128 * 4;
constexpr int L_OUT = L_PRE;
constexpr size_t AGG_OFF = WS_MISC;
static_assert(L_AGG + 4096 <= SCR_BYTES, "LRU LDS map");

__device__ __forceinline__ float sigm(float x) { return __builtin_amdgcn_rcpf(1.f + __builtin_amdgcn_exp2f(-LOG2E * x)); }

__device__ __forceinline__ void l1_phase(Frame& F) {
    const int tid = F.tid, lane = F.lane, wid = F.wave, r32 = lane & 31, hi = lane >> 5;
    LAS unsigned char* lds = F.lds;
    const bf16* XR = (const bf16*)(F.ws + WS_XR); const bf16* GY = (const bf16*)(F.ws + WS_GY);
    bf16* PG = (bf16*)(F.ws + WS_PG); bf16* QG = (bf16*)(F.ws + WS_QG); float* AGG = (float*)(F.ws + AGG_OFF);
    const int n = F.vcu & 7;
    { const float* wr = F.in[7] + (size_t)n * 4096; const float* wi = F.in[9] + (size_t)n * 4096;
#pragma unroll 4
      for (int i = 0; i < 8; ++i) { const int e = tid + 512 * i, c = e >> 6, d = e & 63;
          *(LAS bf16*)(lds + L_WT + d * ROWB + c * 2) = (bf16)f2bf(wr[e]); *(LAS bf16*)(lds + L_WT + (64 + d) * ROWB + c * 2) = (bf16)f2bf(wi[e]); } }
    const int c = tid & 63, ts = wid, ch = n * 64 + c;
    const float br = F.in[8][ch], bi = F.in[10][ch], sp8 = -8.f * LOG2E * log1pf(__expf(-F.in[11][ch]));
    const int nper = (1024 + F.G - 1) / F.G;
    for (int j = 0; j < nper; ++j) {
        const int q = (F.vcu >> 3) * nper + j;
        if (q >= 128 || F.G * 8 < 8) break;
        const int b = q & 1, k = q >> 1;
        const size_t rowbase = (size_t)b * SEQ; const int p0 = k * 128;
        { const int t = tid >> 2, cg = tid & 3, ch0 = n * 64 + cg * 16;
          float acc[16];
          const float* cb = F.in[6] + ch0;
#pragma unroll
          for (int i = 0; i < 16; ++i) acc[i] = cb[i];
#pragma unroll
          for (int jj = 0; jj < 4; ++jj) { const int p = p0 + t - 3 + jj;
              const float* cw = F.in[5] + jj * 512 + ch0;
              if (p >= 0) { const v4u x0 = *(const GAS v4u*)(XR + (rowbase + p) * 512 + ch0), x1 = *(const GAS v4u*)(XR + (rowbase + p) * 512 + ch0 + 8);
#pragma unroll
                  for (int i = 0; i < 4; ++i) { acc[2 * i] += cw[2 * i] * __builtin_bit_cast(float, x0[i] << 16); acc[2 * i + 1] += cw[2 * i + 1] * __builtin_bit_cast(float, x0[i] & 0xffff0000u);
                                                acc[8 + 2 * i] += cw[8 + 2 * i] * __builtin_bit_cast(float, x1[i] << 16); acc[8 + 2 * i + 1] += cw[8 + 2 * i + 1] * __builtin_bit_cast(float, x1[i] & 0xffff0000u); } } }
          v4u o0, o1;
#pragma unroll
          for (int i = 0; i < 4; ++i) { o0[i] = pk2(acc[2 * i], acc[2 * i + 1]); o1[i] = pk2(acc[8 + 2 * i], acc[8 + 2 * i + 1]); }
          *(LAS v4u*)(lds + L_XC + t * ROWB + cg * 32) = o0; *(LAS v4u*)(lds + L_XC + t * ROWB + cg * 32 + 16) = o1;
#pragma unroll
          for (int i = 0; i < 2; ++i) { const int e = tid + 512 * i, row = e >> 3, cc = e & 7;
              *(LAS v4u*)(lds + L_GY + row * 128 + cc * 16) = *(const GAS v4u*)(GY + (rowbase + p0 + row) * 512 + n * 64 + cc * 8); } }
        __syncthreads();
        { const int tb = wid & 3, dh = wid >> 2;
          f32x16 d0, d1;
#pragma unroll
          for (int r = 0; r < 16; ++r) { d0[r] = 0.f; d1[r] = 0.f; }
#pragma unroll
          for (int s = 0; s < 4; ++s) {
              const bf16x8 a = *(const LAS bf16x8*)(lds + L_XC + (tb * 32 + r32) * ROWB + s * 32 + hi * 16);
              const bf16x8 w0 = *(const LAS bf16x8*)(lds + L_WT + (dh * 64 + r32) * ROWB + s * 32 + hi * 16);
              const bf16x8 w1 = *(const LAS bf16x8*)(lds + L_WT + (dh * 64 + 32 + r32) * ROWB + s * 32 + hi * 16);
              d0 = __builtin_amdgcn_mfma_f32_32x32x16_bf16(a, w0, d0, 0, 0, 0);
              d1 = __builtin_amdgcn_mfma_f32_32x32x16_bf16(a, w1, d1, 0, 0, 0); }
          LAS float* pre = (LAS float*)(lds + L_PRE);
#pragma unroll
          for (int r = 0; r < 16; ++r) { const int tok = tb * 32 + (r & 3) + 8 * (r >> 2) + 4 * hi;
              pre[tok * 128 + dh * 64 + r32] = d0[r]; pre[tok * 128 + dh * 64 + 32 + r32] = d1[r]; } }
        __syncthreads();
        float hv[16], cv[16];
        { const LAS float* pre = (const LAS float*)(lds + L_PRE);
          float h = 0.f, cum = 1.f;
#pragma unroll
          for (int i = 0; i < 16; ++i) { const int tt = ts * 16 + i;
              const float r = sigm(pre[tt * 128 + c] + br), ig = sigm(pre[tt * 128 + 64 + c] + bi);
              const float l2a = sp8 * r, a = __builtin_amdgcn_exp2f(l2a);
              const float x2 = 1.3862943611f * l2a;
              const float om = x2 > -0.05f ? -x2 * (1.f + x2 * (0.5f + x2 * (0.16666667f + x2 * 0.041666667f))) : 1.f - a * a;
              const float mult = (p0 + tt == 0) ? 1.f : __builtin_amdgcn_sqrtf(om);
              const float xc = bf2f(*(const LAS bf16*)(lds + L_XC + tt * ROWB + c * 2));
              h = a * h + xc * ig * mult; cum *= a; hv[i] = h; cv[i] = cum; }
          LAS float* ag = (LAS float*)(lds + L_AGG);
          ag[(ts * 64 + c) * 2] = cum; ag[(ts * 64 + c) * 2 + 1] = h; }
        __syncthreads();
        { const LAS float* ag = (const LAS float*)(lds + L_AGG);
          float carry = 0.f, pprev = 1.f;
          for (int s = 0; s < ts; ++s) { const float as = ag[(s * 64 + c) * 2], hs = ag[(s * 64 + c) * 2 + 1]; carry = as * carry + hs; pprev *= as; }
          if (ts == 7) { float* g = AGG + ((size_t)((b * 8 + n) * 64 + k) * 64 + c) * 2; g[0] = pprev * cv[15]; g[1] = cv[15] * carry + hv[15]; }
#pragma unroll
          for (int i = 0; i < 16; ++i) { const int tt = ts * 16 + i;
              const float gy = bf2f(*(const LAS bf16*)(lds + L_GY + tt * 128 + c * 2));
              *(LAS bf16*)(lds + L_OUT + tt * 128 + c * 2) = (bf16)f2bf(cv[i] * pprev * gy); *(LAS bf16*)(lds + L_OUT + 16384 + tt * 128 + c * 2) = (bf16)f2bf((hv[i] + cv[i] * carry) * gy); } }
        __syncthreads();
#pragma unroll
        for (int i = 0; i < 2; ++i) { const int e = tid + 512 * i, row = e >> 3, cc = e & 7;
            *(GAS v4u*)(PG + (rowbase + p0 + row) * 512 + n * 64 + cc * 8) = *(const LAS v4u*)(lds + L_OUT + row * 128 + cc * 16);
            *(GAS v4u*)(QG + (rowbase + p0 + row) * 512 + n * 64 + cc * 8) = *(const LAS v4u*)(lds + L_OUT + 16384 + row * 128 + cc * 16); }
        __syncthreads();
    }
}

__device__ __forceinline__ void l2_phase(Frame& F) {
    const bf16* PG = (const bf16*)(F.ws + WS_PG); const bf16* QG = (const bf16*)(F.ws + WS_QG); const float* AGG = (const float*)(F.ws + AGG_OFF);
    bf16* AL = (bf16*)(F.ws + WS_AL);
    LAS float* car = (LAS float*)F.lds;
    const int tid = F.tid;
    for (int u0 = F.vcu * 4; u0 < 1024; u0 += F.G * 4) {
        const int bn = u0 >> 6, k0 = u0 & 63, b = bn >> 3, n = bn & 7;
        if (tid < 64) { const float* g = AGG + ((size_t)bn * 64 * 64 + tid) * 2; float carry = 0.f;
            for (int j0 = 0; j0 < k0; j0 += 4) { float a_[4], h_[4];
#pragma unroll
                for (int q = 0; q < 4; ++q) { a_[q] = g[(size_t)(j0 + q) * 128]; h_[q] = g[(size_t)(j0 + q) * 128 + 1]; }
#pragma unroll
                for (int q = 0; q < 4; ++q) carry = a_[q] * carry + h_[q]; }
            float a_[4], h_[4];
#pragma unroll
            for (int q = 0; q < 4; ++q) { a_[q] = g[(size_t)(k0 + q) * 128]; h_[q] = g[(size_t)(k0 + q) * 128 + 1]; }
#pragma unroll
            for (int q = 0; q < 4; ++q) { car[q * 64 + tid] = carry; carry = a_[q] * carry + h_[q]; } }
        __syncthreads();
        v4u qv[8], pv[8];
#pragma unroll
        for (int i = 0; i < 8; ++i) { const int e = tid + 512 * i, tok = e >> 3, g8 = e & 7; const size_t row = (size_t)b * SEQ + k0 * 128 + tok;
            qv[i] = *(const GAS v4u*)(QG + row * 512 + n * 64 + g8 * 8); pv[i] = *(const GAS v4u*)(PG + row * 512 + n * 64 + g8 * 8); }
#pragma unroll
        for (int i = 0; i < 8; ++i) { const int e = tid + 512 * i, tok = e >> 3, g8 = e & 7; const size_t row = (size_t)b * SEQ + k0 * 128 + tok;
            const LAS float* cp = car + (tok >> 7) * 64 + g8 * 8; v4u o;
#pragma unroll
            for (int w = 0; w < 4; ++w) { const float c0 = cp[2 * w], c1 = cp[2 * w + 1];
                o[w] = pk2(__builtin_bit_cast(float, qv[i][w] << 16) + __builtin_bit_cast(float, pv[i][w] << 16) * c0, __builtin_bit_cast(float, qv[i][w] & 0xffff0000u) + __builtin_bit_cast(float, pv[i][w] & 0xffff0000u) * c1); }
            *(GAS v4u*)(AL + row * 1024 + 512 + n * 64 + g8 * 8) = o; }
        __syncthreads();
    }
}
}

namespace moe {
constexpr int L_TOK = LDSCTL_OFF + 512;
constexpr int L_HIST = LDSCTL_OFF + 2560, L_BASE = LDSCTL_OFF + 2688, L_PAD = LDSCTL_OFF + 2816;
constexpr size_t TOKSLOT_OFF = WS_MISC + 1 * MiB;
constexpr size_t WER_OFF = WS_MISC + 1536 * 1024;
static_assert(L_PAD + 33 * 4 <= LDS_BYTES, "LDS control map");

__device__ __forceinline__ void route_phase(Frame& F, bool dry) {
    const int lane = F.lane, wave = F.wave, tid = F.tid, r32 = lane & 31, hi = lane >> 5;
    LAS unsigned char* lds = F.lds;
    const float* x1 = F.out;
    { const GAS v4u* src = (const GAS v4u*)(F.ws + WER_OFF);
#pragma unroll 6
      for (int i = 0; i < 18; ++i) *(LAS v4u*)(lds + (tid + 512 * i) * 16) = src[tid + 512 * i]; }
    f32x4 gv[4];
#pragma unroll
    for (int j = 0; j < 4; ++j) gv[j] = ((const GAS f32x4*)F.in[15])[lane + 64 * j];
    for (int i = 0; i < 8; ++i) { const int lt = wave * 8 + i, tok = F.vcu * 64 + lt;
        const GAS f32x4* xr = (const GAS f32x4*)(x1 + (size_t)tok * DM) + lane; float s = 0.f; f32x4 vv[4];
#pragma unroll
        for (int j = 0; j < 4; ++j) { const f32x4 v = xr[64 * j]; vv[j] = v; s += (v.x * v.x + v.y * v.y) + (v.z * v.z + v.w * v.w); }
        s = wave_sum(s);
        const float rstd = rsqrtf(s * (1.f / DM) + EPS);
        if (lane == 0) ((LAS float*)(lds + L_TOK + lt * 32))[6] = rstd;
        if (!dry) { GAS unsigned long long* hb = (GAS unsigned long long*)((bf16*)(F.ws + WS_HNB) + (size_t)tok * DM) + lane;
#pragma unroll
            for (int j = 0; j < 4; ++j) { const f32x4 h = vv[j] * rstd * gv[j]; hb[64 * j] = (unsigned long long)pk2(h.x, h.y) | ((unsigned long long)pk2(h.z, h.w) << 32); } } }
    __syncthreads();
    typedef float f32x16 __attribute__((ext_vector_type(16)));
    f32x16 acc0, acc1;
#pragma unroll
    for (int r = 0; r < 16; ++r) { acc0[r] = 0.f; acc1[r] = 0.f; }
    { const int mb = wave & 1, kq = wave >> 1, lt = mb * 32 + r32, tok = F.vcu * 64 + lt;
      const float rs = ((const LAS float*)(lds + L_TOK + lt * 32))[6];
      const float* xp = x1 + (size_t)tok * DM + kq * 256 + 8 * hi;
      const LAS unsigned char* wp0 = lds + r32 * 2048;
      const LAS unsigned char* wp1 = lds + (32 + (r32 & 3)) * 2048;
      const int c0 = kq * 32 + hi, z0 = r32 & 15, z1 = r32 & 3;
      const bool gz = r32 >= 4;
#pragma unroll 4
      for (int ks = 0; ks < 16; ++ks) {
          const f32x4 xa = *(const GAS f32x4*)(xp + ks * 16), xb = *(const GAS f32x4*)(xp + ks * 16 + 4);
          v4u ah, al;
#pragma unroll
          for (int e = 0; e < 4; ++e) { const float h0 = (e < 2 ? xa[2 * e] : xb[2 * e - 4]) * rs, h1 = (e < 2 ? xa[2 * e + 1] : xb[2 * e - 3]) * rs;
              const unsigned b0 = f2bf(h0), b1 = f2bf(h1); ah[e] = b0 | (b1 << 16);
              al[e] = pk2(h0 - __builtin_bit_cast(float, b0 << 16), h1 - __builtin_bit_cast(float, b1 << 16)); }
          const bf16x8 a_h = __builtin_bit_cast(bf16x8, ah), a_l = __builtin_bit_cast(bf16x8, al);
          const int o0 = ((c0 + 2 * ks) ^ z0) * 16, o1 = ((c0 + 2 * ks) ^ z1) * 16;
          const bf16x8 bh0 = *(const LAS bf16x8*)(wp0 + o0), bl0 = *(const LAS bf16x8*)(wp0 + 73728 + o0);
          bf16x8 bh1 = *(const LAS bf16x8*)(wp1 + o1), bl1 = *(const LAS bf16x8*)(wp1 + 73728 + o1);
          if (gz) { bh1 = (bf16x8){0, 0, 0, 0, 0, 0, 0, 0}; bl1 = bh1; }
          acc0 = __builtin_amdgcn_mfma_f32_32x32x16_bf16(a_h, bh0, acc0, 0, 0, 0); acc0 = __builtin_amdgcn_mfma_f32_32x32x16_bf16(a_h, bl0, acc0, 0, 0, 0); acc0 = __builtin_amdgcn_mfma_f32_32x32x16_bf16(a_l, bh0, acc0, 0, 0, 0);
          acc1 = __builtin_amdgcn_mfma_f32_32x32x16_bf16(a_h, bh1, acc1, 0, 0, 0); acc1 = __builtin_amdgcn_mfma_f32_32x32x16_bf16(a_h, bl1, acc1, 0, 0, 0); acc1 = __builtin_amdgcn_mfma_f32_32x32x16_bf16(a_l, bh1, acc1, 0, 0, 0);
      } }
    __syncthreads();
    { LAS float* part = (LAS float*)lds;
#pragma unroll
      for (int r = 0; r < 16; ++r) { part[((wave * 2 + 0) * 16 + r) * 64 + lane] = acc0[r]; part[((wave * 2 + 1) * 16 + r) * 64 + lane] = acc1[r]; } }
    __syncthreads();
    if (tid < 64) {
        const int lt = tid, mb = lt >> 5, i5 = lt & 31, h2 = (i5 >> 2) & 1, r = (i5 & 3) + 4 * (i5 >> 3);
        const LAS float* part = (const LAS float*)lds;
        float lg[4];
#pragma unroll
        for (int c = 0; c < 4; ++c) { float s = 0.f;
#pragma unroll
            for (int kq = 0; kq < 4; ++kq) s += part[(((mb + 2 * kq) * 2 + 1) * 16 + r) * 64 + h2 * 32 + c];
            lg[c] = s; }
        int grp = 0; float mx = lg[0];
#pragma unroll
        for (int e = 1; e < 4; ++e) if (lg[e] > mx) { mx = lg[e]; grp = e; }
        float den = 0.f;
#pragma unroll
        for (int e = 0; e < 4; ++e) den += __expf(lg[e] - mx);
        const float gw = 1.f / den;
        float le[8];
#pragma unroll
        for (int e = 0; e < 8; ++e) { float s = 0.f;
#pragma unroll
            for (int kq = 0; kq < 4; ++kq) s += part[(((mb + 2 * kq) * 2 + 0) * 16 + r) * 64 + h2 * 32 + grp * 8 + e];
            le[e] = s; }
        int i0 = 0; float m0 = le[0];
#pragma unroll
        for (int e = 1; e < 8; ++e) if (le[e] > m0) { m0 = le[e]; i0 = e; }
        int i1 = -1; float m1 = -INFINITY;
#pragma unroll
        for (int e = 0; e < 8; ++e) if (e != i0 && le[e] > m1) { m1 = le[e]; i1 = e; }
        const float pa = 1.f / (1.f + __expf(m1 - m0));
        if (!dry) { const int e0 = grp * 8 + i0, e1 = grp * 8 + i1;
            const int l0 = atomicAdd((int*)(lds + L_HIST) + e0, 1), l1 = atomicAdd((int*)(lds + L_HIST) + e1, 1);
            LAS int* tk = (LAS int*)(lds + L_TOK + lt * 32); tk[0] = e0; tk[1] = e1; ((LAS float*)tk)[2] = gw * pa; ((LAS float*)tk)[3] = gw * (1.f - pa); tk[4] = l0; tk[5] = l1; }
        else asm volatile("" :: "v"(gw), "v"(pa), "v"(i0), "v"(i1));
    }
    __syncthreads();
    if (dry) return;
    if (tid < 32) { const int h = ((LAS int*)(lds + L_HIST))[tid];
        ((LAS int*)(lds + L_BASE))[tid] = (int)atomicAdd((unsigned*)(F.ctl + CW_CNT) + tid, (unsigned)h); }
}
__device__ __forceinline__ void scatter_phase(Frame& F) {
    const int lane = F.lane, wave = F.wave;
    LAS unsigned char* lds = F.lds;
    if (F.tid == 0) { int cs[32];
#pragma unroll
        for (int e = 0; e < 32; ++e) cs[e] = (int)__hip_atomic_load(F.ctl + CW_CNT + e, RLX_AGENT);
        int acc = 0; LAS int* pad = (LAS int*)(lds + L_PAD);
#pragma unroll
        for (int e = 0; e < 32; ++e) { pad[e] = acc; acc += (cs[e] + 255) & ~255; }
        pad[32] = acc; }
    __syncthreads();
    bf16* XS = (bf16*)(F.ws + WS_XS); int* TS = (int*)(F.ws + TOKSLOT_OFF); const bf16* HNB = (const bf16*)(F.ws + WS_HNB);
    const LAS int* pad = (const LAS int*)(lds + L_PAD); const LAS int* base = (const LAS int*)(lds + L_BASE);
    for (int i = 0; i < 8; i += 4) {
        v4u a[4], b[4];
#pragma unroll
        for (int q = 0; q < 4; ++q) { const int tok = F.vcu * 64 + wave * 8 + i + q; const GAS v4u* src = (const GAS v4u*)(HNB + (size_t)tok * DM) + lane; a[q] = src[0]; b[q] = src[64]; }
#pragma unroll
        for (int q = 0; q < 4; ++q) { const int lt = wave * 8 + i + q, tok = F.vcu * 64 + lt;
            const LAS int* tk = (const LAS int*)(lds + L_TOK + lt * 32);
            const int e0 = tk[0], e1 = tk[1];
            const int s0 = pad[e0] + base[e0] + tk[4], s1 = pad[e1] + base[e1] + tk[5];
            GAS v4u* o0 = (GAS v4u*)(XS + (size_t)s0 * 1024) + lane; GAS v4u* o1 = (GAS v4u*)(XS + (size_t)s1 * 1024) + lane;
            o0[0] = a[q]; o0[64] = b[q]; o1[0] = a[q]; o1[64] = b[q];
            if (lane == 0) { int* t = TS + (size_t)tok * 4; t[0] = s0; t[1] = s1; t[2] = tk[2]; t[3] = tk[3]; } }
    }
}
__device__ __forceinline__ void final_phase(Frame& F, float* dst) {
    const int lane = F.lane; const int gw = F.vcu * NWAVES + F.wave, NGW = F.G * NWAVES;
    const bf16* YB = (const bf16*)(F.ws + WS_YB); const int* TS = (const int*)(F.ws + TOKSLOT_OFF); const float* gfin = F.in[21];
    f32x4 gv[4];
#pragma unroll
    for (int j = 0; j < 4; ++j) gv[j] = ((const GAS f32x4*)gfin)[lane + 64 * j];
    for (int tok = gw; tok < NTOK; tok += NGW) {
        const int* t = TS + (size_t)tok * 4; const int s0 = t[0], s1 = t[1]; const float w0 = __builtin_bit_cast(float, t[2]), w1 = __builtin_bit_cast(float, t[3]);
        GAS f32x4* xr = (GAS f32x4*)(F.out + (size_t)tok * DM) + lane;
        const GAS unsigned long long* y0 = (const GAS unsigned long long*)(YB + (size_t)s0 * 1024) + lane; const GAS unsigned long long* y1 = (const GAS unsigned long long*)(YB + (size_t)s1 * 1024) + lane;
        f32x4 v[4]; float s = 0.f;
#pragma unroll
        for (int j = 0; j < 4; ++j) { v[j] = xr[64 * j]; const unsigned long long a = y0[64 * j], b = y1[64 * j];
            v[j].x += w0 * __builtin_bit_cast(float, (unsigned)a << 16) + w1 * __builtin_bit_cast(float, (unsigned)b << 16);
            v[j].y += w0 * __builtin_bit_cast(float, (unsigned)a & 0xffff0000u) + w1 * __builtin_bit_cast(float, (unsigned)b & 0xffff0000u);
            v[j].z += w0 * __builtin_bit_cast(float, (unsigned)(a >> 32) << 16) + w1 * __builtin_bit_cast(float, (unsigned)(b >> 32) << 16);
            v[j].w += w0 * __builtin_bit_cast(float, (unsigned)(a >> 32) & 0xffff0000u) + w1 * __builtin_bit_cast(float, (unsigned)(b >> 32) & 0xffff0000u);
            s += (v[j].x * v[j].x + v[j].y * v[j].y) + (v[j].z * v[j].z + v[j].w * v[j].w); }
        const float rstd = rsqrtf(wave_sum(s) * (1.f / DM) + EPS);
        GAS f32x4* orow = (GAS f32x4*)(dst + (size_t)tok * DM) + lane;
#pragma unroll
        for (int j = 0; j < 4; ++j) orow[64 * j] = v[j] * rstd * gv[j];
    }
}
}

struct Args { const float* in[22]; float* out; unsigned char* ws; int ph_lo, ph_hi, li, pad; };
constexpr int N_PHASES = 11;
#ifndef P1_CONV_PER
#define P1_CONV_PER 6
#endif
constexpr int P1_CONV = 128 * P1_CONV_PER;
__global__ void __launch_bounds__(NWAVES * 64, 2) mega(Args args) {
    extern __shared__ __attribute__((aligned(16))) unsigned char lds[];
    Frame F;
    F.lds = (LAS unsigned char*)lds;
    F.MISC = (volatile LAS unsigned*)(F.lds + MISC_OFF);
    F.tid = threadIdx.x; F.lane = F.tid & 63; F.wave = __builtin_amdgcn_readfirstlane(F.tid >> 6);
    F.G = gridDim.x; { const int bx = blockIdx.x; F.vcu = (F.G % 8 == 0) ? (bx % 8) * (F.G / 8) + bx / 8 : bx; }
    F.ws = args.ws; F.out = args.out; F.ctl = (gu32*)(args.ws + WS_CTL);
#pragma unroll
    for (int i = 0; i < 22; ++i) F.in[i] = args.in[i];
    for (int u = F.tid; u < (LDS_BYTES - LDSCTL_OFF) / 4; u += NWAVES * 64) ((LAS unsigned*)(F.lds + LDSCTL_OFF))[u] = 0u;
    __syncthreads();
    XcdBarrier bar = xcd_barrier_post((unsigned*)(F.ctl + CW_BAR) + args.li * XCD_BAR_WORDS, F.MISC + 8);
    const int lo = args.ph_lo, hi = args.ph_hi;
#define IN(k) (lo <= (k) && (k) < hi)
#define BOTH(k) (IN(k) && IN((k) + 1))
#define GRID_BAR() xcd_barrier(bar)
#define REFRESH() do { int t_ = threadIdx.x; asm volatile("" : "+v"(t_)); F.tid = t_; F.lane = t_ & 63; } while (0)

    if (IN(0)) { REFRESH(); p0_prologue(F); if (BOTH(0)) GRID_BAR(); }

    if (IN(1)) {
        pg8::Gemm g{(const bf16*)(F.ws + WS_XN), (const bf16*)(F.ws + WS_WIN), NTOK, INC, DM}; pg8::StaticOrder S; S.init(NTOK, INC, F.G, (int)blockIdx.x);
        pg8::EpiInProj E{(bf16*)(F.ws + WS_Q), (bf16*)(F.ws + WS_K), (bf16*)(F.ws + WS_V), (bf16*)(F.ws + WS_XR), (bf16*)(F.ws + WS_GY), (bf16*)F.out, (unsigned*)(F.ctl + CW_QKMAX)};
        pg8::gemm_phase<pg8::EpiInProj, pg8::StaticOrder, true, true>(F.lds + RING_OFF, g, S, E);
        if (F.G == 256 && blockIdx.x >= 128) { REFRESH();
#pragma unroll 1
            for (int i = 0; i < P1_CONV_PER; ++i) { conv_batch(F, ((int)blockIdx.x - 128) * P1_CONV_PER + i); __syncthreads(); } }
        if (BOTH(1)) GRID_BAR();
    }
    if (IN(2)) { REFRESH(); lru::l1_phase(F);
#ifdef PROBE_L1X2
        REFRESH(); lru::l1_phase(F);
#endif
        REFRESH(); att2::attn_phase<0, true>(F, (bf16*)(F.ws + WS_AL), 1024, att2::CW_AQ2, att2::CW_CQ, F.G == 256 ? P1_CONV : 0);
#ifdef PROBE_ATT
        __syncthreads(); REFRESH(); att2::attn_phase<PROBE_ATT, false>(F, (bf16*)(F.ws + 256 * MiB), 512, att2::CW_AQ2 + 64, 0, 0);
#ifdef PROBE_ATT3
        __syncthreads(); REFRESH(); att2::attn_phase<PROBE_ATT, false>(F, (bf16*)(F.ws + 256 * MiB), 512, att2::CW_AQ2 + 128, 0, 0);
        __syncthreads(); REFRESH(); att2::attn_phase<PROBE_ATT, false>(F, (bf16*)(F.ws + 256 * MiB), 512, att2::CW_AQ2 + 192, 0, 0);
#endif
#endif
        if (BOTH(2)) GRID_BAR(); }

    if (IN(3)) { REFRESH(); lru::l2_phase(F); if (BOTH(3)) GRID_BAR(); }
#ifndef NO_P4
    if (IN(4)) {
        pg8::Gemm g{(const bf16*)(F.ws + WS_AL), (const bf16*)(F.ws + WS_WMIX), NTOK, DM, DM}; pg8::StaticOrder S; S.init(NTOK, DM, F.G, (int)blockIdx.x);
        pg8::EpiMix E{(const bf16*)F.out, (bf16*)(F.ws + WS_MERGED)};
        pg8::gemm_phase<pg8::EpiMix, pg8::StaticOrder, true, true>(F.lds + RING_OFF, g, S, E);
        if (BOTH(4)) GRID_BAR();
    }
#endif
#ifndef NO_P5
    if (IN(5)) {
        pg8::Gemm g{(const bf16*)(F.ws + WS_MERGED), (const bf16*)(F.ws + WS_WOUT), NTOK, DM, DM}; pg8::StaticOrder S; S.init(NTOK, DM, F.G, (int)blockIdx.x);
        pg8::EpiResidF32 E{F.in[0], F.out};
        pg8::gemm_phase<pg8::EpiResidF32, pg8::StaticOrder, true, true>(F.lds + RING_OFF, g, S, E);
        if (BOTH(5)) GRID_BAR();
    }
#endif
    if (IN(6)) { REFRESH();
#ifdef PROBE_ROUTEX2
        moe::route_phase(F, true); __syncthreads(); REFRESH();
#endif
        moe::route_phase(F, false); if (BOTH(6)) GRID_BAR(); }
    if (IN(7)) { REFRESH(); moe::scatter_phase(F);
#ifdef PROBE_SCATX2
        __syncthreads(); REFRESH(); moe::scatter_phase(F);
#endif
#ifdef PROBE_BARX10
        for (int i_ = 0; i_ < 10; ++i_) GRID_BAR();
#endif
        if (BOTH(7)) GRID_BAR(); }
#ifdef DUP_PHASE
    if ((IN(8) || IN(9)) && !IN(7)) { if (F.tid == 0) { int acc = 0; LAS int* pad = (LAS int*)(F.lds + moe::L_PAD);
        for (int e = 0; e < 32; ++e) { pad[e] = acc; const int c = (int)__hip_atomic_load(F.ctl + CW_CNT + e, RLX_AGENT); acc += (c + 255) & ~255; } pad[32] = acc; } __syncthreads(); }
#endif
    if (IN(8)) {
        pg8::Gemm g{(const bf16*)(F.ws + WS_XS), (const bf16*)(F.ws + WS_WGU), 0, 0, 1024}; pg8::MoeOrder S; S.init((const LAS int*)(F.lds + moe::L_PAD), F.G, (int)blockIdx.x);
        pg8::EpiSwiGLU E{(bf16*)(F.ws + WS_HB)};
        pg8::gemm_phase<pg8::EpiSwiGLU, pg8::MoeOrder, true, true>(F.lds + RING_OFF, g, S, E);
        if (BOTH(8)) GRID_BAR();
    }
    if (IN(9)) {
        pg8::Gemm g{(const bf16*)(F.ws + WS_HB), (const bf16*)(F.ws + WS_WD), 0, 0, 512}; pg8::MoeOrder S; S.init((const LAS int*)(F.lds + moe::L_PAD), F.G, (int)blockIdx.x);
        pg8::EpiStoreBf16 E{(bf16*)(F.ws + WS_YB), 1024};
        pg8::gemm_phase<pg8::EpiStoreBf16, pg8::MoeOrder, true, true>(F.lds + RING_OFF, g, S, E);
        if (BOTH(9)) GRID_BAR();
    }
    if (IN(10)) { REFRESH();
#ifdef PROBE_FINALX2
        moe::final_phase(F, (float*)(F.ws + 190 * MiB)); REFRESH();
#endif
        moe::final_phase(F, F.out); }
#undef IN
#undef BOTH
#undef GRID_BAR
#undef REFRESH
}
__global__ void n_rmsnorm(const float* __restrict__ x, const float* __restrict__ g, bf16* __restrict__ xn) {
    const int row = blockIdx.x, tid = threadIdx.x;
    const float4 v = ((const float4*)(x + (size_t)row * DM))[tid];
    float s = v.x * v.x + v.y * v.y + v.z * v.z + v.w * v.w;
    __shared__ float red[256];
    red[tid] = s; __syncthreads();
    for (int o = 128; o > 0; o >>= 1) { if (tid < o) red[tid] += red[tid + o]; __syncthreads(); }
    const float rstd = rsqrtf(red[0] / DM + EPS);
    const float4 gg = ((const float4*)g)[tid];
    bf16* o = xn + (size_t)row * DM + tid * 4;
    o[0] = f2bf(v.x * rstd * gg.x); o[1] = f2bf(v.y * rstd * gg.y); o[2] = f2bf(v.z * rstd * gg.z); o[3] = f2bf(v.w * rstd * gg.w);
}

template <class Epi>
__global__ void n_gemm(const bf16* __restrict__ A, int lda, const float* __restrict__ W, int ldw, int K, Epi epi) {
    __shared__ float As[16][65]; __shared__ float Ws[16][64];
    const int tx = threadIdx.x, ty = threadIdx.y, tid = ty * 16 + tx;
    const int row0 = blockIdx.y * 64, col0 = blockIdx.x * 64;
    float acc[4][4];
#pragma unroll
    for (int i = 0; i < 4; ++i)
#pragma unroll
        for (int j = 0; j < 4; ++j) acc[i][j] = 0.f;
    for (int k0 = 0; k0 < K; k0 += 16) {
#pragma unroll
        for (int i = 0; i < 4; ++i) { const int idx = tid + i * 256; const int r = idx >> 4, kk = idx & 15; As[kk][r] = bf2f(A[(size_t)(row0 + r) * lda + k0 + kk]); }
#pragma unroll
        for (int i = 0; i < 4; ++i) { const int idx = tid + i * 256; const int kk = idx >> 6, c = idx & 63; Ws[kk][c] = W[(size_t)(k0 + kk) * ldw + col0 + c]; }
        __syncthreads();
#pragma unroll
        for (int kk = 0; kk < 16; ++kk) {
            float a[4], b[4];
#pragma unroll
            for (int i = 0; i < 4; ++i) a[i] = As[kk][ty * 4 + i];
#pragma unroll
            for (int j = 0; j < 4; ++j) b[j] = Ws[kk][tx * 4 + j];
#pragma unroll
            for (int i = 0; i < 4; ++i)
#pragma unroll
                for (int j = 0; j < 4; ++j) acc[i][j] += a[i] * b[j];
        }
        __syncthreads();
    }
#pragma unroll
    for (int i = 0; i < 4; ++i)
#pragma unroll
        for (int j = 0; j < 4; ++j) epi(row0 + ty * 4 + i, col0 + tx * 4 + j, acc[i][j]);
}

struct EpiInProjN {
    bf16 *Q, *K, *V, *XR, *GY, *GATES;
    __device__ void operator()(int r, int c, float v) const {
        if (c < 512) Q[(size_t)r * 512 + c] = f2bf(v * C2);
        else if (c < 1024) K[(size_t)r * 512 + c - 512] = f2bf(v);
        else if (c < 1536) V[(size_t)r * 512 + c - 1024] = f2bf(v);
        else if (c < 2048) XR[(size_t)r * 512 + c - 1536] = f2bf(v);
        else if (c < 2560) GY[(size_t)r * 512 + c - 2048] = f2bf(gelu_tanh(v));
        else GATES[(size_t)r * 2048 + c - 2560] = f2bf(sigmoidf_(v));
    }
};
struct EpiResid { const float* x; float* out; __device__ void operator()(int r, int c, float v) const { out[(size_t)r * DM + c] = x[(size_t)r * DM + c] + v; } };

__global__ void n_gemm_mix(const bf16* __restrict__ AL, const float* __restrict__ Woa, const float* __restrict__ Wol, const bf16* __restrict__ GATES, bf16* __restrict__ MERGED) {
    __shared__ float As[2][16][65]; __shared__ float Ws[2][16][64];
    const int tx = threadIdx.x, ty = threadIdx.y, tid = ty * 16 + tx;
    const int row0 = blockIdx.y * 64, col0 = blockIdx.x * 64;
    float acc[2][4][4];
#pragma unroll
    for (int s = 0; s < 2; ++s)
#pragma unroll
        for (int i = 0; i < 4; ++i)
#pragma unroll
            for (int j = 0; j < 4; ++j) acc[s][i][j] = 0.f;
    for (int k0 = 0; k0 < 512; k0 += 16) {
#pragma unroll
        for (int i = 0; i < 4; ++i) { const int idx = tid + i * 256; const int r = idx >> 4, kk = idx & 15;
            As[0][kk][r] = bf2f(AL[(size_t)(row0 + r) * 1024 + k0 + kk]); As[1][kk][r] = bf2f(AL[(size_t)(row0 + r) * 1024 + 512 + k0 + kk]); }
#pragma unroll
        for (int i = 0; i < 4; ++i) { const int idx = tid + i * 256; const int kk = idx >> 6, c = idx & 63;
            Ws[0][kk][c] = Woa[(size_t)(k0 + kk) * 1024 + col0 + c]; Ws[1][kk][c] = Wol[(size_t)(k0 + kk) * 1024 + col0 + c]; }
        __syncthreads();
#pragma unroll
        for (int s = 0; s < 2; ++s)
#pragma unroll
            for (int kk = 0; kk < 16; ++kk) {
                float a[4], b[4];
#pragma unroll
                for (int i = 0; i < 4; ++i) a[i] = As[s][kk][ty * 4 + i];
#pragma unroll
                for (int j = 0; j < 4; ++j) b[j] = Ws[s][kk][tx * 4 + j];
#pragma unroll
                for (int i = 0; i < 4; ++i)
#pragma unroll
                    for (int j = 0; j < 4; ++j) acc[s][i][j] += a[i] * b[j];
            }
        __syncthreads();
    }
#pragma unroll
    for (int i = 0; i < 4; ++i)
#pragma unroll
        for (int j = 0; j < 4; ++j) { const int r = row0 + ty * 4 + i, c = col0 + tx * 4 + j;
            const float ga = bf2f(GATES[(size_t)r * 2048 + c]), gl = bf2f(GATES[(size_t)r * 2048 + 1024 + c]);
            MERGED[(size_t)r * 1024 + c] = f2bf(ga * acc[0][i][j] + gl * acc[1][i][j]); }
}

__global__ void n_attn(const bf16* __restrict__ Q, const bf16* __restrict__ K, const bf16* __restrict__ V, const float* __restrict__ lambda_qk, const float* __restrict__ subln_g, bf16* __restrict__ AL) {
    const int row = blockIdx.x, h = blockIdx.y, tid = threadIdx.x;
    const int b = row / SEQ, qpos = row % SEQ;
    __shared__ float sc[SEQ]; __shared__ float qv[64]; __shared__ float red[256]; __shared__ float o0[128]; __shared__ float part[256];
    const float slope2 = exp2f(-2.f * (h + 1)) * LOG2E;
    float lam;
    { float s0 = 0.f, s1 = 0.f; for (int d = 0; d < 64; ++d) { s0 += lambda_qk[d] * lambda_qk[64 + d]; s1 += lambda_qk[128 + d] * lambda_qk[192 + d]; } lam = expf(s0) - expf(s1) + 0.2f; }
    float ofin = 0.f;
    for (int m = 0; m < 2; ++m) {
        __syncthreads();
        if (tid < 64) qv[tid] = bf2f(Q[(size_t)row * 512 + h * 128 + m * 64 + tid]);
        __syncthreads();
        float lmax = -INFINITY;
        for (int key = tid; key <= qpos; key += 256) {
            const bf16* kr = K + (size_t)(b * SEQ + key) * 512 + h * 128 + m * 64;
            float s = 0.f;
            for (int d = 0; d < 64; ++d) s += qv[d] * bf2f(kr[d]);
            s += slope2 * (float)(key - qpos);
            sc[key] = s; lmax = fmaxf(lmax, s);
        }
        red[tid] = lmax; __syncthreads();
        for (int o = 128; o > 0; o >>= 1) { if (tid < o) red[tid] = fmaxf(red[tid], red[tid + o]); __syncthreads(); }
        const float mx = red[0]; __syncthreads();
        float lsum = 0.f;
        for (int key = tid; key <= qpos; key += 256) { const float p = exp2f(sc[key] - mx); sc[key] = p; lsum += p; }
        red[tid] = lsum; __syncthreads();
        for (int o = 128; o > 0; o >>= 1) { if (tid < o) red[tid] += red[tid + o]; __syncthreads(); }
        const float inv = 1.f / red[0]; __syncthreads();
        const int vd = tid & 127, half = tid >> 7;
        float acc = 0.f;
        for (int key = half; key <= qpos; key += 2) acc += sc[key] * bf2f(V[(size_t)(b * SEQ + key) * 512 + h * 128 + vd]);
        part[tid] = acc; __syncthreads();
        if (tid < 128) { const float o = (part[tid] + part[tid + 128]) * inv; if (m == 0) ofin = o; else ofin = ofin - lam * o; }
    }
    __syncthreads();
    red[tid] = (tid < 128) ? ofin * ofin : 0.f; __syncthreads();
    for (int o = 128; o > 0; o >>= 1) { if (tid < o) red[tid] += red[tid + o]; __syncthreads(); }
    const float rstd = rsqrtf(red[0] / 128.f + EPS);
    if (tid < 128) AL[(size_t)row * 1024 + h * 128 + tid] = f2bf(ofin * rstd * subln_g[tid] * 0.8f);
}

__global__ void n_lru(const bf16* __restrict__ XR, const bf16* __restrict__ GY, const float* __restrict__ conv_w, const float* __restrict__ conv_b, const float* __restrict__ w_r, const float* __restrict__ b_r,
                      const float* __restrict__ w_i, const float* __restrict__ b_i, const float* __restrict__ lru_lambda, bf16* __restrict__ AL) {
    const int b = blockIdx.x >> 3, n = blockIdx.x & 7, d = threadIdx.x, ch = n * 64 + d;
    __shared__ float Wr[64][64]; __shared__ float Wi[64][64]; __shared__ float xs[64];
    for (int c = 0; c < 64; ++c) { Wr[c][d] = w_r[(size_t)n * 4096 + c * 64 + d]; Wi[c][d] = w_i[(size_t)n * 4096 + c * 64 + d]; }
    const float cw0 = conv_w[ch], cw1 = conv_w[512 + ch], cw2 = conv_w[1024 + ch], cw3 = conv_w[1536 + ch], cb = conv_b[ch];
    const float br = b_r[ch], bi = b_i[ch];
    const float sp = log1pf(expf(-lru_lambda[ch]));
    float xm3 = 0.f, xm2 = 0.f, xm1 = 0.f, hst = 0.f;
    __syncthreads();
    for (int t = 0; t < SEQ; ++t) {
        const size_t row = (size_t)b * SEQ + t;
        const float xt = bf2f(XR[row * 512 + ch]);
        const float xc = cw0 * xm3 + cw1 * xm2 + cw2 * xm1 + cw3 * xt + cb;
        xm3 = xm2; xm2 = xm1; xm1 = xt;
        xs[d] = xc; __syncthreads();
        float rp = br, ip = bi;
        for (int c = 0; c < 64; ++c) { const float xv = xs[c]; rp += xv * Wr[c][d]; ip += xv * Wi[c][d]; }
        __syncthreads();
        const float r = sigmoidf_(rp), ig = sigmoidf_(ip);
        const float log_a = -8.f * r * sp;
        const float a = expf(log_a);
        const float mult = (t == 0) ? 1.f : sqrtf(-expm1f(2.f * log_a));
        hst = a * hst + xc * ig * mult;
        AL[row * 1024 + 512 + ch] = f2bf(hst * bf2f(GY[row * 512 + ch]));
    }
}

__global__ void n_moe_final(float* __restrict__ xio, const float* __restrict__ g_ffn, const float* __restrict__ w_group, const float* __restrict__ w_er, const float* __restrict__ w_gate, const float* __restrict__ w_up,
                            const float* __restrict__ w_down, const float* __restrict__ g_fin) {
    const int row = blockIdx.x, tid = threadIdx.x;
    __shared__ float x1[1024]; __shared__ float hn[1024]; __shared__ float hb[512]; __shared__ float red[512]; __shared__ float lg[16]; __shared__ int sel[4]; __shared__ float selw[2];
    float* xr = xio + (size_t)row * DM;
    const float a0 = xr[tid], a1 = xr[tid + 512];
    x1[tid] = a0; x1[tid + 512] = a1;
    red[tid] = a0 * a0 + a1 * a1; __syncthreads();
    for (int o = 256; o > 0; o >>= 1) { if (tid < o) red[tid] += red[tid + o]; __syncthreads(); }
    const float rstd = rsqrtf(red[0] / DM + EPS); __syncthreads();
    hn[tid] = a0 * rstd * g_ffn[tid]; hn[tid + 512] = a1 * rstd * g_ffn[tid + 512]; __syncthreads();
    if (tid < 4) { float s = 0.f; for (int k = 0; k < 1024; ++k) s += hn[k] * w_group[k * 4 + tid]; lg[tid] = s; }
    __syncthreads();
    if (tid == 0) { int g = 0; float mx = lg[0]; for (int j = 1; j < 4; ++j) if (lg[j] > mx) { mx = lg[j]; g = j; } float den = 0.f; for (int j = 0; j < 4; ++j) den += expf(lg[j] - mx); sel[0] = g; lg[8] = 1.f / den; }
    __syncthreads();
    const int grp = sel[0];
    if (tid < 8) { float s = 0.f; const float* w = w_er + (size_t)grp * 8192; for (int k = 0; k < 1024; ++k) s += hn[k] * w[k * 8 + tid]; lg[tid] = s; }
    __syncthreads();
    if (tid == 0) {
        const float gw = lg[8];
        int i0 = 0; for (int j = 1; j < 8; ++j) if (lg[j] > lg[i0]) i0 = j;
        int i1 = (i0 == 0) ? 1 : 0; for (int j = 0; j < 8; ++j) if (j != i0 && lg[j] > lg[i1]) i1 = j;
        const float p0 = 1.f / (1.f + expf(lg[i1] - lg[i0]));
        sel[1] = grp * 8 + i0; sel[2] = grp * 8 + i1; selw[0] = gw * p0; selw[1] = gw * (1.f - p0);
    }
    __syncthreads();
    float y0 = 0.f, y1 = 0.f;
    for (int kk = 0; kk < 2; ++kk) {
        const int e = sel[1 + kk]; const float wk = selw[kk];
        const float* wg = w_gate + (size_t)e * 1024 * 512; const float* wu = w_up + (size_t)e * 1024 * 512; const float* wd = w_down + (size_t)e * 512 * 1024;
        float g = 0.f, u = 0.f;
        for (int k = 0; k < 1024; ++k) { const float xv = hn[k]; g += xv * wg[(size_t)k * 512 + tid]; u += xv * wu[(size_t)k * 512 + tid]; }
        __syncthreads();
        hb[tid] = g / (1.f + expf(-g)) * u; __syncthreads();
        float s0 = 0.f, s1 = 0.f;
        for (int j = 0; j < 512; ++j) { const float hv = hb[j]; s0 += hv * wd[(size_t)j * 1024 + tid]; s1 += hv * wd[(size_t)j * 1024 + tid + 512]; }
        y0 += wk * s0; y1 += wk * s1;
    }
    const float z0 = a0 + y0, z1 = a1 + y1;
    __syncthreads();
    red[tid] = z0 * z0 + z1 * z1; __syncthreads();
    for (int o = 256; o > 0; o >>= 1) { if (tid < o) red[tid] += red[tid + o]; __syncthreads(); }
    const float rs2 = rsqrtf(red[0] / DM + EPS);
    xr[tid] = z0 * rs2 * g_fin[tid]; xr[tid + 512] = z1 * rs2 * g_fin[tid + 512];
}


__global__ void n_conv_win(const float* __restrict__ W, bf16* __restrict__ WT) {
    const int c = blockIdx.x * 256 + threadIdx.x, k = blockIdx.y;
    const int w = c & 255; const int row = (c & ~255) + ((w >> 5) & 1) * 128 + (w >> 6) * 32 + (w & 31);
    WT[(size_t)row * 1024 + k] = (bf16)f2bf(W[(size_t)k * INC + c]);
}
#ifndef MEGA_HI
#define MEGA_HI 11
#endif
static void launch_mega(const Args& a0, int lo, int hi, int li, int grid, hipStream_t stream) {
    Args a = a0; a.ph_lo = lo; a.ph_hi = hi; a.li = li;
    hipLaunchKernelGGL(mega, dim3(grid), dim3(NWAVES * 64), LDS_BYTES, stream, a);
    const hipError_t le = hipPeekAtLastError();
    if (le != hipSuccess) fprintf(stderr, "kernel_launch: mega launch [%d,%d) failed: %s\n", lo, hi, hipGetErrorName(le));
}
extern "C" void kernel_launch(void* const* d_in, const int* in_sizes, int n_in, void* d_out, int out_size, void* d_ws, size_t ws_size, hipStream_t stream) {
    static int grid = 0;
    if (grid == 0) {
        if (n_in != 22 || out_size != NTOK * DM || ws_size < WS_END) { fprintf(stderr, "kernel_launch: unexpected shapes (n_in %d out %d ws %zu)\n", n_in, out_size, ws_size); grid = -1; return; }
        int dev = 0, cus = 0, per_cu = 0;
        if (hipGetDevice(&dev) != hipSuccess || hipDeviceGetAttribute(&cus, hipDeviceAttributeMultiprocessorCount, dev) != hipSuccess) { grid = -1; return; }
        if (hipFuncSetAttribute((const void*)mega, hipFuncAttributeMaxDynamicSharedMemorySize, LDS_BYTES) != hipSuccess) { fprintf(stderr, "kernel_launch: hipFuncSetAttribute failed\n"); grid = -1; return; }
        if (hipOccupancyMaxActiveBlocksPerMultiprocessor(&per_cu, (const void*)mega, NWAVES * 64, LDS_BYTES) != hipSuccess || per_cu < 1) fprintf(stderr, "kernel_launch: occupancy query says %d\n", per_cu);
        (void)hipGetLastError();
        grid = cus;
    }
    if (grid < 0) return;
    (void)hipMemsetAsync((char*)d_ws + WS_CTL, 0, CTL_ZERO_BYTES, stream);
    Args a{};
    for (int i = 0; i < 22; ++i) a.in[i] = (const float*)d_in[i];
    a.out = (float*)d_out; a.ws = (unsigned char*)d_ws;
    const float* x = (const float*)d_in[0];
    unsigned char* ws = (unsigned char*)d_ws;
    bf16* XN = (bf16*)(ws + WS_XN); bf16* Qb = (bf16*)(ws + WS_Q); bf16* Kb = (bf16*)(ws + WS_K); bf16* Vb = (bf16*)(ws + WS_V);
    bf16* XR = (bf16*)(ws + WS_XR); bf16* GY = (bf16*)(ws + WS_GY); bf16* AL = (bf16*)(ws + WS_AL); bf16* MERGED = (bf16*)(ws + WS_MERGED);
    bf16* GATES = (bf16*)d_out;
#ifdef DUP_PHASE
    launch_mega(a, 0, DUP_PHASE + 1, 0, grid, stream);
    launch_mega(a, DUP_PHASE, DUP_PHASE + 1, 1, grid, stream);
    if (DUP_PHASE + 1 < 11) launch_mega(a, DUP_PHASE + 1, 11, 2, grid, stream);
#elif defined(PROBE_P1_ONLY)
    n_rmsnorm<<<NTOK, 256, 0, stream>>>(x, (const float*)d_in[1], XN);
    n_conv_win<<<dim3(INC / 256, 1024), 256, 0, stream>>>((const float*)d_in[2], (bf16*)(ws + WS_WIN));
    launch_mega(a, 1, 2, 0, grid, stream);
#elif defined(MEGA_SPLIT)
    for (int ph = 0; ph < MEGA_HI; ++ph) launch_mega(a, ph, ph + 1, ph, grid, stream);
#else
    if (MEGA_HI > 0) launch_mega(a, 0, MEGA_HI, 0, grid, stream);
#endif
    if (MEGA_HI < 1) n_rmsnorm<<<NTOK, 256, 0, stream>>>(x, (const float*)d_in[1], XN);
    if (MEGA_HI < 2) n_gemm<EpiInProjN><<<dim3(INC / 64, NTOK / 64), dim3(16, 16), 0, stream>>>(XN, DM, (const float*)d_in[2], INC, DM, EpiInProjN{Qb, Kb, Vb, XR, GY, GATES});
    if (MEGA_HI < 3) n_attn<<<dim3(NTOK, 4), 256, 0, stream>>>(Qb, Kb, Vb, (const float*)d_in[3], (const float*)d_in[4], AL);
    if (MEGA_HI < 4) n_lru<<<16, 64, 0, stream>>>(XR, GY, (const float*)d_in[5], (const float*)d_in[6], (const float*)d_in[7], (const float*)d_in[8], (const float*)d_in[9], (const float*)d_in[10], (const float*)d_in[11], AL);
    if (MEGA_HI < 5) n_gemm_mix<<<dim3(DM / 64, NTOK / 64), dim3(16, 16), 0, stream>>>(AL, (const float*)d_in[12], (const float*)d_in[13], GATES, MERGED);
    if (MEGA_HI < 6) n_gemm<EpiResid><<<dim3(DM / 64, NTOK / 64), dim3(16, 16), 0, stream>>>(MERGED, DM, (const float*)d_in[14], DM, DM, EpiResid{x, (float*)d_out});
    if (MEGA_HI < 11) n_moe_final<<<NTOK, 512, 0, stream>>>((float*)d_out, (const float*)d_in[15], (const float*)d_in[16], (const float*)d_in[17], (const float*)d_in[18], (const float*)d_in[19], (const float*)d_in[20], (const float*)d_in[21]);
}
```
